# Optimizing an MI355X kernel written in HIP

```python
import math
import jax, jax.numpy as jnp
from jax import lax
import numpy as np

D_MODEL = 1024
BATCH = 32
SEQ = 2048
DEPTH = 1
DEC_BATCH = 128
DEC_SEQ = 1
PAST_LEN = 8192
PAGE_SIZE = 128

N_HEADS_A = 8
HEAD_DIM_A = 64
D_ATTN = N_HEADS_A * HEAD_DIM_A
DILATED_PATTERNS = ((128, 1), (512, 4), (2048, 16))
MAX_WINDOW = 2048
NUM_BUCKETS = 32
MAX_DISTANCE = 2048
N_HEADS_B = 16
HEAD_DIM_B = 64
D_INNER = N_HEADS_B * HEAD_DIM_B
N_SSM_GROUPS = 2
HEADS_PER_GROUP = N_HEADS_B // N_SSM_GROUPS
D_STATE = 128
CONV_WIDTH = 4
SSD_CHUNK = 128
D_XBC = D_INNER + 2 * N_SSM_GROUPS * D_STATE
D_MIX = D_ATTN + D_INNER
D_IN_PROJ = 3 * D_ATTN + D_INNER + D_XBC + N_HEADS_B
N_MEM = 256
N_HEADS_X = 4
HEAD_DIM_X = D_MODEL // N_HEADS_X
D_FF = ((8 * D_MODEL // 3 + 127) // 128) * 128
EPS = 1e-6
NEG_INF = -1e30

kernel_name = "hymba_dilated_ssd_macaron_step"


def rms_norm(x, g):
    x32 = x.astype(jnp.float32)
    y = x32 * lax.rsqrt(jnp.mean(x32 * x32, axis=-1, keepdims=True) + EPS)
    return (y * g.astype(jnp.float32)).astype(x.dtype)


def swiglu(x, w_gate, w_up, w_down):
    return (jax.nn.silu(x @ w_gate) * (x @ w_up)) @ w_down


def t5_bucket(dist):
    max_exact = NUM_BUCKETS // 2
    d = jnp.maximum(dist, 0)
    df = jnp.maximum(d, 1).astype(jnp.float32)
    large = max_exact + (jnp.log(df / max_exact) / math.log(MAX_DISTANCE / max_exact)
                         * (NUM_BUCKETS - max_exact)).astype(jnp.int32)
    large = jnp.minimum(large, NUM_BUCKETS - 1)
    return jnp.where(d < max_exact, d, large)


def dilated_attn_prompt(q, k, v, rel_bias, window, dilation):
    b, s, h, dh = q.shape
    n_back = window // dilation
    blk = n_back
    ls = s // dilation
    nb = -(-ls // blk)
    lp = nb * blk
    n = b * dilation

    def by_residue(a):
        a = a.reshape(b, ls, dilation, h, dh).transpose(0, 2, 1, 3, 4).reshape(n, ls, h, dh)
        a = jnp.pad(a, ((0, 0), (0, lp - ls), (0, 0), (0, 0)))
        return a.reshape(n, nb, blk, h, dh)

    def with_prev_block(a):
        prev = jnp.concatenate([jnp.zeros_like(a[:, :1]), a[:, :-1]], axis=1)
        return jnp.concatenate([prev, a], axis=2)

    qb = by_residue(q)
    kb = with_prev_block(by_residue(k))
    vb = with_prev_block(by_residue(v))
    qi = jnp.arange(blk)[:, None]
    kj = jnp.arange(2 * blk)[None, :]
    delta = qi + blk - kj
    band = (delta >= 0) & (delta <= n_back)
    exists = (jnp.arange(nb)[:, None, None] > 0) | (kj[None] >= blk)
    mask = band[None] & exists
    bias = jnp.transpose(rel_bias[t5_bucket(delta * dilation)], (2, 0, 1)).astype(jnp.float32)
    scores = jnp.einsum('nbqhd,nbkhd->nbhqk', qb, kb).astype(jnp.float32) * (HEAD_DIM_A ** -0.5)
    scores = jnp.where(mask[None, :, None], scores + bias[None, None], NEG_INF)
    lse = jax.nn.logsumexp(scores, axis=-1)
    p = jnp.exp(scores - lse[..., None])
    o = jnp.einsum('nbhqk,nbkhd->nbqhd', p, vb.astype(jnp.float32))
    o = o.reshape(n, lp, h, dh)[:, :ls]
    lse = jnp.transpose(lse, (0, 1, 3, 2)).reshape(n, lp, h)[:, :ls]
    o = o.reshape(b, dilation, ls, h, dh).transpose(0, 2, 1, 3, 4).reshape(b, s, h, dh)
    lse = lse.reshape(b, dilation, ls, h).transpose(0, 2, 1, 3).reshape(b, s, h)
    return o, lse


def dilated_attn_sample(q, k_all, v_all, rel_bias, window, dilation):
    t = q.shape[1]
    w = k_all.shape[1] - t
    offs = jnp.arange(window // dilation + 1) * dilation
    idx = w + jnp.arange(t)[:, None] - offs[None, :]
    valid = idx >= 0
    idx = jnp.maximum(idx, 0)
    kg = k_all[:, idx]
    vg = v_all[:, idx]
    bias = jnp.transpose(rel_bias[t5_bucket(offs)], (1, 0)).astype(jnp.float32)
    scores = jnp.einsum('bthd,btkhd->bhtk', q, kg).astype(jnp.float32) * (HEAD_DIM_A ** -0.5)
    scores = jnp.where(valid[None, None], scores + bias[None, :, None, :], NEG_INF)
    lse = jax.nn.logsumexp(scores, axis=-1)
    p = jnp.exp(scores - lse[..., None])
    o = jnp.einsum('bhtk,btkhd->bthd', p, vg.astype(jnp.float32))
    return o, jnp.transpose(lse, (0, 2, 1))


def denominator_mixture(outs, lses):
    wts = jax.nn.softmax(jnp.stack(lses, 0), axis=0)
    return jnp.einsum('pblh,pblhd->blhd', wts, jnp.stack(outs, 0))


def ssd_chunked(xs, dt, a, bm, cm, h0):
    b, L, G, E, P = xs.shape
    N = bm.shape[-1]
    Q = min(SSD_CHUNK, L)
    lp = -(-L // Q) * Q
    pad = lp - L
    xs = xs.astype(jnp.float32)
    bm = bm.astype(jnp.float32)
    cm = cm.astype(jnp.float32)
    if pad:
        xs = jnp.pad(xs, ((0, 0), (0, pad), (0, 0), (0, 0), (0, 0)))
        dt = jnp.pad(dt, ((0, 0), (0, pad), (0, 0), (0, 0)))
        bm = jnp.pad(bm, ((0, 0), (0, pad), (0, 0), (0, 0)))
        cm = jnp.pad(cm, ((0, 0), (0, pad), (0, 0), (0, 0)))
    nc = lp // Q
    xdt = (xs * dt[..., None]).reshape(b, nc, Q, G, E, P)
    la = (dt * a[None, None]).reshape(b, nc, Q, G, E).transpose(0, 1, 3, 4, 2)
    a_cs = jnp.cumsum(la, axis=-1)
    bc = bm.reshape(b, nc, Q, G, N)
    cc = cm.reshape(b, nc, Q, G, N)
    causal = jnp.tril(jnp.ones((Q, Q), dtype=bool))
    seg = a_cs[..., :, None] - a_cs[..., None, :]
    lmat = jnp.exp(jnp.where(causal, seg, -jnp.inf))
    cb = jnp.einsum('bclgn,bcsgn->bcgls', cc, bc)
    y_diag = jnp.einsum('bcgls,bcgels,bcsgep->bclgep', cb, lmat, xdt)
    decay_s = jnp.exp(a_cs[..., -1:] - a_cs)
    st = jnp.einsum('bcsgn,bcges,bcsgep->bcgepn', bc, decay_s, xdt)
    chunk_decay = jnp.exp(a_cs[..., -1])

    def step(h, inp):
        st_c, dec_c = inp
        return dec_c[..., None, None] * h + st_c, h

    h_last, h_in = lax.scan(step, h0, (jnp.transpose(st, (1, 0, 2, 3, 4, 5)),
                                       jnp.transpose(chunk_decay, (1, 0, 2, 3))))
    h_in = jnp.transpose(h_in, (1, 0, 2, 3, 4, 5))
    y_off = jnp.einsum('bclgn,bcgepn,bcgel->bclgep', cc, h_in, jnp.exp(a_cs))
    y = (y_diag + y_off).reshape(b, lp, G, E, P)[:, :L]
    return y, h_last


def mamba2_mixer(z, xbc_raw, dt_raw, conv_prev, ssm_prev, conv_w, conv_b, dt_bias, a_log, d_skip, g_ssm):
    b, l, _ = z.shape
    xin = jnp.concatenate([conv_prev.astype(jnp.float32), xbc_raw.astype(jnp.float32)], axis=1)
    new_conv = xin[:, -(CONV_WIDTH - 1):].astype(xbc_raw.dtype)
    xbc = lax.conv_general_dilated(xin, conv_w.astype(jnp.float32)[:, None, :], window_strides=(1,),
                                   padding='VALID', dimension_numbers=('NWC', 'WIO', 'NWC'),
                                   feature_group_count=D_XBC)
    xbc = jax.nn.silu(xbc + conv_b.astype(jnp.float32))
    xs = xbc[..., :D_INNER].reshape(b, l, N_SSM_GROUPS, HEADS_PER_GROUP, HEAD_DIM_B)
    bm = xbc[..., D_INNER:D_INNER + N_SSM_GROUPS * D_STATE].reshape(b, l, N_SSM_GROUPS, D_STATE)
    cm = xbc[..., D_INNER + N_SSM_GROUPS * D_STATE:].reshape(b, l, N_SSM_GROUPS, D_STATE)
    dt = jax.nn.softplus(dt_raw.astype(jnp.float32) + dt_bias.astype(jnp.float32))
    dt = dt.reshape(b, l, N_SSM_GROUPS, HEADS_PER_GROUP)
    a = -jnp.exp(a_log.astype(jnp.float32)).reshape(N_SSM_GROUPS, HEADS_PER_GROUP)
    h0 = ssm_prev.astype(jnp.float32).reshape(b, N_SSM_GROUPS, HEADS_PER_GROUP, HEAD_DIM_B, D_STATE)
    y, h_last = ssd_chunked(xs, dt, a, bm, cm, h0)
    y = y + d_skip.astype(jnp.float32).reshape(N_SSM_GROUPS, HEADS_PER_GROUP)[..., None] * xs
    gate = jax.nn.silu(z.astype(jnp.float32)).reshape(b, l, N_SSM_GROUPS, D_INNER // N_SSM_GROUPS)
    yg = y.reshape(b, l, N_SSM_GROUPS, D_INNER // N_SSM_GROUPS) * gate
    yg = yg * lax.rsqrt(jnp.mean(yg * yg, axis=-1, keepdims=True) + EPS)
    y = yg.reshape(b, l, D_INNER) * g_ssm.astype(jnp.float32)
    return y, new_conv, h_last.reshape(b, N_HEADS_B, HEAD_DIM_B, D_STATE)


def memory_kv(mem, g_mem, w_ck, w_cv):
    b = mem.shape[0]
    m = rms_norm(mem, g_mem)
    mk = (m @ w_ck).reshape(b, N_MEM, N_HEADS_X, HEAD_DIM_X)
    mv = (m @ w_cv).reshape(b, N_MEM, N_HEADS_X, HEAD_DIM_X)
    return mk, mv


def memory_attend(h, mk, mv, w_cq, w_co):
    b, l, _ = h.shape
    q = (h @ w_cq).reshape(b, l, N_HEADS_X, HEAD_DIM_X)
    s = jnp.einsum('blhd,bmhd->bhlm', q, mk).astype(jnp.float32) * (HEAD_DIM_X ** -0.5)
    p = jax.nn.softmax(s, axis=-1)
    o = jnp.einsum('bhlm,bmhd->blhd', p, mv.astype(jnp.float32))
    return o.reshape(b, l, N_HEADS_X * HEAD_DIM_X).astype(h.dtype) @ w_co


def decoder_layer(x, k_prev, v_prev, conv_prev, ssm_prev, mem_k, mem_v, rel_bias,
                  g_ffn1, w1_gate, w1_up, w1_down, g_mix, w_in, conv_w, conv_b, dt_bias, a_log,
                  d_skip, g_ssm, w_out, g_cross, w_cq, w_co, g_ffn2, w2_gate, w2_up, w2_down):
    b, l, _ = x.shape
    x = x + (0.5 * swiglu(rms_norm(x, g_ffn1), w1_gate, w1_up, w1_down)).astype(x.dtype)
    h = rms_norm(x, g_mix)
    proj = h @ w_in
    cuts = [D_ATTN, 2 * D_ATTN, 3 * D_ATTN, 3 * D_ATTN + D_INNER, 3 * D_ATTN + D_INNER + D_XBC]
    q, k, v, z, xbc_raw, dt_raw = jnp.split(proj, cuts, axis=-1)
    q = q.reshape(b, l, N_HEADS_A, HEAD_DIM_A)
    k = k.reshape(b, l, N_HEADS_A, HEAD_DIM_A)
    v = v.reshape(b, l, N_HEADS_A, HEAD_DIM_A)
    if k_prev is None:
        res = [dilated_attn_prompt(q, k, v, rel_bias, wnd, dil) for (wnd, dil) in DILATED_PATTERNS]
        keep = min(MAX_WINDOW, l)
        new_k, new_v = k[:, l - keep:], v[:, l - keep:]
        conv_prev = jnp.zeros((b, CONV_WIDTH - 1, D_XBC), xbc_raw.dtype)
        ssm_prev = jnp.zeros((b, N_HEADS_B, HEAD_DIM_B, D_STATE), jnp.float32)
    else:
        k_all = jnp.concatenate([k_prev.astype(k.dtype), k], axis=1)
        v_all = jnp.concatenate([v_prev.astype(v.dtype), v], axis=1)
        res = [dilated_attn_sample(q, k_all, v_all, rel_bias, wnd, dil) for (wnd, dil) in DILATED_PATTERNS]
        new_k, new_v = k, v
    o_attn = denominator_mixture([r[0] for r in res], [r[1] for r in res]).reshape(b, l, D_ATTN)
    y_ssm, new_conv, new_ssm = mamba2_mixer(z, xbc_raw, dt_raw, conv_prev, ssm_prev, conv_w, conv_b,
                                            dt_bias, a_log, d_skip, g_ssm)
    mixed = jnp.concatenate([o_attn.astype(x.dtype), y_ssm.astype(x.dtype)], axis=-1)
    x = x + (mixed @ w_out).astype(x.dtype)
    x = x + memory_attend(rms_norm(x, g_cross), mem_k, mem_v, w_cq, w_co).astype(x.dtype)
    x = x + (0.5 * swiglu(rms_norm(x, g_ffn2), w2_gate, w2_up, w2_down)).astype(x.dtype)
    return x, new_k, new_v, new_conv, new_ssm


def setup_inputs(seed: int = 0) -> dict:
    key = jax.random.key(seed)
    ks = iter(jax.random.split(key, 48))

    def nrm(shape, scale=1.0):
        return jax.random.normal(next(ks), shape, jnp.float32) * scale

    def gain(shape):
        return 1.0 + nrm(shape, 0.05)

    w_buf = min(MAX_WINDOW, PAST_LEN)
    L = DEPTH
    inp = {}
    inp["x_prompt"] = nrm((BATCH, SEQ, D_MODEL))
    inp["x_sample"] = nrm((DEC_BATCH, DEC_SEQ, D_MODEL))
    inp["cache_win_k"] = nrm((L, DEC_BATCH, w_buf, N_HEADS_A, HEAD_DIM_A))
    inp["cache_win_v"] = nrm((L, DEC_BATCH, w_buf, N_HEADS_A, HEAD_DIM_A))
    inp["cache_conv"] = nrm((L, DEC_BATCH, CONV_WIDTH - 1, D_XBC))
    inp["state_ssm"] = nrm((L, DEC_BATCH, N_HEADS_B, HEAD_DIM_B, D_STATE), 0.1)
    inp["cache_mem_k"] = nrm((L, DEC_BATCH, N_MEM, N_HEADS_X, HEAD_DIM_X))
    inp["cache_mem_v"] = nrm((L, DEC_BATCH, N_MEM, N_HEADS_X, HEAD_DIM_X))
    inp["mem_prompt"] = nrm((BATCH, N_MEM, D_MODEL))
    inp["rel_bias"] = nrm((NUM_BUCKETS, N_HEADS_A), 0.5)
    inp["g_ffn1"] = gain((L, D_MODEL))
    inp["w1_gate"] = nrm((L, D_MODEL, D_FF), D_MODEL ** -0.5)
    inp["w1_up"] = nrm((L, D_MODEL, D_FF), D_MODEL ** -0.5)
    inp["w1_down"] = nrm((L, D_FF, D_MODEL), D_FF ** -0.5)
    inp["g_mix"] = gain((L, D_MODEL))
    inp["w_in"] = nrm((L, D_MODEL, D_IN_PROJ), D_MODEL ** -0.5)
    inp["conv_w"] = nrm((L, CONV_WIDTH, D_XBC), CONV_WIDTH ** -0.5)
    inp["conv_b"] = nrm((L, D_XBC), 0.02)
    u = jax.random.uniform(next(ks), (L, N_HEADS_B), jnp.float32)
    dt0 = jnp.exp(u * (math.log(0.1) - math.log(0.001)) + math.log(0.001))
    inp["dt_bias"] = dt0 + jnp.log(-jnp.expm1(-dt0))
    inp["a_log"] = jnp.log(jax.random.uniform(next(ks), (L, N_HEADS_B), jnp.float32, 1.0, 16.0))
    inp["d_skip"] = gain((L, N_HEADS_B))
    inp["g_ssm"] = gain((L, D_INNER))
    inp["w_out"] = nrm((L, D_MIX, D_MODEL), D_MIX ** -0.5)
    inp["g_mem"] = gain((L, D_MODEL))
    inp["w_ck"] = nrm((L, D_MODEL, N_HEADS_X * HEAD_DIM_X), D_MODEL ** -0.5)
    inp["w_cv"] = nrm((L, D_MODEL, N_HEADS_X * HEAD_DIM_X), D_MODEL ** -0.5)
    inp["g_cross"] = gain((L, D_MODEL))
    inp["w_cq"] = nrm((L, D_MODEL, N_HEADS_X * HEAD_DIM_X), D_MODEL ** -0.5)
    inp["w_co"] = nrm((L, N_HEADS_X * HEAD_DIM_X, D_MODEL), (N_HEADS_X * HEAD_DIM_X) ** -0.5)
    inp["g_ffn2"] = gain((L, D_MODEL))
    inp["w2_gate"] = nrm((L, D_MODEL, D_FF), D_MODEL ** -0.5)
    inp["w2_up"] = nrm((L, D_MODEL, D_FF), D_MODEL ** -0.5)
    inp["w2_down"] = nrm((L, D_FF, D_MODEL), D_FF ** -0.5)
    inp["g_final"] = gain((D_MODEL,))
    return inp


def reference(x_prompt, x_sample, cache_win_k, cache_win_v, cache_conv, state_ssm, cache_mem_k,
              cache_mem_v, mem_prompt, rel_bias, g_ffn1, w1_gate, w1_up, w1_down, g_mix, w_in,
              conv_w, conv_b, dt_bias, a_log, d_skip, g_ssm, w_out, g_mem, w_ck, w_cv, g_cross,
              w_cq, w_co, g_ffn2, w2_gate, w2_up, w2_down, g_final):
    yp, ys = x_prompt, x_sample
    pk, pv, pc, pss, pmk, pmv = [], [], [], [], [], []
    sk, sv, sc, sss = [], [], [], []
    for i in range(DEPTH):
        lw = (g_ffn1[i], w1_gate[i], w1_up[i], w1_down[i], g_mix[i], w_in[i], conv_w[i], conv_b[i],
              dt_bias[i], a_log[i], d_skip[i], g_ssm[i], w_out[i], g_cross[i], w_cq[i], w_co[i],
              g_ffn2[i], w2_gate[i], w2_up[i], w2_down[i])
        mk_p, mv_p = memory_kv(mem_prompt, g_mem[i], w_ck[i], w_cv[i])
        yp, k_p, v_p, c_p, s_p = decoder_layer(yp, None, None, None, None, mk_p, mv_p, rel_bias, *lw)
        ys, k_s, v_s, c_s, s_s = decoder_layer(ys, cache_win_k[i], cache_win_v[i], cache_conv[i],
                                               state_ssm[i], cache_mem_k[i], cache_mem_v[i], rel_bias, *lw)
        pk.append(k_p); pv.append(v_p); pc.append(c_p); pss.append(s_p); pmk.append(mk_p); pmv.append(mv_p)
        sk.append(k_s); sv.append(v_s); sc.append(c_s); sss.append(s_s)
    y_prompt = rms_norm(yp, g_final)
    y_sample = rms_norm(ys, g_final)
    return (y_prompt, y_sample, jnp.stack(pk), jnp.stack(pv), jnp.stack(pc), jnp.stack(pss),
            jnp.stack(pmk), jnp.stack(pmv), jnp.stack(sk), jnp.stack(sv), jnp.stack(sc), jnp.stack(sss))
```

```cpp
#include <hip/hip_runtime.h>
#include <cstdio>
#include <cstdint>
namespace pg8 {
#define PG8_LAS __attribute__((address_space(3)))
typedef unsigned short bf16_t;
typedef short bf16x8 __attribute__((ext_vector_type(8)));
typedef float f32x4 __attribute__((ext_vector_type(4)));
typedef unsigned u32x4 __attribute__((ext_vector_type(4)));
constexpr int BM = 256, BK = 64, HALF = 128, HTB = HALF * BK * 2  , STAGE_BYTES = 8 * HTB, NXCD = 8, WGM = 8;

__host__ __device__ __forceinline__ int lds_byte(int r, int c) { const int st = (r >> 4) * 2 + (c >> 5), rr = r & 15, cc = c & 31, ob = rr * 64 + cc * 2; return st * 1024 + (ob ^ (((ob >> 9) & 1) << 5)); }
__host__ __device__ __forceinline__ void stage_rc(int b, int& R, int& C) { const int st = b / 1024, sb = b % 1024, swz = sb ^ (((sb >> 9) & 1) << 5); R = (st >> 1) * 16 + swz / 64; C = (st & 1) * 32 + (swz % 64) / 2; }
__host__ __device__ __forceinline__ int perm32(int rho) { const int n = rho >> 4, i = rho & 15; return 8 * (i >> 2) + 4 * n + (i & 3); }

struct Unit { int pm, pn, koff, ks; };
struct Gemm { const bf16_t* A; const bf16_t* Bt; int M, N, K, lda, ldb; };

struct StaticOrder {
    int nM, nN, nwg, G, c;
    __host__ __device__ void init(int M, int N, int G_, int c_) { nM = M / BM; nN = N / BM; nwg = nM * nN; G = G_; c = c_; }
    __host__ __device__ bool next(int i, Unit& u) const {
        const long L = (long)i * G + c; if (L >= nwg) return false;
        int wgid = (int)L; { const int q = nwg / NXCD, r = nwg % NXCD, xcd = wgid % NXCD, off = wgid / NXCD; wgid = (xcd < r ? xcd * (q + 1) : r * (q + 1) + (xcd - r) * q) + off; }
        const int nig = WGM * nN, gid = wgid / nig, fm = gid * WGM, gsz = (nM - fm) < WGM ? (nM - fm) : WGM;
        u.pm = fm + ((wgid % nig) % gsz); u.pn = (wgid % nig) / gsz; u.koff = 0; u.ks = 0; return true;
    }
    __device__ __forceinline__ void a_ready(const Unit&) const {}
    __device__ __forceinline__ void done(const Unit&) const {}
};
__device__ __forceinline__ unsigned cvt_pk_bf16(float lo, float hi) { unsigned r; asm volatile("v_cvt_pk_bf16_f32 %0, %1, %2" : "=v"(r) : "v"(lo), "v"(hi)); return r; }
typedef float f32x2 __attribute__((ext_vector_type(2)));
template <class Epi, class Sched, bool ALIGN_EPI = false, bool SP2 = false>
__device__ __forceinline__ void gemm_phase(PG8_LAS unsigned char* lds, const Gemm g, const Sched& S, const Epi& E, const int wid) {
    int lane; asm volatile("v_mbcnt_lo_u32_b32 %0, -1, 0\n\tv_mbcnt_hi_u32_b32 %0, -1, %0" : "=v"(lane));
    const int tid = wid * 64 + lane, wr = wid >> 2, wc = wid & 3, fr = lane & 15, fq = lane >> 4;
    const int K = g.K, nt = K / BK;
    unsigned voffA[2], voffB[2];
#pragma unroll
    for (int i = 0; i < 2; ++i) { int R, C; stage_rc(tid * 16 + i * 8192, R, C); const int Rb = Epi::PERM ? ((R & ~31) + perm32(R & 31)) : R;
        voffA[i] = (unsigned)(R * g.lda + C) * 2u; voffB[i] = (unsigned)(Rb * g.ldb + C) * 2u; }
    const size_t kstep = (size_t)(BK * 2);
    const size_t hstepA = (size_t)HALF * g.lda * 2, hstepB = (size_t)HALF * g.ldb * 2;
    const size_t tstepA = 2 * hstepA, tstepB = 2 * hstepB;
    const unsigned ldsw = (unsigned)wid * 1024u;
    const int aoff = lds_byte(wr * 64 + fr, fq * 8), boff = lds_byte(wc * 32 + fr, fq * 8);
#define PG8_SA(b, h) (((b) * 2 + (h)) * HTB)
#define PG8_SB(b, h) ((4 + (b) * 2 + (h)) * HTB)
#define PG8_STAGE(bufoff, gbase, voff) do { _Pragma("unroll") for (int _i = 0; _i < 2; ++_i) \
        __builtin_amdgcn_global_load_lds((const unsigned*)((const char*)(gbase) + (voff)[_i]), (PG8_LAS unsigned*)(lds + (bufoff) + ldsw + _i * 8192), 16, 0, 0); } while (0)
#define PG8_LDA(dst, b, h) do { _Pragma("unroll") for (int m = 0; m < 4; ++m) _Pragma("unroll") for (int k = 0; k < 2; ++k) dst[m][k] = *(const PG8_LAS bf16x8*)(lds + PG8_SA(b, h) + aoff + m * 2048 + k * 1024); } while (0)
#define PG8_LDB(dst, b, h) do { _Pragma("unroll") for (int n = 0; n < 2; ++n) _Pragma("unroll") for (int k = 0; k < 2; ++k) dst[n][k] = *(const PG8_LAS bf16x8*)(lds + PG8_SB(b, h) + boff + n * 2048 + k * 1024); } while (0)
#define PG8_MMA(ai, bj, At, Bt) do { __builtin_amdgcn_s_setprio(1); _Pragma("unroll") for (int m = 0; m < 4; ++m) _Pragma("unroll") for (int n = 0; n < 2; ++n) _Pragma("unroll") for (int k = 0; k < 2; ++k) \
        acc[ai][bj][m][n] = __builtin_amdgcn_mfma_f32_16x16x32_bf16(Bt[n][k], At[m][k], acc[ai][bj][m][n], 0, 0, 0); __builtin_amdgcn_s_setprio(0); } while (0)
#define PG8_WAIT_V(n) asm volatile("s_waitcnt vmcnt(" #n ")" ::: "memory")
#define PG8_WAIT_L(n) asm volatile("s_waitcnt lgkmcnt(" #n ")" ::: "memory")
#define PG8_BAR __builtin_amdgcn_s_barrier()
#define PG8_SCHED __builtin_amdgcn_sched_barrier(0)
    Unit cur, nxt; int ui = 0;
    if (!S.next(0, cur)) return;
    float pre[8] = {0.f, 0.f, 0.f, 0.f, 0.f, 0.f, 0.f, 0.f};
    f32x4 acc[2][2][4][2];
#pragma unroll
    for (int a = 0; a < 2; ++a)
#pragma unroll
        for (int b = 0; b < 2; ++b)
#pragma unroll
            for (int m = 0; m < 4; ++m)
#pragma unroll
                for (int n = 0; n < 2; ++n) acc[a][b][m][n] = (f32x4){0.f, 0.f, 0.f, 0.f};
    bf16x8 At[4][2], B0[2][2], B1[2][2];
    const char* cA = (const char*)g.A + (size_t)cur.pm * tstepA + cur.koff; const char* cB = (const char*)g.Bt + (size_t)cur.pn * tstepB + cur.koff;
    S.a_ready(cur);
    if constexpr (SP2) {
        PG8_STAGE(PG8_SB(0, 0), cB, voffB); PG8_STAGE(PG8_SB(0, 1), cB + hstepB, voffB); PG8_STAGE(PG8_SA(0, 0), cA, voffA); PG8_STAGE(PG8_SA(0, 1), cA + hstepA, voffA);
        if (wr == 1) PG8_BAR;
        PG8_WAIT_V(2); PG8_BAR;
        PG8_STAGE(PG8_SB(1, 0), cB + kstep, voffB); PG8_STAGE(PG8_SA(1, 0), cA + kstep, voffA); PG8_STAGE(PG8_SB(1, 1), cB + hstepB + kstep, voffB);
        PG8_WAIT_V(6); PG8_BAR;
    } else {
        PG8_STAGE(PG8_SB(0, 0), cB, voffB); PG8_STAGE(PG8_SA(0, 0), cA, voffA); PG8_STAGE(PG8_SB(0, 1), cB + hstepB, voffB); PG8_STAGE(PG8_SA(0, 1), cA + hstepA, voffA);
        if (wr == 1) PG8_BAR;
        PG8_WAIT_V(4); PG8_BAR;
        PG8_STAGE(PG8_SB(1, 0), cB + kstep, voffB); PG8_STAGE(PG8_SA(1, 0), cA + kstep, voffA); PG8_STAGE(PG8_SB(1, 1), cB + hstepB + kstep, voffB);
        PG8_WAIT_V(6); PG8_BAR;
    }
    for (;;) {
        const bool has_next = S.next(ui + 1, nxt);
        const char* nA = has_next ? (const char*)g.A + (size_t)nxt.pm * tstepA + nxt.koff : cA; const char* nB = has_next ? (const char*)g.Bt + (size_t)nxt.pn * tstepB + nxt.koff : cB;
        for (int t = 0; t < nt; t += 2) {
            if constexpr (Epi::KSEG > 0) { if (t == Epi::KSEG || t == 2 * Epi::KSEG) E.kseg(acc, cur, t, wr, fr); }
            if constexpr (Epi::PRE) { if (t == nt - 2) E.preload(cur, wr, fr, pre); }
            const bool last = (t == nt - 2);
            const char* a1 = cA + (size_t)(t + 1) * kstep;
            const char* a2 = last ? nA : cA + (size_t)(t + 2) * kstep; const char* b2 = last ? nB : cB + (size_t)(t + 2) * kstep;
            const char* a3 = a2 + kstep; const char* b3 = b2 + kstep;
            if (last && has_next) S.a_ready(nxt);
            if constexpr (SP2) {
            PG8_LDB(B0, 0, 0); PG8_LDB(B1, 0, 1); PG8_SCHED; PG8_LDA(At, 0, 0); PG8_STAGE(PG8_SA(1, 1), a1 + hstepA, voffA);
            PG8_WAIT_V(8); PG8_WAIT_L(0); PG8_BAR; PG8_MMA(0, 0, At, B0); PG8_MMA(0, 1, At, B1); PG8_BAR; PG8_SCHED;
            PG8_LDA(At, 0, 1); PG8_STAGE(PG8_SB(0, 0), b2, voffB); PG8_STAGE(PG8_SB(0, 1), b2 + hstepB, voffB); PG8_STAGE(PG8_SA(0, 0), a2, voffA);
            PG8_WAIT_V(8); PG8_WAIT_L(0); PG8_BAR; PG8_MMA(1, 0, At, B0); PG8_MMA(1, 1, At, B1); PG8_BAR; PG8_SCHED;
            PG8_LDB(B0, 1, 0); PG8_LDB(B1, 1, 1); PG8_SCHED; PG8_LDA(At, 1, 0); PG8_STAGE(PG8_SA(0, 1), a2 + hstepA, voffA);
            PG8_WAIT_V(8); PG8_WAIT_L(0); PG8_BAR; PG8_MMA(0, 0, At, B0); PG8_MMA(0, 1, At, B1); PG8_BAR; PG8_SCHED;
            PG8_LDA(At, 1, 1); PG8_STAGE(PG8_SB(1, 0), b3, voffB); PG8_STAGE(PG8_SB(1, 1), b3 + hstepB, voffB); PG8_STAGE(PG8_SA(1, 0), a3, voffA);
            PG8_WAIT_V(8); PG8_WAIT_L(0); PG8_BAR; PG8_MMA(1, 0, At, B0); PG8_MMA(1, 1, At, B1); PG8_BAR; PG8_SCHED;
            } else {
            PG8_LDB(B0, 0, 0); PG8_SCHED; PG8_LDA(At, 0, 0); PG8_STAGE(PG8_SA(1, 1), a1 + hstepA, voffA);
            PG8_WAIT_L(8); PG8_BAR; PG8_WAIT_L(0); PG8_MMA(0, 0, At, B0); PG8_BAR; PG8_SCHED;
            PG8_LDB(B1, 0, 1); PG8_STAGE(PG8_SB(0, 0), b2, voffB);
            PG8_BAR; PG8_WAIT_L(0); PG8_MMA(0, 1, At, B1); PG8_BAR;
            PG8_LDA(At, 0, 1); PG8_STAGE(PG8_SA(0, 0), a2, voffA);
            PG8_BAR; PG8_WAIT_L(0); PG8_MMA(1, 0, At, B0); PG8_BAR; PG8_SCHED;
            PG8_STAGE(PG8_SB(0, 1), b2 + hstepB, voffB);
            PG8_WAIT_V(6); PG8_BAR; PG8_MMA(1, 1, At, B1); PG8_BAR;
            PG8_LDB(B0, 1, 0); PG8_SCHED; PG8_LDA(At, 1, 0); PG8_STAGE(PG8_SA(0, 1), a2 + hstepA, voffA);
            PG8_WAIT_L(8); PG8_BAR; PG8_WAIT_L(0); PG8_MMA(0, 0, At, B0); PG8_BAR; PG8_SCHED;
            PG8_LDB(B1, 1, 1); PG8_STAGE(PG8_SB(1, 0), b3, voffB);
            PG8_BAR; PG8_WAIT_L(0); PG8_MMA(0, 1, At, B1); PG8_BAR;
            PG8_LDA(At, 1, 1); PG8_STAGE(PG8_SA(1, 0), a3, voffA);
            PG8_BAR; PG8_WAIT_L(0); PG8_MMA(1, 0, At, B0); PG8_BAR; PG8_SCHED;
            PG8_STAGE(PG8_SB(1, 1), b3 + hstepB, voffB);
            PG8_WAIT_V(6); PG8_BAR; PG8_MMA(1, 1, At, B1); PG8_BAR;
            }
        }
        if constexpr (ALIGN_EPI) { if (wr == 0) PG8_BAR; }
        if constexpr (!Epi::AFTER_DRAIN) { if constexpr (Epi::PRE) E(acc, cur, wr, wc, fr, fq, pre); else E(acc, cur, wr, wc, fr, fq); S.done(cur); }
        if (!has_next) break;
#pragma unroll
        for (int a = 0; a < 2; ++a)
#pragma unroll
            for (int b = 0; b < 2; ++b)
#pragma unroll
                for (int m = 0; m < 4; ++m)
#pragma unroll
                    for (int n = 0; n < 2; ++n) acc[a][b][m][n] = (f32x4){0.f, 0.f, 0.f, 0.f};
        cur = nxt; cA = nA; cB = nB; ++ui;
        if constexpr (ALIGN_EPI) { if (wr == 1) PG8_BAR; }
    }
    PG8_WAIT_V(0);
    if constexpr (!ALIGN_EPI) { if (wr == 0) PG8_BAR; }
    PG8_BAR;
    if constexpr (Epi::AFTER_DRAIN) { E.fused(acc, cur, wr, wc, fr, fq, lds, wid, lane); S.done(cur); }
#undef PG8_SA
#undef PG8_SB
#undef PG8_STAGE
#undef PG8_LDA
#undef PG8_LDB
#undef PG8_MMA
#undef PG8_WAIT_V
#undef PG8_WAIT_L
#undef PG8_BAR
#undef PG8_SCHED
}
}

#define GAS __attribute__((address_space(1)))
#define LAS __attribute__((address_space(3)))
typedef unsigned short bf16;
typedef unsigned v4u __attribute__((ext_vector_type(4)));
typedef unsigned v2u __attribute__((ext_vector_type(2)));
typedef float f32x4 __attribute__((ext_vector_type(4)));
typedef GAS unsigned gu32;
#define RLX_AGENT __ATOMIC_RELAXED, __HIP_MEMORY_SCOPE_AGENT
#define LDS_WAIT() asm volatile("s_waitcnt lgkmcnt(0)" ::: "memory")
#define VM_WAIT() asm volatile("s_waitcnt vmcnt(0)" ::: "memory")
#define LBAR() do { asm volatile("s_waitcnt lgkmcnt(0)" ::: "memory"); __builtin_amdgcn_s_barrier(); asm volatile("" ::: "memory"); } while (0)

constexpr int DM = 1024, NB = 32, SEQ = 2048, TP = NB * SEQ, TS = 128, MROWS = TP + TS, MT = 65792;
constexpr int DATT = 512, DINNER = 1024, DXBC = 1536, DMIX = 1536, DFF = 2816, NIN = 4112, NINP = 4352, NHA = 8, NHB = 16, NMEM = 256;
constexpr float EPS = 1e-6f;
constexpr size_t O_YP = 0, O_YS = 67108864, O_WKP = 67239936, O_WVP = 100794368, O_CVP = 134348800, O_SSP = 134496256, O_MKP = 138690560, O_MVP = 147079168,
                 O_WKS = 155467776, O_WVS = 155533312, O_CVS = 155598848, O_SSS = 156188672, O_END = 172965888;
constexpr size_t MiB = 1u << 20;
constexpr size_t WS_CTL = 0, CTL_ZERO_BYTES = 4 * MiB;
constexpr size_t WS_RQ1 = 1 * MiB, WS_RQ2 = WS_RQ1 + 512 * 1024, WS_RQ3 = 2 * MiB, WS_RQ4 = WS_RQ3 + 512 * 1024, WS_SSQ = 3 * MiB;
constexpr size_t WS_RQ0 = 4 * MiB, WS_RMEM = WS_RQ0 + 512 * 1024, WS_RS2 = 5 * MiB;
constexpr size_t WS_W1GU = 8 * MiB, WS_W1D = 19 * MiB, WS_WIN = 25 * MiB, WS_WOUT = 34 * MiB, WS_WCQ = 37 * MiB, WS_WCO = 39 * MiB, WS_WMEM = 41 * MiB, WS_W2GU = 45 * MiB, WS_W2D = 56 * MiB;
constexpr size_t WS_XB = 64 * MiB, WS_U = 193 * MiB, WS_QB = 547 * MiB, WS_KB = 612 * MiB, WS_VB = 677 * MiB, WS_ZG = 742 * MiB, WS_XBC = 871 * MiB, WS_DTB = 1064 * MiB,
                 WS_MIX = 1069 * MiB, WS_QC = 1262 * MiB, WS_OC = 1391 * MiB, WS_MEMB = 1520 * MiB, WS_MKB = 1536 * MiB, WS_MVB = 1552 * MiB, WS_SLAB = 1568 * MiB, WS_END = 1584 * MiB;
constexpr int CW_BAR = 4096, CW_TICK = 16384, TICK_WORDS = 22 * 8 * 16;
constexpr int RING_OFF = 0, RING_BYTES = 131072, LDS_BYTES = 147456, LDSCTL_OFF = LDS_BYTES - 512, MISC_OFF = LDSCTL_OFF + 320;
constexpr int NWAVES = 8;
#ifndef MK_SPLIT
#define MK_SPLIT 0
#endif
constexpr int NPHASE = 13;

__device__ __forceinline__ float bf2f(unsigned b) { return __uint_as_float(b << 16); }
__device__ __forceinline__ unsigned f2bf(float f) { unsigned u = __float_as_uint(f); return (u + 0x7fffu + ((u >> 16) & 1u)) >> 16; }
__device__ __forceinline__ unsigned pk2(float lo, float hi) { return f2bf(lo) | (f2bf(hi) << 16); }
__device__ __forceinline__ float silu_f(float x) { return x * __builtin_amdgcn_rcpf(1.f + __expf(-x)); }
__device__ __forceinline__ float wave_sum(float v) {
#pragma unroll
    for (int o = 1; o < 64; o <<= 1) v += __shfl_xor(v, o);
    return v;
}
__device__ __forceinline__ float wave_max(float v) {
#pragma unroll
    for (int o = 1; o < 64; o <<= 1) v = fmaxf(v, __shfl_xor(v, o));
    return v;
}
__device__ __forceinline__ float rdlane(float v, int l) { return __int_as_float(__builtin_amdgcn_readlane(__float_as_int(v), l)); }
__device__ __forceinline__ void unpack8(const v4u w, float* f) {
    f[0] = __uint_as_float(w.x << 16); f[1] = __uint_as_float(w.x & 0xffff0000u); f[2] = __uint_as_float(w.y << 16); f[3] = __uint_as_float(w.y & 0xffff0000u);
    f[4] = __uint_as_float(w.z << 16); f[5] = __uint_as_float(w.z & 0xffff0000u); f[6] = __uint_as_float(w.w << 16); f[7] = __uint_as_float(w.w & 0xffff0000u);
}

namespace pg8 {
struct EpiGateUp {
    static constexpr bool PERM = true, AFTER_DRAIN = false; static constexpr int KSEG = 0; static constexpr bool PRE = true;
    bf16_t* U; const float* rq;
    __device__ __forceinline__ void preload(const Unit& u, int wr, int fr, float (&pre)[8]) const {
        const int row0 = u.pm * BM + wr * 64 + fr;
#pragma unroll
        for (int ai = 0; ai < 2; ++ai)
#pragma unroll
            for (int m = 0; m < 4; ++m) pre[ai * 4 + m] = rq[row0 + ai * HALF + m * 16];
    }
    __device__ __forceinline__ void operator()(const f32x4 (&acc)[2][2][4][2], const Unit& u, int wr, int wc, int fr, int fq, const float (&pre)[8]) const {
        const int row0 = u.pm * BM + wr * 64 + fr, col0 = u.pn * 128 + wc * 32 + 8 * fq;
#pragma unroll
        for (int ai = 0; ai < 2; ++ai)
#pragma unroll
            for (int m = 0; m < 4; ++m) {
                const int row = row0 + ai * HALF + m * 16; const float rs = rsqrtf(pre[ai * 4 + m] * (1.f / 1024.f) + 1e-6f);
                f32x2 o[4];
#pragma unroll
                for (int n = 0; n < 2; ++n)
#pragma unroll
                    for (int jp = 0; jp < 2; ++jp) { const f32x2 ga = {acc[ai][0][m][n][2 * jp], acc[ai][0][m][n][2 * jp + 1]}, ua = {acc[ai][1][m][n][2 * jp], acc[ai][1][m][n][2 * jp + 1]};
                        const f32x2 g = ga * rs, t = ga * (rs * -1.44269504f), uu = ua * rs;
                        f32x2 e; e.x = __builtin_amdgcn_exp2f(t.x); e.y = __builtin_amdgcn_exp2f(t.y);
                        const f32x2 d = e + 1.0f; f32x2 r; r.x = __builtin_amdgcn_rcpf(d.x); r.y = __builtin_amdgcn_rcpf(d.y);
                        o[2 * n + jp] = (g * r) * uu; }
                u32x4 w; w.x = cvt_pk_bf16(o[0].x, o[0].y); w.y = cvt_pk_bf16(o[1].x, o[1].y); w.z = cvt_pk_bf16(o[2].x, o[2].y); w.w = cvt_pk_bf16(o[3].x, o[3].y);
                *(u32x4*)(U + (size_t)row * 2816 + col0) = w; }
    }
};
struct EpiResid {
    static constexpr bool PERM = true, AFTER_DRAIN = false; static constexpr int KSEG = 0; static constexpr bool PRE = false;
    bf16_t* X; float alpha; float* rq; float* yp; float* ys;
    __device__ __forceinline__ void operator()(const f32x4 (&acc)[2][2][4][2], const Unit& u, int wr, int wc, int fr, int fq) const {
        const int row0 = u.pm * BM + wr * 64 + fr, col0 = u.pn * BM + wc * 32 + 8 * fq;
#pragma unroll
        for (int ai = 0; ai < 2; ++ai)
#pragma unroll
            for (int m = 0; m < 4; ++m) {
                const int row = row0 + ai * HALF + m * 16; float ss = 0.f;
#pragma unroll
                for (int bj = 0; bj < 2; ++bj) {
                    const int col = col0 + bj * HALF; bf16_t* xp = X + (size_t)row * 1024 + col;
                    const u32x4 ow = *(const u32x4*)xp; float v[8];
                    { f32x2 p0 = {__uint_as_float(ow.x << 16), __uint_as_float(ow.x & 0xffff0000u)}, p1 = {__uint_as_float(ow.y << 16), __uint_as_float(ow.y & 0xffff0000u)},
                            p2 = {__uint_as_float(ow.z << 16), __uint_as_float(ow.z & 0xffff0000u)}, p3 = {__uint_as_float(ow.w << 16), __uint_as_float(ow.w & 0xffff0000u)};
                      const f32x4 a0 = acc[ai][bj][m][0], a1 = acc[ai][bj][m][1];
                      p0 = p0 + (f32x2){a0[0], a0[1]} * alpha; p1 = p1 + (f32x2){a0[2], a0[3]} * alpha; p2 = p2 + (f32x2){a1[0], a1[1]} * alpha; p3 = p3 + (f32x2){a1[2], a1[3]} * alpha;
                      const f32x2 q = (p0 * p0 + p1 * p1) + (p2 * p2 + p3 * p3); ss += q.x + q.y;
                      v[0] = p0.x; v[1] = p0.y; v[2] = p1.x; v[3] = p1.y; v[4] = p2.x; v[5] = p2.y; v[6] = p3.x; v[7] = p3.y; }
                    if (yp) {
                        float* dst = row < 65536 ? yp + (size_t)row * 1024 + col : (row < 65664 ? ys + (size_t)(row - 65536) * 1024 + col : nullptr);
                        if (dst) { *(f32x4*)dst = (f32x4){v[0], v[1], v[2], v[3]}; *(f32x4*)(dst + 4) = (f32x4){v[4], v[5], v[6], v[7]}; }
                    } else {
                        u32x4 w; w.x = cvt_pk_bf16(v[0], v[1]); w.y = cvt_pk_bf16(v[2], v[3]); w.z = cvt_pk_bf16(v[4], v[5]); w.w = cvt_pk_bf16(v[6], v[7]);
                        *(u32x4*)xp = w; }
                }
                ss += __shfl_xor(ss, 16); ss += __shfl_xor(ss, 32);
                if (fq == 0) unsafeAtomicAdd(rq + row, ss);
            }
    }
};

struct EpiResidKS {
    static constexpr bool PERM = true, AFTER_DRAIN = false; static constexpr int KSEG = 8; static constexpr bool PRE = false;
    bf16_t* X; float* rq; const float* rs2;
    __device__ __forceinline__ void kseg(f32x4 (&acc)[2][2][4][2], const Unit& u, int t, int wr, int fr) const {
        const int row0 = u.pm * BM + wr * 64 + fr;
#pragma unroll
        for (int ai = 0; ai < 2; ++ai)
#pragma unroll
            for (int m = 0; m < 4; ++m) { const int row = row0 + ai * HALF + m * 16; const f32x2 sv = *(const f32x2*)(rs2 + 2 * row);
                const float f = (t == KSEG) ? __builtin_amdgcn_rcpf(sv.x) : sv.x * __builtin_amdgcn_rcpf(sv.y);
#pragma unroll
                for (int bj = 0; bj < 2; ++bj)
#pragma unroll
                    for (int n = 0; n < 2; ++n) acc[ai][bj][m][n] = acc[ai][bj][m][n] * f; }
    }
    __device__ __forceinline__ void operator()(const f32x4 (&acc)[2][2][4][2], const Unit& u, int wr, int wc, int fr, int fq) const {
        const int row0 = u.pm * BM + wr * 64 + fr, col0 = u.pn * BM + wc * 32 + 8 * fq;
#pragma unroll
        for (int ai = 0; ai < 2; ++ai)
#pragma unroll
            for (int m = 0; m < 4; ++m) {
                const int row = row0 + ai * HALF + m * 16; float ss = 0.f; const float alpha = rs2[2 * (size_t)row + 1];
#pragma unroll
                for (int bj = 0; bj < 2; ++bj) {
                    const int col = col0 + bj * HALF; bf16_t* xp = X + (size_t)row * 1024 + col;
                    const u32x4 ow = *(const u32x4*)xp; float v[8];
                    { f32x2 p0 = {__uint_as_float(ow.x << 16), __uint_as_float(ow.x & 0xffff0000u)}, p1 = {__uint_as_float(ow.y << 16), __uint_as_float(ow.y & 0xffff0000u)},
                            p2 = {__uint_as_float(ow.z << 16), __uint_as_float(ow.z & 0xffff0000u)}, p3 = {__uint_as_float(ow.w << 16), __uint_as_float(ow.w & 0xffff0000u)};
                      const f32x4 a0 = acc[ai][bj][m][0], a1 = acc[ai][bj][m][1];
                      p0 = p0 + (f32x2){a0[0], a0[1]} * alpha; p1 = p1 + (f32x2){a0[2], a0[3]} * alpha; p2 = p2 + (f32x2){a1[0], a1[1]} * alpha; p3 = p3 + (f32x2){a1[2], a1[3]} * alpha;
                      const f32x2 q = (p0 * p0 + p1 * p1) + (p2 * p2 + p3 * p3); ss += q.x + q.y;
                      v[0] = p0.x; v[1] = p0.y; v[2] = p1.x; v[3] = p1.y; v[4] = p2.x; v[5] = p2.y; v[6] = p3.x; v[7] = p3.y; }
                    u32x4 w; w.x = cvt_pk_bf16(v[0], v[1]); w.y = cvt_pk_bf16(v[2], v[3]); w.z = cvt_pk_bf16(v[4], v[5]); w.w = cvt_pk_bf16(v[6], v[7]);
                    *(u32x4*)xp = w;
                }
                ss += __shfl_xor(ss, 16); ss += __shfl_xor(ss, 32);
                if (fq == 0) unsafeAtomicAdd(rq + row, ss);
            }
    }
};
struct EpiScale {
    static constexpr bool PERM = true, AFTER_DRAIN = false; static constexpr int KSEG = 0; static constexpr bool PRE = false;
    bf16_t* O; int ldc; const float* rq; float scale;
    __device__ __forceinline__ void operator()(const f32x4 (&acc)[2][2][4][2], const Unit& u, int wr, int wc, int fr, int fq) const {
        const int row0 = u.pm * BM + wr * 64 + fr, col0 = u.pn * BM + wc * 32 + 8 * fq;
#pragma unroll
        for (int ai = 0; ai < 2; ++ai)
#pragma unroll
            for (int m = 0; m < 4; ++m) {
                const int row = row0 + ai * HALF + m * 16; const float rs = rsqrtf(rq[row] * (1.f / 1024.f) + 1e-6f) * scale;
#pragma unroll
                for (int bj = 0; bj < 2; ++bj) { const f32x4 v0 = acc[ai][bj][m][0] * rs, v1 = acc[ai][bj][m][1] * rs;
                    u32x4 w; w.x = cvt_pk_bf16(v0[0], v0[1]); w.y = cvt_pk_bf16(v0[2], v0[3]); w.z = cvt_pk_bf16(v1[0], v1[1]); w.w = cvt_pk_bf16(v1[2], v1[3]);
                    *(u32x4*)(O + (size_t)row * ldc + col0 + bj * HALF) = w; } }
    }
};
struct EpiMemKV {
    static constexpr bool PERM = true, AFTER_DRAIN = false; static constexpr int KSEG = 0; static constexpr bool PRE = false;
    const float* rmem; float* mkp; float* mvp; bf16_t* mkb; bf16_t* mvb;
    __device__ __forceinline__ void operator()(const f32x4 (&acc)[2][2][4][2], const Unit& u, int wr, int wc, int fr, int fq) const {
        const int row0 = u.pm * BM + wr * 64 + fr; const bool isv = u.pn >= 4; const int col0 = (u.pn & 3) * BM + wc * 32 + 8 * fq;
        float* of = isv ? mvp : mkp; bf16_t* ob = isv ? mvb : mkb;
#pragma unroll
        for (int ai = 0; ai < 2; ++ai)
#pragma unroll
            for (int m = 0; m < 4; ++m) {
                const int row = row0 + ai * HALF + m * 16; const float rs = rmem[row];
#pragma unroll
                for (int bj = 0; bj < 2; ++bj) { const f32x4 v0 = acc[ai][bj][m][0] * rs, v1 = acc[ai][bj][m][1] * rs; const size_t o = (size_t)row * 1024 + col0 + bj * HALF;
                    *(f32x4*)(of + o) = v0; *(f32x4*)(of + o + 4) = v1;
                    u32x4 w; w.x = cvt_pk_bf16(v0[0], v0[1]); w.y = cvt_pk_bf16(v0[2], v0[3]); w.z = cvt_pk_bf16(v1[0], v1[1]); w.w = cvt_pk_bf16(v1[2], v1[3]);
                    *(u32x4*)(ob + o) = w; } }
    }
};
struct EpiInProj {
    static constexpr bool PERM = true, AFTER_DRAIN = false; static constexpr int KSEG = 0; static constexpr bool PRE = false;
    const float* rq; bf16_t* qb; bf16_t* kb; bf16_t* vb; bf16_t* zg; bf16_t* xbc; float* dtb; const float* dt_bias;
    float* wkp; float* wvp; float* cvp; float* wks; float* wvs; float* cvs;
    __device__ __forceinline__ void operator()(const f32x4 (&acc)[2][2][4][2], const Unit& u, int wr, int wc, int fr, int fq) const {
        const int row0 = u.pm * BM + wr * 64 + fr, c0 = wc * 32 + 8 * fq, pn = u.pn;
#pragma unroll
        for (int ai = 0; ai < 2; ++ai)
#pragma unroll
            for (int m = 0; m < 4; ++m) {
                const int row = row0 + ai * HALF + m * 16; const float rs = rsqrtf(rq[row] * (1.f / 1024.f) + 1e-6f);
#pragma unroll
                for (int bj = 0; bj < 2; ++bj) {
                    const int c8 = c0 + bj * HALF; f32x4 v0 = acc[ai][bj][m][0] * rs, v1 = acc[ai][bj][m][1] * rs;
                    if (pn < 2) {
                        v0 = v0 * 0.180336880f; v1 = v1 * 0.180336880f;
                        u32x4 w; w.x = cvt_pk_bf16(v0[0], v0[1]); w.y = cvt_pk_bf16(v0[2], v0[3]); w.z = cvt_pk_bf16(v1[0], v1[1]); w.w = cvt_pk_bf16(v1[2], v1[3]);
                        *(u32x4*)(qb + (size_t)row * 512 + pn * 256 + c8) = w;
                    } else if (pn < 6) {
                        const bool isv = pn >= 4; const int col = (pn & 1) * 256 + c8;
                        u32x4 w; w.x = cvt_pk_bf16(v0[0], v0[1]); w.y = cvt_pk_bf16(v0[2], v0[3]); w.z = cvt_pk_bf16(v1[0], v1[1]); w.w = cvt_pk_bf16(v1[2], v1[3]);
                        *(u32x4*)((isv ? vb : kb) + (size_t)row * 512 + col) = w;
                        float* dst = row < 65536 ? (isv ? wvp : wkp) + (size_t)row * 512 + col : (row < 65664 ? (isv ? wvs : wks) + (size_t)(row - 65536) * 512 + col : nullptr);
                        if (dst) { *(f32x4*)dst = v0; *(f32x4*)(dst + 4) = v1; }
                    } else if (pn < 10) {
                        float o[8];
#pragma unroll
                        for (int j = 0; j < 4; ++j) { o[j] = v0[j] * __builtin_amdgcn_rcpf(1.f + __expf(-v0[j])); o[4 + j] = v1[j] * __builtin_amdgcn_rcpf(1.f + __expf(-v1[j])); }
                        u32x4 w; w.x = cvt_pk_bf16(o[0], o[1]); w.y = cvt_pk_bf16(o[2], o[3]); w.z = cvt_pk_bf16(o[4], o[5]); w.w = cvt_pk_bf16(o[6], o[7]);
                        *(u32x4*)(zg + (size_t)row * 1024 + (pn - 6) * 256 + c8) = w;
                    } else if (pn < 16) {
                        const int col = (pn - 10) * 256 + c8;
                        u32x4 w; w.x = cvt_pk_bf16(v0[0], v0[1]); w.y = cvt_pk_bf16(v0[2], v0[3]); w.z = cvt_pk_bf16(v1[0], v1[1]); w.w = cvt_pk_bf16(v1[2], v1[3]);
                        *(u32x4*)(xbc + (size_t)row * 1536 + col) = w;
                        float* dst = nullptr;
                        if (row < 65536) { const int t = row & 2047; if (t >= 2045) dst = cvp + ((size_t)(row >> 11) * 3 + (t - 2045)) * 1536 + col; }
                        else if (row < 65664) dst = cvs + ((size_t)(row - 65536) * 3 + 2) * 1536 + col;
                        if (dst) { *(f32x4*)dst = v0; *(f32x4*)(dst + 4) = v1; }
                    } else {
                        if (c8 < 16) {
                            float o[8];
#pragma unroll
                            for (int j = 0; j < 8; ++j) { const float x = (j < 4 ? v0[j & 3] : v1[j & 3]) + dt_bias[c8 + j]; o[j] = fmaxf(x, 0.f) + log1pf(__expf(-fabsf(x))); }
                            float* dst = dtb + (size_t)row * 16 + c8; *(f32x4*)dst = (f32x4){o[0], o[1], o[2], o[3]}; *(f32x4*)(dst + 4) = (f32x4){o[4], o[5], o[6], o[7]};
                        }
                    }
                }
            }
    }
};

struct SplitOrder {
    int nN, KS, G, c, kbytes;
    __host__ __device__ void init(int N, int KS_, int kper, int G_, int c_) { nN = N / BM; KS = KS_; G = G_; c = c_; kbytes = kper * 2; }
    __host__ __device__ bool next(int i, Unit& u) const { const int L = i * G + c; if (L >= nN * KS) return false; u.pm = 256; u.pn = L % nN; u.ks = L / nN; u.koff = u.ks * kbytes; return true; }
    __device__ __forceinline__ void a_ready(const Unit&) const {}
    __device__ __forceinline__ void done(const Unit&) const {}
};
template <class Inner> struct EpiSplit {
    static constexpr bool PERM = Inner::PERM, AFTER_DRAIN = false; static constexpr int KSEG = 0; static constexpr bool PRE = false;
    Inner in; float* slab; unsigned* tick; int KS;
    __device__ __forceinline__ void operator()(f32x4 (&acc)[2][2][4][2], const Unit& u, int wr, int wc, int fr, int fq) const {
        const int wave = wr * 4 + wc, lane = fr + 16 * fq;
        const __amdgpu_buffer_rsrc_t rs = __builtin_amdgcn_make_buffer_rsrc((void*)slab, 0, 0x7fffffff, 0x00020000);
        const int base = (((u.pn * KS + u.ks) * 8 + wave) * 16) * 1024 + lane * 16;
#pragma unroll
        for (int bj = 0; bj < 2; ++bj)
#pragma unroll
            for (int m = 0; m < 4; ++m)
#pragma unroll
                for (int n = 0; n < 2; ++n) __builtin_amdgcn_raw_buffer_store_b128(__builtin_bit_cast(u32x4, acc[0][bj][m][n]), rs, base + ((bj * 4 + m) * 2 + n) * 1024, 0, 16);
        asm volatile("s_waitcnt vmcnt(0)" ::: "memory");
        unsigned old = 0u;
        if (lane == 0) old = __hip_atomic_fetch_add(tick + (u.pn * 8 + wave) * 16, 1u, __ATOMIC_RELAXED, __HIP_MEMORY_SCOPE_AGENT);
        old = (unsigned)__builtin_amdgcn_readfirstlane((int)old);
        if (old == (unsigned)(KS - 1)) {
            __builtin_amdgcn_fence(__ATOMIC_ACQUIRE, "agent");
            asm volatile("s_waitcnt vmcnt(0)" ::: "memory");
#pragma unroll 1
            for (int s2 = 0; s2 < KS; ++s2) { if (s2 == u.ks) continue;
                const int ob = (((u.pn * KS + s2) * 8 + wave) * 16) * 1024 + lane * 16;
#pragma unroll
                for (int bj = 0; bj < 2; ++bj)
#pragma unroll
                    for (int m = 0; m < 4; ++m)
#pragma unroll
                        for (int n = 0; n < 2; ++n) acc[0][bj][m][n] += __builtin_bit_cast(f32x4, __builtin_amdgcn_raw_buffer_load_b128(rs, ob + ((bj * 4 + m) * 2 + n) * 1024, 0, 16)); }
#pragma unroll
            for (int bj = 0; bj < 2; ++bj)
#pragma unroll
                for (int m = 0; m < 4; ++m)
#pragma unroll
                    for (int n = 0; n < 2; ++n) acc[1][bj][m][n] = (f32x4){0.f, 0.f, 0.f, 0.f};
            int fr2 = fr, fq2 = fq; asm volatile("" : "+v"(fr2), "+v"(fq2));
            if constexpr (Inner::PRE) { float pre[8]; in.preload(u, wr, fr2, pre); in(acc, u, wr, wc, fr2, fq2, pre); } else in(acc, u, wr, wc, fr2, fq2);
        }
    }
};
}
#define PG8_SP2 true
#define PG8_ALIGN true

#define XB_TMO      128
#define XB_XCNT(j)  (256  + 64 * (j))
#define XB_XSUB(j)  (1280 + 64 * (j))
#define XB_XGEN(j)  (2304 + 64 * (j))
#define XB_TOP      3328
#define XB_TOPGEN   3392
#define XCD_BAR_WORDS 3456
#define XB_SPIN_CAP (1u << 18)

__device__ __forceinline__ unsigned xb_ld(unsigned* p)              { return __hip_atomic_load(p, __ATOMIC_RELAXED, __HIP_MEMORY_SCOPE_AGENT); }
__device__ __forceinline__ unsigned xb_add(unsigned* p, unsigned v) { return __hip_atomic_fetch_add(p, v, __ATOMIC_RELAXED, __HIP_MEMORY_SCOPE_AGENT); }
__device__ __forceinline__ unsigned xb_xcc_id() { return (unsigned)__builtin_amdgcn_s_getreg((3 << 11) | 20) & 0xFu; }
#define XB_SPIN(cond, bar) do { unsigned _sp = 0; while (cond) { __builtin_amdgcn_s_sleep(1); \
    if ((++_sp & 255u) == 0u) { if (xb_ld(&(bar)[XB_TMO])) break; if (_sp > XB_SPIN_CAP) { atomicAdd(&(bar)[XB_TMO], 1u); break; } } } } while (0)

struct XcdBarrier {
    unsigned* bar; unsigned x;
    volatile LAS unsigned* st;
};

__device__ __forceinline__ XcdBarrier xcd_barrier_post(unsigned* bar, volatile LAS unsigned* st, const bool leader) {
    XcdBarrier b; b.bar = bar; b.x = xb_xcc_id(); b.st = st;
    if (leader) (void)xb_add(&bar[XB_XCNT(b.x)], 1u);
    return b;
}
__device__ __forceinline__ void xcd_barrier_complete(unsigned* bar, unsigned x, unsigned& nloc, unsigned& nx) {
    const unsigned G = gridDim.x * gridDim.y * gridDim.z;
    unsigned sum, cnt, mine, sp = 0u;
    for (;;) {
        sum = 0u; cnt = 0u; mine = 0u;
#pragma unroll
        for (unsigned j = 0; j < 16; ++j) { const unsigned c = xb_ld(&bar[XB_XCNT(j)]); sum += c; cnt += (c > 0u) ? 1u : 0u; mine = (j == x) ? c : mine; }
        if (sum == G) break;
        __builtin_amdgcn_s_sleep(1);
        if ((++sp & 255u) == 0u) { if (xb_ld(&bar[XB_TMO])) break; if (sp > XB_SPIN_CAP) { atomicAdd(&bar[XB_TMO], 1u); break; } }
    }
    nloc = mine > 0u ? mine : 1u; nx = cnt > 0u ? cnt : 1u;
}

__device__ __forceinline__ void xcd_barrier(const XcdBarrier& b, const bool leader) {
    asm volatile("s_waitcnt vmcnt(0)" ::: "memory");
    __syncthreads();
    if (leader) {
        unsigned* bar = b.bar;
        __builtin_amdgcn_s_waitcnt(0);
        unsigned nloc = b.st[0], nx = b.st[1];
        if (nloc == 0u) { xcd_barrier_complete(bar, b.x, nloc, nx); b.st[0] = nloc; b.st[1] = nx; }
        const unsigned old = xb_add(&bar[XB_XSUB(b.x)], 1u);
        const unsigned gen = old / nloc;
        if (old + 1u == (gen + 1u) * nloc) {
            __builtin_amdgcn_fence(__ATOMIC_RELEASE, "agent");
            asm volatile("s_waitcnt vmcnt(0)" ::: "memory");
            const unsigned og = xb_add(&bar[XB_TOP], 1u);
            const unsigned tg = og / nx;
            if (og + 1u == (tg + 1u) * nx) xb_add(&bar[XB_TOPGEN], 1u);
            else XB_SPIN(xb_ld(&bar[XB_TOPGEN]) == tg, bar);
            __builtin_amdgcn_fence(__ATOMIC_ACQUIRE, "agent");
            xb_add(&bar[XB_XGEN(b.x)], 1u);
            asm volatile("s_waitcnt vmcnt(0)" ::: "memory");
        } else {
            XB_SPIN(xb_ld(&bar[XB_XGEN(b.x)]) == gen, bar);
            __builtin_amdgcn_fence(__ATOMIC_ACQUIRE, "agent");
            asm volatile("s_waitcnt vmcnt(0)" ::: "memory");
        }
    }
    __syncthreads();
}

struct Args { const float* in[34]; float* out; unsigned char* ws; int ph_lo, ph_hi, li, pad; };
struct Frame {
    LAS unsigned char* lds; volatile LAS unsigned* MISC; gu32* ctl;
    int tid, lane, wave, vcu, G;
    float* out; unsigned char* ws;
};
#define WSP(T, off) ((T*)(F.ws + (off)))
__device__ __forceinline__ void refresh(Frame& F) { int l; asm volatile("v_mbcnt_lo_u32_b32 %0, -1, 0\n\tv_mbcnt_hi_u32_b32 %0, -1, %0" : "=v"(l)); F.lane = l; F.tid = F.wave * 64 + l; }

__device__ __forceinline__ void tr_item(const float* W, int ldsrc, int ncols, int k0, int n0, bf16* WT, int K, int drow0, const float* gain, int gofs, LAS float* scr, int lane) {
    const int c = lane & 7, rk = lane >> 3;
    const int nn = n0 + 4 * c; const bool okc = nn < ncols; const int nc = okc ? nn : 0;
    f32x4 v[8];
#pragma unroll
    for (int ib = 0; ib < 8; ++ib) v[ib] = *(const GAS f32x4*)(W + (size_t)(k0 + 8 * ib + rk) * ldsrc + nc);
    const int kg = k0 + 8 * c - gofs; const bool useg = gain != nullptr && kg >= 0;
    const float* gp = gain ? gain + max(kg, 0) : W; const f32x4 ga = *(const GAS f32x4*)gp, gb = *(const GAS f32x4*)(gp + 4);
#pragma unroll
    for (int ib = 0; ib < 8; ++ib) { LAS float* d = scr + (8 * ib + rk) * 33 + 4 * c; const f32x4 x = okc ? v[ib] : (f32x4){0.f, 0.f, 0.f, 0.f}; d[0] = x.x; d[1] = x.y; d[2] = x.z; d[3] = x.w; }
    LDS_WAIT(); asm volatile("" ::: "memory");
    const float g0 = useg ? ga.x : 1.f, g1 = useg ? ga.y : 1.f, g2 = useg ? ga.z : 1.f, g3 = useg ? ga.w : 1.f, g4 = useg ? gb.x : 1.f, g5 = useg ? gb.y : 1.f, g6 = useg ? gb.z : 1.f, g7 = useg ? gb.w : 1.f;
#pragma unroll
    for (int j = 0; j < 4; ++j) { const int n = (lane >> 3) + 8 * j; const LAS float* s = scr + (8 * c) * 33 + n;
        v4u o; o.x = pk2(s[0 * 33] * g0, s[1 * 33] * g1); o.y = pk2(s[2 * 33] * g2, s[3 * 33] * g3); o.z = pk2(s[4 * 33] * g4, s[5 * 33] * g5); o.w = pk2(s[6 * 33] * g6, s[7 * 33] * g7);
        *(GAS v4u*)(WT + (size_t)(drow0 + n) * K + k0 + 8 * c) = o; }
    LDS_WAIT(); asm volatile("" ::: "memory");
}
__device__ __forceinline__ bool tr_job(int& r, const float* W, int K, int N, bf16* WT, int mode, int roff, const float* gain, int gofs, LAS float* scr, int lane) {
    const int nblk = (N + 31) / 32, items = (K / 64) * nblk;
    if (r >= items) { r -= items; return false; }
    const int kb = r / nblk, nb = r % nblk, n0 = nb * 32;
    const int drow0 = roff + (mode == 0 ? n0 : 256 * (n0 >> 7) + 128 * (mode - 1) + (n0 & 127));
    tr_item(W, N, N, kb * 64, n0, WT, K, drow0, gain, gofs, scr, lane);
    return true;
}
__device__ __forceinline__ void p0_prologue(Frame& F, const Args& A) {
    LAS float* scr = (LAS float*)(F.lds + RING_OFF + F.wave * 16384);
    const int gw = F.vcu * NWAVES + F.wave, NGW = F.G * NWAVES, lane = F.lane;
    constexpr int I_GU = 16 * 88, I_D = 44 * 32, I_IN = 16 * 129, I_OUT = 24 * 32, I_SQ = 16 * 32;
    constexpr int NITEMS = 4 * I_GU + 2 * I_D + I_IN + I_OUT + 4 * I_SQ;
    for (int it = gw; it < NITEMS; it += NGW) {
        int r = it;
        if (tr_job(r, A.in[11], 1024, 2816, WSP(bf16, WS_W1GU), 1, 0, A.in[10], 0, scr, lane)) continue;
        if (tr_job(r, A.in[12], 1024, 2816, WSP(bf16, WS_W1GU), 2, 0, A.in[10], 0, scr, lane)) continue;
        if (tr_job(r, A.in[13], 2816, 1024, WSP(bf16, WS_W1D), 0, 0, nullptr, 0, scr, lane)) continue;
        if (tr_job(r, A.in[15], 1024, 4112, WSP(bf16, WS_WIN), 0, 0, A.in[14], 0, scr, lane)) continue;
        if (tr_job(r, A.in[22], 1536, 1024, WSP(bf16, WS_WOUT), 0, 0, A.in[21], 512, scr, lane)) continue;
        if (tr_job(r, A.in[27], 1024, 1024, WSP(bf16, WS_WCQ), 0, 0, A.in[26], 0, scr, lane)) continue;
        if (tr_job(r, A.in[28], 1024, 1024, WSP(bf16, WS_WCO), 0, 0, nullptr, 0, scr, lane)) continue;
        if (tr_job(r, A.in[24], 1024, 1024, WSP(bf16, WS_WMEM), 0, 0, A.in[23], 0, scr, lane)) continue;
        if (tr_job(r, A.in[25], 1024, 1024, WSP(bf16, WS_WMEM), 0, 1024, A.in[23], 0, scr, lane)) continue;
        if (tr_job(r, A.in[30], 1024, 2816, WSP(bf16, WS_W2GU), 1, 0, A.in[29], 0, scr, lane)) continue;
        if (tr_job(r, A.in[31], 1024, 2816, WSP(bf16, WS_W2GU), 2, 0, A.in[29], 0, scr, lane)) continue;
        tr_job(r, A.in[32], 2816, 1024, WSP(bf16, WS_W2D), 0, 0, nullptr, 0, scr, lane);
    }
    { GAS v4u* z = (GAS v4u*)(WSP(bf16, WS_WIN) + (size_t)4128 * 1024); const int n16 = (4352 - 4128) * 1024 / 8;
      for (int i = gw * 64 + lane; i < n16; i += NGW * 64) z[i] = (v4u){0u, 0u, 0u, 0u}; }
    for (int m0 = gw; m0 < MT; m0 += 4 * NGW) {
        f32x4 v[4][4];
#pragma unroll
        for (int q = 0; q < 4; ++q) { const int m = m0 + q * NGW, mc = min(m, MROWS - 1);
            const float* src = mc < TP ? A.in[0] + (size_t)mc * 1024 : A.in[1] + (size_t)(mc - TP) * 1024; const GAS f32x4* xr = (const GAS f32x4*)src + lane;
#pragma unroll
            for (int j = 0; j < 4; ++j) v[q][j] = xr[64 * j]; }
#pragma unroll
        for (int q = 0; q < 4; ++q) { const int m = m0 + q * NGW; const float keep = m < MROWS ? 1.f : 0.f;
            if (m < MT) { float sq = 0.f;
#pragma unroll
            for (int j = 0; j < 4; ++j) { v[q][j] = v[q][j] * keep; sq += (v[q][j].x * v[q][j].x + v[q][j].y * v[q][j].y) + (v[q][j].z * v[q][j].z + v[q][j].w * v[q][j].w); }
            sq = wave_sum(sq);
            if (lane == 0) WSP(float, WS_RQ0)[m] = sq;
            GAS v2u* o8 = (GAS v2u*)(WSP(bf16, WS_XB) + (size_t)m * 1024) + lane;
#pragma unroll
            for (int j = 0; j < 4; ++j) o8[64 * j] = (v2u){pk2(v[q][j].x, v[q][j].y), pk2(v[q][j].z, v[q][j].w)}; } }
    }
    for (int m0 = gw; m0 < NB * NMEM; m0 += 4 * NGW) {
        f32x4 v[4][4];
#pragma unroll
        for (int q = 0; q < 4; ++q) { const int mc = min(m0 + q * NGW, NB * NMEM - 1); const GAS f32x4* xr = (const GAS f32x4*)(A.in[8] + (size_t)mc * 1024) + lane;
#pragma unroll
            for (int j = 0; j < 4; ++j) v[q][j] = xr[64 * j]; }
#pragma unroll
        for (int q = 0; q < 4; ++q) { const int m = m0 + q * NGW; if (m < NB * NMEM) { float sq = 0.f;
#pragma unroll
            for (int j = 0; j < 4; ++j) sq += (v[q][j].x * v[q][j].x + v[q][j].y * v[q][j].y) + (v[q][j].z * v[q][j].z + v[q][j].w * v[q][j].w);
            sq = wave_sum(sq);
            if (lane == 0) WSP(float, WS_RMEM)[m] = rsqrtf(sq * (1.f / 1024.f) + EPS);
            GAS v2u* o8 = (GAS v2u*)(WSP(bf16, WS_MEMB) + (size_t)m * 1024) + lane;
#pragma unroll
            for (int j = 0; j < 4; ++j) o8[64 * j] = (v2u){pk2(v[q][j].x, v[q][j].y), pk2(v[q][j].z, v[q][j].w)}; } }
    }
    for (int i = gw * 64 + lane; i < TS * 2 * DXBC; i += NGW * 64) { const int b = i / (2 * DXBC), r = i % (2 * DXBC); F.out[O_CVS + (size_t)b * 3 * DXBC + r] = A.in[4][(size_t)b * 3 * DXBC + DXBC + r]; }
}

__device__ __forceinline__ int t5_bucket(int d) {
    if (d < 16) return d;
    int b = 16;
    b += d >= 22; b += d >= 30; b += d >= 40; b += d >= 54; b += d >= 73; b += d >= 99; b += d >= 134; b += d >= 182; b += d >= 246; b += d >= 332; b += d >= 450; b += d >= 609; b += d >= 825; b += d >= 1117; b += d >= 1513;
    return b;
}

typedef float f32x16 __attribute__((ext_vector_type(16)));
typedef short s16x4 __attribute__((ext_vector_type(4)));
typedef short v4i16_t __attribute__((ext_vector_type(4)));
typedef float f32x2_t __attribute__((ext_vector_type(2)));
typedef __bf16 bf16x2_t __attribute__((ext_vector_type(2)));
using pg8::bf16x8; using pg8::f32x2;
#define MFMA32(a, b, c) __builtin_amdgcn_mfma_f32_32x32x16_bf16((a), (b), (c), 0, 0, 0)
__device__ __forceinline__ unsigned cvtpk(float lo, float hi) { f32x2_t v = {lo, hi}; bf16x2_t b = __builtin_convertvector(v, bf16x2_t); return __builtin_bit_cast(unsigned, b); }
__device__ __forceinline__ bf16x8 pack8(float a0, float a1, float a2, float a3, float a4, float a5, float a6, float a7) { v4u w; w.x = cvtpk(a0, a1); w.y = cvtpk(a2, a3); w.z = cvtpk(a4, a5); w.w = cvtpk(a6, a7); return __builtin_bit_cast(bf16x8, w); }
#define PACK_STEP(x, s) pack8((x)[8 * (s)], (x)[8 * (s) + 1], (x)[8 * (s) + 2], (x)[8 * (s) + 3], (x)[8 * (s) + 4], (x)[8 * (s) + 5], (x)[8 * (s) + 6], (x)[8 * (s) + 7])
__device__ __forceinline__ s16x4 tr_read(const LAS unsigned char* p) { return __builtin_bit_cast(s16x4, __builtin_amdgcn_ds_read_tr16_b64_v4i16((LAS v4i16_t*)p)); }
__device__ __forceinline__ f32x16 zero16() { f32x16 z;
#pragma unroll
    for (int i = 0; i < 16; ++i) z[i] = 0.f; return z; }

constexpr size_t WS_PX = WS_U + 16 * MiB;
__device__ __forceinline__ void cross_mfma_phase(Frame& F) {
    const bf16* qc = WSP(bf16, WS_QC); const bf16* mkb = WSP(bf16, WS_MKB); const bf16* mvb = WSP(bf16, WS_MVB); bf16* oc = WSP(bf16, WS_OC); v4u* px = WSP(v4u, WS_PX);
    LAS unsigned char* L = F.lds + RING_OFF;
    for (int su = F.vcu; su < NB * 4 * 2; su += F.G) {
        const int bh = su >> 1, b = bh >> 2, hx = bh & 3, half = su & 1;
        __syncthreads();
        for (int c = F.tid; c < 8192; c += 512) { const int key = c >> 5, ch = c & 31;
            const v4u x = *(const GAS v4u*)(mkb + ((size_t)(b * 256 + key)) * 1024 + hx * 256 + ch * 8);
            *(LAS v4u*)(L + key * 512 + ((ch ^ (key & 15)) << 4)) = x; }
        __syncthreads();
        for (int qb = 0; qb < 4; ++qb) {
            int lane = F.lane; asm volatile("" : "+v"(lane));
            const int r = lane & 31, h = lane >> 5;
            const int m0 = b * SEQ + (half * 4 + qb) * 256 + F.wave * 32;
            bf16x8 qf[16];
            { const bf16* qrow = qc + (size_t)(m0 + r) * 1024 + hx * 256 + 8 * h;
#pragma unroll
              for (int ks = 0; ks < 16; ++ks) qf[ks] = *(const GAS bf16x8*)(qrow + 16 * ks); }
            asm volatile("" : "+v"(qf[0]), "+v"(qf[1]), "+v"(qf[2]), "+v"(qf[3]), "+v"(qf[4]), "+v"(qf[5]), "+v"(qf[6]), "+v"(qf[7]));
            asm volatile("" : "+v"(qf[8]), "+v"(qf[9]), "+v"(qf[10]), "+v"(qf[11]), "+v"(qf[12]), "+v"(qf[13]), "+v"(qf[14]), "+v"(qf[15]));
            f32x16 S[8];
#pragma unroll
            for (int kt = 0; kt < 8; ++kt) S[kt] = zero16();
            const LAS unsigned char* kb0 = L + r * 512;
            bf16x8 ka[4], kb_[4];
            { const int off = ((h ^ (r & 15)) << 4);
#pragma unroll
              for (int j = 0; j < 4; ++j) ka[j] = *(const LAS bf16x8*)(kb0 + j * 16384 + off); }
#pragma unroll
            for (int ks = 0; ks < 16; ++ks) { const int off = (((2 * ks + h) ^ (r & 15)) << 4), offn = (((2 * ks + 2 + h) ^ (r & 15)) << 4);
#pragma unroll
                for (int j = 0; j < 4; ++j) kb_[j] = *(const LAS bf16x8*)(kb0 + (4 + j) * 16384 + off);
                asm volatile("" : "+v"(ka[0]), "+v"(ka[1]), "+v"(ka[2]), "+v"(ka[3]));
#pragma unroll
                for (int j = 0; j < 4; ++j) S[j] = MFMA32(ka[j], qf[ks], S[j]);
                if (ks < 15) {
#pragma unroll
                    for (int j = 0; j < 4; ++j) ka[j] = *(const LAS bf16x8*)(kb0 + j * 16384 + offn); }
                asm volatile("" : "+v"(kb_[0]), "+v"(kb_[1]), "+v"(kb_[2]), "+v"(kb_[3]));
#pragma unroll
                for (int j = 0; j < 4; ++j) S[4 + j] = MFMA32(kb_[j], qf[ks], S[4 + j]);
            }
            float mx = -1e30f;
#pragma unroll
            for (int kt = 0; kt < 8; ++kt)
#pragma unroll
                for (int i = 0; i < 16; ++i) mx = fmaxf(mx, S[kt][i]);
            mx = fmaxf(mx, __shfl_xor(mx, 32));
            float sum = 0.f;
            { f32x2 s2v = {0.f, 0.f}; const float mxl = mx * 1.44269504f;
#pragma unroll
              for (int kt = 0; kt < 8; ++kt)
#pragma unroll
                for (int i2 = 0; i2 < 8; ++i2) { const f32x2 x = (f32x2){S[kt][2 * i2], S[kt][2 * i2 + 1]} * 1.44269504f - mxl; f32x2 e; e.x = __builtin_amdgcn_exp2f(x.x); e.y = __builtin_amdgcn_exp2f(x.y);
                    S[kt][2 * i2] = e.x; S[kt][2 * i2 + 1] = e.y; s2v = s2v + e; }
              sum = s2v.x + s2v.y; }
            sum += __shfl_xor(sum, 32);
            const float inv = 1.f / sum;
            v4u* pw = px + ((size_t)(m0 >> 5) * 4 + hx) * 1024 + lane;
#pragma unroll
            for (int kt = 0; kt < 8; ++kt)
#pragma unroll
                for (int s2 = 0; s2 < 2; ++s2) { v4u w; w.x = cvtpk(S[kt][8 * s2] * inv, S[kt][8 * s2 + 1] * inv); w.y = cvtpk(S[kt][8 * s2 + 2] * inv, S[kt][8 * s2 + 3] * inv);
                    w.z = cvtpk(S[kt][8 * s2 + 4] * inv, S[kt][8 * s2 + 5] * inv); w.w = cvtpk(S[kt][8 * s2 + 6] * inv, S[kt][8 * s2 + 7] * inv);
                    *(GAS v4u*)(pw + (kt * 2 + s2) * 64) = w; }
        }
        asm volatile("s_waitcnt vmcnt(0)" ::: "memory");
        __syncthreads();
        for (int c = F.tid; c < 8192; c += 512) { const int key = c >> 5, c16 = c & 31;
            const v4u x = *(const GAS v4u*)(mvb + ((size_t)(b * 256 + key)) * 1024 + hx * 256 + c16 * 8);
            *(LAS v4u*)(L + key * 512 + ((c16 * 16) ^ ((key & 3) << 6))) = x; }
        __syncthreads();
        for (int qb = 0; qb < 4; ++qb) {
            int lane = F.lane; asm volatile("" : "+v"(lane));
            const int r = lane & 31, h = lane >> 5, q4 = (lane & 15) >> 2, p4 = lane & 3, blk = (lane >> 4) & 1;
            const int m0 = b * SEQ + (half * 4 + qb) * 256 + F.wave * 32;
            const v4u* pw = px + ((size_t)(m0 >> 5) * 4 + hx) * 1024 + lane;
            bf16x8 P[8][2];
#pragma unroll
            for (int kt = 0; kt < 8; ++kt)
#pragma unroll
                for (int s2 = 0; s2 < 2; ++s2) P[kt][s2] = __builtin_bit_cast(bf16x8, *(const GAS v4u*)(pw + (kt * 2 + s2) * 64));
            asm volatile("" : "+v"(P[0][0]), "+v"(P[0][1]), "+v"(P[1][0]), "+v"(P[1][1]), "+v"(P[2][0]), "+v"(P[2][1]), "+v"(P[3][0]), "+v"(P[3][1]));
            asm volatile("" : "+v"(P[4][0]), "+v"(P[4][1]), "+v"(P[5][0]), "+v"(P[5][1]), "+v"(P[6][0]), "+v"(P[6][1]), "+v"(P[7][0]), "+v"(P[7][1]));
            f32x16 O[8];
#pragma unroll
            for (int dt = 0; dt < 8; ++dt) O[dt] = zero16();
            const LAS unsigned char* vb0 = L + (4 * h + q4) * 512 + 32 * blk + 8 * p4;
            bf16x8 va[4], vb_[4];
#define CX_VREAD(dst, step, d0) do { _Pragma("unroll") for (int j = 0; j < 4; ++j) { const LAS unsigned char* a0 = vb0 + (step) * 8192 + 64 * (((d0) + j) ^ q4); \
                const s16x4 lo = tr_read(a0), hi = tr_read(a0 + 8 * 512); dst[j] = __builtin_shufflevector(lo, hi, 0, 1, 2, 3, 4, 5, 6, 7); } } while (0)
            CX_VREAD(va, 0, 0);
#pragma unroll
            for (int st = 0; st < 16; ++st) {
                CX_VREAD(vb_, st, 4);
                asm volatile("" : "+v"(va[0]), "+v"(va[1]), "+v"(va[2]), "+v"(va[3]));
#pragma unroll
                for (int j = 0; j < 4; ++j) O[j] = MFMA32(P[st >> 1][st & 1], va[j], O[j]);
                if (st < 15) CX_VREAD(va, st + 1, 0);
                asm volatile("" : "+v"(vb_[0]), "+v"(vb_[1]), "+v"(vb_[2]), "+v"(vb_[3]));
#pragma unroll
                for (int j = 0; j < 4; ++j) O[4 + j] = MFMA32(P[st >> 1][st & 1], vb_[j], O[4 + j]);
            }
#undef CX_VREAD
            bf16* ocol = oc + (size_t)(m0 + 4 * h) * 1024 + hx * 256 + r;
#pragma unroll
            for (int dt = 0; dt < 8; ++dt)
#pragma unroll
                for (int i = 0; i < 16; ++i) ocol[(size_t)((i & 3) + 8 * (i >> 2)) * 1024 + 32 * dt] = (bf16)f2bf(O[dt][i]);
        }
    }
    __syncthreads();
}

constexpr size_t WS_PART = WS_QC, WS_LSE = WS_U, WS_SSQP = WS_U + 8 * MiB;
template <int MODE> __device__ __forceinline__ void attn_step(const bf16x8 (&kf)[4], const bf16x8 (&vf)[2][2], const bf16x8 (&qf)[4], const LAS float* tbk, int dl, float& m, float& l, f32x16 (&O)[2]) {
    f32x16 acc = zero16();
#pragma unroll
    for (int ks = 0; ks < 4; ++ks) acc = MFMA32(kf[ks], qf[ks], acc);
    float tmax = -1e30f;
#pragma unroll
    for (int hb = 0; hb < 4; ++hb) {
        const f32x2 b01 = {tbk[-(8 * hb)], tbk[-(8 * hb + 1)]}, b23 = {tbk[-(8 * hb + 2)], tbk[-(8 * hb + 3)]};
        const f32x2 a01 = (f32x2){acc[4 * hb], acc[4 * hb + 1]} + b01, a23 = (f32x2){acc[4 * hb + 2], acc[4 * hb + 3]} + b23;
        float v[4] = {a01.x, a01.y, a23.x, a23.y};
#pragma unroll
        for (int j = 0; j < 4; ++j) { const int ci = j + 8 * hb;
            if (MODE == 1) v[j] = (dl - ci <= 128) ? v[j] : -1e30f;
            else if (MODE == 2) v[j] = (dl - ci >= 0) ? v[j] : -1e30f;
            acc[4 * hb + j] = v[j]; tmax = fmaxf(tmax, v[j]); } }
    tmax = fmaxf(tmax, __shfl_xor(tmax, 32));
    const bool grow = tmax > m + 8.f;
    if (__builtin_amdgcn_ballot_w64(grow) != 0ull) {
        const float mn = grow ? tmax : m, scl = __builtin_amdgcn_exp2f(m - mn); m = mn; l *= scl;
#pragma unroll
        for (int i = 0; i < 16; ++i) { O[0][i] *= scl; O[1][i] *= scl; }
    }
    f32x2 ps = {0.f, 0.f}; const float mv = m;
#pragma unroll
    for (int i2 = 0; i2 < 8; ++i2) { const f32x2 x = (f32x2){acc[2 * i2], acc[2 * i2 + 1]} - mv; f32x2 e; e.x = __builtin_amdgcn_exp2f(x.x); e.y = __builtin_amdgcn_exp2f(x.y); acc[2 * i2] = e.x; acc[2 * i2 + 1] = e.y; ps = ps + e; }
    l += ps.x + ps.y;
#pragma unroll
    for (int s2 = 0; s2 < 2; ++s2) { const bf16x8 pf = PACK_STEP(acc, s2);
        O[0] = MFMA32(vf[s2][0], pf, O[0]); O[1] = MFMA32(vf[s2][1], pf, O[1]); }
}
__device__ __forceinline__ void attn_step_kt(const bf16x8 (&kf)[4], const bf16x8 (&vf)[2][2], const bf16x8 (&qf)[4], const LAS float* tb0, int d0, int kt, float& m, float& l, f32x16 (&O)[2]) {
    const LAS float* tbk = tb0 - 32 * kt; const int dl = d0 - 32 * kt;
    if (kt == 0) attn_step<1>(kf, vf, qf, tbk, dl, m, l, O); else if (kt == 4) attn_step<2>(kf, vf, qf, tbk, dl, m, l, O); else attn_step<0>(kf, vf, qf, tbk, dl, m, l, O);
}
template <bool FUSE>
__device__ __forceinline__ void attn_mfma_phase(Frame& F, const Args& A, const int u0, const int u1) {
    const int w = F.wave;
    LAS float* tab = (LAS float*)(F.lds + RING_OFF);
    LAS unsigned char* kl = F.lds + RING_OFF + 20480 + w * 8704;
    LAS unsigned char* vl = kl + 4608;
    const bf16* qb = WSP(bf16, WS_QB); const bf16* kb = WSP(bf16, WS_KB); const bf16* vb = WSP(bf16, WS_VB);
    bf16* part = WSP(bf16, WS_PART); float* lsep = WSP(float, WS_LSE); const float* relb = A.in[9]; bf16* mixo = WSP(bf16, WS_MIX);
    __syncthreads();
    for (int idx = F.tid; idx < 3 * 8 * 192; idx += 512) { const int p = idx / (8 * 192), rem = idx % (8 * 192), hh = rem / 192, d = min(max(rem % 192 - 32, 0), 128); tab[idx] = relb[t5_bucket(d << (2 * p)) * 8 + hh] * 1.44269504f; }
    __syncthreads();
    for (int u = u0 + F.vcu; u < u1; u += F.G) {
        const int p = u >> 9, v = u & 511, lg = 2 * p, b = v >> 4, w2 = v & 15, nbk = w2 >> lg, rcls = w2 & ((1 << lg) - 1);
        const size_t tokbase = (size_t)b * SEQ + rcls;
        const LAS float* tb = tab + (p * 8 + w) * 192 + 32;
        for (int pr = 0; pr < 2; ++pr) {
            int lane = F.lane; asm volatile("" : "+v"(lane));
            const int r = lane & 31, h = lane >> 5, q4 = (lane & 15) >> 2, p4 = lane & 3, blk = (lane >> 4) & 1, vxor = ((q4 >> 1) & 1) << 6;
            const int i0 = 128 * nbk + 64 * pr, jbase = i0 - 128, amin = jbase >= 0 ? 0 : ((-jbase) >> 5);
            const int d0 = 128 + r - 4 * h; const LAS float* tb0 = tb + d0;
            const int skey = lane >> 3, sc16 = lane & 7; const size_t hoff = (size_t)w * 64 + sc16 * 8;
            v4u ka[4], va[4];
            { const int j0 = jbase + 32 * amin;
#pragma unroll
              for (int i = 0; i < 4; ++i) { const size_t g = (tokbase + ((size_t)(j0 + skey + 8 * i) << lg)) * 512 + hoff; ka[i] = *(const GAS v4u*)(kb + g); va[i] = *(const GAS v4u*)(vb + g); } }
            bf16x8 qfa[4], qfb[4];
            { const bf16* qrow = qb + (tokbase + ((size_t)(i0 + r) << lg)) * 512 + w * 64 + 8 * h; const size_t qstep = ((size_t)32 << lg) * 512;
#pragma unroll
              for (int ks = 0; ks < 4; ++ks) { qfa[ks] = *(const GAS bf16x8*)(qrow + 16 * ks); qfb[ks] = *(const GAS bf16x8*)(qrow + qstep + 16 * ks); } }
            float ma = -1e30f, la = 0.f, mb = -1e30f, lb = 0.f; f32x16 Oa[2], Ob[2]; Oa[0] = zero16(); Oa[1] = zero16(); Ob[0] = zero16(); Ob[1] = zero16();
#pragma unroll 1
            for (int a = amin; a < 6; ++a) {
                {
                    asm volatile("" ::: "memory");
#pragma unroll
                    for (int i = 0; i < 4; ++i) { const int key = skey + 8 * i;
                        *(LAS v4u*)(kl + key * 144 + sc16 * 16) = ka[i];
                        *(LAS v4u*)(vl + key * 128 + ((sc16 * 16) ^ (((key >> 1) & 1) << 6))) = va[i]; }
                    if (a < 5) { const int j1 = jbase + 32 * (a + 1);
#pragma unroll
                        for (int i = 0; i < 4; ++i) { const size_t g = (tokbase + ((size_t)(j1 + skey + 8 * i) << lg)) * 512 + hoff; ka[i] = *(const GAS v4u*)(kb + g); va[i] = *(const GAS v4u*)(vb + g); } }
                    asm volatile("s_waitcnt lgkmcnt(0)" ::: "memory");
                    bf16x8 kf[4], vf[2][2];
#pragma unroll
                    for (int ks = 0; ks < 4; ++ks) kf[ks] = *(const LAS bf16x8*)(kl + r * 144 + (2 * ks + h) * 16);
#pragma unroll
                    for (int s2 = 0; s2 < 2; ++s2)
#pragma unroll
                        for (int dt = 0; dt < 2; ++dt) { const LAS unsigned char* a0 = vl + (16 * s2 + 4 * h + q4) * 128 + ((64 * dt + 32 * blk + 8 * p4) ^ vxor);
                            const s16x4 lo = tr_read(a0), hi = tr_read(a0 + 8 * 128); vf[s2][dt] = __builtin_shufflevector(lo, hi, 0, 1, 2, 3, 4, 5, 6, 7); }
                    if (a < 5) attn_step_kt(kf, vf, qfa, tb0, d0, a, ma, la, Oa);
                    if (a > 0) attn_step_kt(kf, vf, qfb, tb0, d0, a - 1, mb, lb, Ob);
                    asm volatile("s_waitcnt lgkmcnt(0)" ::: "memory");
                }
            }
            if constexpr (FUSE) {
                v2u pa[2][2][8]; float l0[2], l1[2];
#pragma unroll
                for (int sb = 0; sb < 2; ++sb) { const size_t tok = tokbase + ((size_t)(i0 + 32 * sb + r) << lg);
                    const bf16* p0 = part + tok * 512 + w * 64 + 4 * h; const bf16* p1 = p0 + (size_t)TP * 512;
                    l0[sb] = lsep[tok * 8 + w]; l1[sb] = lsep[((size_t)TP + tok) * 8 + w];
#pragma unroll
                    for (int dt = 0; dt < 2; ++dt)
#pragma unroll
                        for (int g = 0; g < 4; ++g) { pa[sb][0][dt * 4 + g] = *(const GAS v2u*)(p0 + 32 * dt + 8 * g); pa[sb][1][dt * 4 + g] = *(const GAS v2u*)(p1 + 32 * dt + 8 * g); } }
#pragma unroll
                for (int sb = 0; sb < 2; ++sb) {
                    float lsum = sb ? lb : la; const float mm = sb ? mb : ma; lsum += __shfl_xor(lsum, 32);
                    const float l2 = (mm + __builtin_amdgcn_logf(lsum)) * 0.69314718f;
                    const float mx = fmaxf(l0[sb], fmaxf(l1[sb], l2)); float e0 = __expf(l0[sb] - mx), e1 = __expf(l1[sb] - mx), e2 = __expf(l2 - mx);
                    const float invs = 1.f / (e0 + e1 + e2); e0 *= invs; e1 *= invs; e2 *= invs / lsum;
                    const size_t tok = tokbase + ((size_t)(i0 + 32 * sb + r) << lg);
                    bf16* orow = mixo + tok * 1536 + w * 64 + 4 * h;
#pragma unroll
                    for (int dt = 0; dt < 2; ++dt)
#pragma unroll
                        for (int g = 0; g < 4; ++g) { const f32x16& O = sb ? Ob[dt] : Oa[dt]; const v2u a = pa[sb][0][dt * 4 + g], c = pa[sb][1][dt * 4 + g];
                            v2u x; x.x = cvtpk(e0 * __uint_as_float(a.x << 16) + e1 * __uint_as_float(c.x << 16) + e2 * O[4 * g], e0 * __uint_as_float(a.x & 0xffff0000u) + e1 * __uint_as_float(c.x & 0xffff0000u) + e2 * O[4 * g + 1]);
                            x.y = cvtpk(e0 * __uint_as_float(a.y << 16) + e1 * __uint_as_float(c.y << 16) + e2 * O[4 * g + 2], e0 * __uint_as_float(a.y & 0xffff0000u) + e1 * __uint_as_float(c.y & 0xffff0000u) + e2 * O[4 * g + 3]);
                            *(GAS v2u*)(orow + 32 * dt + 8 * g) = x; }
                }
            } else
#pragma unroll
            for (int sb = 0; sb < 2; ++sb) {
                float lsum = sb ? lb : la; const float mm = sb ? mb : ma; lsum += __shfl_xor(lsum, 32);
                const float inv = 1.f / lsum;
                const size_t tok = tokbase + ((size_t)(i0 + 32 * sb + r) << lg);
                bf16* orow = part + ((size_t)p * TP + tok) * 512 + w * 64 + 4 * h;
#pragma unroll
                for (int dt = 0; dt < 2; ++dt)
#pragma unroll
                    for (int g = 0; g < 4; ++g) { const f32x16& O = sb ? Ob[dt] : Oa[dt]; v2u x; x.x = cvtpk(O[4 * g] * inv, O[4 * g + 1] * inv); x.y = cvtpk(O[4 * g + 2] * inv, O[4 * g + 3] * inv);
                        *(GAS v2u*)(orow + 32 * dt + 8 * g) = x; }
                if (h == 0) lsep[((size_t)p * TP + tok) * 8 + w] = (mm + __builtin_amdgcn_logf(lsum)) * 0.69314718f;
            }
        }
    }
    __syncthreads();
}

constexpr int SSP = 272;
constexpr int SS_CN = 0, SS_BN = 34816, SS_BTD = 69632, SS_XT = 104448, SS_HB = 121856, SS_ACS = 139264;
static_assert(SS_ACS + 2 * 1536 <= LDSCTL_OFF, "SSD LDS map");

__device__ __forceinline__ void unpack8x2(const v4u w, f32x2 (&f)[4]) {
    f[0] = (f32x2){__uint_as_float(w.x << 16), __uint_as_float(w.x & 0xffff0000u)}; f[1] = (f32x2){__uint_as_float(w.y << 16), __uint_as_float(w.y & 0xffff0000u)};
    f[2] = (f32x2){__uint_as_float(w.z << 16), __uint_as_float(w.z & 0xffff0000u)}; f[3] = (f32x2){__uint_as_float(w.w << 16), __uint_as_float(w.w & 0xffff0000u)};
}
__device__ __forceinline__ f32x2 silu2(f32x2 v) { const f32x2 t = v * -1.44269504f; f32x2 e; e.x = __builtin_amdgcn_exp2f(t.x); e.y = __builtin_amdgcn_exp2f(t.y); const f32x2 d = e + 1.0f; f32x2 r; r.x = __builtin_amdgcn_rcpf(d.x); r.y = __builtin_amdgcn_rcpf(d.y); return v * r; }
constexpr size_t WS_BCC = 1455 * MiB;
__device__ __forceinline__ void bc_conv_prepass(Frame& F, const Args& A) {
    const bf16* xbc = WSP(bf16, WS_XBC); bf16* bcc = WSP(bf16, WS_BCC); const float* conv_w = A.in[16]; const float* conv_b = A.in[17];
    const int nthr = F.G * 512;
    for (int sidx = F.vcu * 512 + F.tid; sidx < (TP / 8) * 64; sidx += nthr) {
        const int cg = sidx & 63, rb = sidx >> 6, colg = 1024 + 8 * cg, row = rb * 8, t0 = row & 2047;
        v4u raw[11];
#pragma unroll
        for (int q = 0; q < 11; ++q) { const bool ok = t0 - 3 + q >= 0; const v4u x = *(const GAS v4u*)(xbc + (size_t)(ok ? row - 3 + q : row) * 1536 + colg);
            raw[q].x = ok ? x.x : 0u; raw[q].y = ok ? x.y : 0u; raw[q].z = ok ? x.z : 0u; raw[q].w = ok ? x.w : 0u; }
        f32x2 cw[4][4], cb[4];
#pragma unroll
        for (int w = 0; w < 4; ++w) { const f32x4 a = *(const GAS f32x4*)(conv_w + w * 1536 + colg), c = *(const GAS f32x4*)(conv_w + w * 1536 + colg + 4);
            cw[w][0] = (f32x2){a.x, a.y}; cw[w][1] = (f32x2){a.z, a.w}; cw[w][2] = (f32x2){c.x, c.y}; cw[w][3] = (f32x2){c.z, c.w}; }
        { const f32x4 a = *(const GAS f32x4*)(conv_b + colg), c = *(const GAS f32x4*)(conv_b + colg + 4); cb[0] = (f32x2){a.x, a.y}; cb[1] = (f32x2){a.z, a.w}; cb[2] = (f32x2){c.x, c.y}; cb[3] = (f32x2){c.z, c.w}; }
#pragma unroll
        for (int i = 0; i < 8; ++i) { f32x2 f0[4], f1[4], f2[4], f3[4], o[4]; unpack8x2(raw[i], f0); unpack8x2(raw[i + 1], f1); unpack8x2(raw[i + 2], f2); unpack8x2(raw[i + 3], f3);
#pragma unroll
            for (int e = 0; e < 4; ++e) o[e] = silu2(cb[e] + cw[0][e] * f0[e] + cw[1][e] * f1[e] + cw[2][e] * f2[e] + cw[3][e] * f3[e]);
            *(GAS v4u*)(bcc + (size_t)(row + i) * 512 + 8 * cg) = (v4u){cvtpk(o[0].x, o[0].y), cvtpk(o[1].x, o[1].y), cvtpk(o[2].x, o[2].y), cvtpk(o[3].x, o[3].y)}; }
    }
}
__device__ __forceinline__ void xstrip_load(v4u (&raw)[5], const bf16* xbc, size_t row0, int c, int k, int head) {
    const int cg = k & 7, rb = k >> 3, t0 = c * 128 + 2 * rb;
#pragma unroll
    for (int q = 0; q < 5; ++q) { const bool ok = t0 - 3 + q >= 0; const v4u x = *(const GAS v4u*)(xbc + (row0 + (ok ? t0 - 3 + q : 0)) * 1536 + head * 64 + 8 * cg);
        raw[q].x = ok ? x.x : 0u; raw[q].y = ok ? x.y : 0u; raw[q].z = ok ? x.z : 0u; raw[q].w = ok ? x.w : 0u; }
}
__device__ __forceinline__ void xstrip_compute(const v4u (&raw)[5], LAS unsigned char* L, const float* conv_w, const float* conv_b, int k, int head) {
    const int cg = k & 7, rb = k >> 3, colg = head * 64 + 8 * cg, s0 = 2 * rb;
    f32x2 cw[4][4], cb[4];
#pragma unroll
    for (int w = 0; w < 4; ++w) { const f32x4 a = *(const GAS f32x4*)(conv_w + w * 1536 + colg), c = *(const GAS f32x4*)(conv_w + w * 1536 + colg + 4);
        cw[w][0] = (f32x2){a.x, a.y}; cw[w][1] = (f32x2){a.z, a.w}; cw[w][2] = (f32x2){c.x, c.y}; cw[w][3] = (f32x2){c.z, c.w}; }
    { const f32x4 a = *(const GAS f32x4*)(conv_b + colg), c = *(const GAS f32x4*)(conv_b + colg + 4); cb[0] = (f32x2){a.x, a.y}; cb[1] = (f32x2){a.z, a.w}; cb[2] = (f32x2){c.x, c.y}; cb[3] = (f32x2){c.z, c.w}; }
    f32x2 o[2][4];
#pragma unroll
    for (int i = 0; i < 2; ++i) { f32x2 f0[4], f1[4], f2[4], f3[4]; unpack8x2(raw[i], f0); unpack8x2(raw[i + 1], f1); unpack8x2(raw[i + 2], f2); unpack8x2(raw[i + 3], f3);
#pragma unroll
        for (int e = 0; e < 4; ++e) o[i][e] = silu2(cb[e] + cw[0][e] * f0[e] + cw[1][e] * f1[e] + cw[2][e] * f2[e] + cw[3][e] * f3[e]); }
#pragma unroll
    for (int e = 0; e < 4; ++e) { *(LAS unsigned*)(L + SS_XT + (8 * cg + 2 * e) * SSP + s0 * 2) = cvtpk(o[0][e].x, o[1][e].x); *(LAS unsigned*)(L + SS_XT + (8 * cg + 2 * e + 1) * SSP + s0 * 2) = cvtpk(o[0][e].y, o[1][e].y); }
}
__device__ __forceinline__ void bcstrip_load(v4u (&raw)[8], const bf16* bcc, size_t row0, int c, int k, int g, int reg) {
    const int cg = k & 15, rb = k >> 4;
#pragma unroll
    for (int q = 0; q < 8; ++q) raw[q] = *(const GAS v4u*)(bcc + (row0 + c * 128 + 8 * rb + q) * 512 + (reg == 1 ? 0 : 256) + g * 128 + 8 * cg);
}
template <int REG> __device__ __forceinline__ void bcstrip_compute(const v4u (&raw)[8], LAS unsigned char* L, int k, const LAS float* acs, const LAS float* dtv) {
    const int cg = k & 15, rb = k >> 4, s0 = 8 * rb;
#pragma unroll
    for (int i = 0; i < 8; ++i) *(LAS v4u*)(L + (REG == 1 ? SS_BN : SS_CN) + (s0 + i) * SSP + cg * 16) = raw[i];
    if (REG == 1) { const float atot = acs[127]; float fd[8], f[8][8];
#pragma unroll
        for (int i = 0; i < 8; ++i) { fd[i] = dtv[s0 + i] * __expf(atot - acs[s0 + i]); unpack8(raw[i], f[i]); }
#pragma unroll
        for (int e = 0; e < 8; ++e) *(LAS v4u*)(L + SS_BTD + (8 * cg + e) * SSP + s0 * 2) =
            (v4u){cvtpk(f[0][e] * fd[0], f[1][e] * fd[1]), cvtpk(f[2][e] * fd[2], f[3][e] * fd[3]), cvtpk(f[4][e] * fd[4], f[5][e] * fd[5]), cvtpk(f[6][e] * fd[6], f[7][e] * fd[7])}; }
}
__device__ __forceinline__ void ssd_scan(LAS float* buf, float d0, float d1, float a, int lane) {
    float s0 = d0 * a, s1 = d1 * a;
#pragma unroll
    for (int o = 1; o < 64; o <<= 1) { const float t0 = __shfl_up(s0, o), t1 = __shfl_up(s1, o); if (lane >= o) { s0 += t0; s1 += t1; } }
    const float tot0 = __shfl(s0, 63); s1 += tot0;
    const float r0 = __shfl(s0, (lane & 32) + 31), r1 = __shfl(s1, (lane & 32) + 31);
    buf[lane] = s0; buf[64 + lane] = s1; buf[128 + lane] = d0; buf[192 + lane] = d1; buf[256 + lane] = d0 * __expf(r0 - s0); buf[320 + lane] = d1 * __expf(r1 - s1);
}
__device__ __forceinline__ void ssd_mfma_unit(Frame& F, const Args& A, int b, int head, float* hout) {
    const int w = F.wave, g = head >> 3;
    LAS unsigned char* L = F.lds + RING_OFF;
    const bf16* xbc = WSP(bf16, WS_XBC); const bf16* bcc = WSP(bf16, WS_BCC); const float* dtb = WSP(float, WS_DTB); const bf16* zg = WSP(bf16, WS_ZG); bf16* mix = WSP(bf16, WS_MIX); float* ssqp = WSP(float, WS_SSQP);
    const float* conv_w = A.in[16]; const float* conv_b = A.in[17];
    const float a = -__expf(A.in[19][head]), dsk = A.in[20][head];
    const size_t row0 = (size_t)b * SEQ;
    const int pt = w & 1, lt = (0x11002233 >> (4 * w)) & 3, pt2 = w >> 2, nt = w & 3, breg = w < 4 ? 1 : 2;
    f32x16 hacc = zero16();
    v4u rawx[5], rawb[8];
    float dn0 = 0.f, dn1 = 0.f;
    __syncthreads();
    { int lane0 = F.lane; asm volatile("" : "+v"(lane0)); const int tid0 = w * 64 + lane0;
      for (int i = tid0; i < 17408 / 16; i += 512) *(LAS v4u*)(L + SS_HB + i * 16) = (v4u){0u, 0u, 0u, 0u};
      xstrip_load(rawx, xbc, row0, 0, tid0, head); bcstrip_load(rawb, bcc, row0, 0, tid0 & 255, g, breg);
      if (w == 4) ssd_scan((LAS float*)(L + SS_ACS), dtb[(row0 + lane0) * 16 + head], dtb[(row0 + 64 + lane0) * 16 + head], a, lane0); }
    __syncthreads();
    for (int c = 0; c < 16; ++c) {
        int lane = F.lane; asm volatile("" : "+v"(lane));
        const int tid = w * 64 + lane, r = lane & 31, h = lane >> 5;
        const LAS float* acs = (const LAS float*)(L + SS_ACS + (c & 1) * 1536); const LAS float* dtv = acs + 128; const LAS float* vfac = acs + 256;
        if (w == 4 && c < 15) { dn0 = dtb[(row0 + (c + 1) * 128 + lane) * 16 + head]; dn1 = dtb[(row0 + (c + 1) * 128 + 64 + lane) * 16 + head]; }
        xstrip_compute(rawx, L, conv_w, conv_b, tid, head);
        if (w < 4) bcstrip_compute<1>(rawb, L, tid & 255, acs, dtv); else bcstrip_compute<2>(rawb, L, tid & 255, acs, dtv);
        LBAR();
        {
            if (c < 15) {
                int tc = tid; asm volatile("" : "+v"(tc));
                xstrip_load(rawx, xbc, row0, c + 1, tc, head); bcstrip_load(rawb, bcc, row0, c + 1, tc & 255, g, breg);
                if (w == 4) ssd_scan((LAS float*)(L + SS_ACS + ((c + 1) & 1) * 1536), dn0, dn1, a, lane); }
            const int l = 32 * lt + r; const size_t tok = row0 + c * 128 + l;
            v2u zw[4];
#pragma unroll
            for (int g4 = 0; g4 < 4; ++g4) zw[g4] = *(const GAS v2u*)(zg + tok * 1024 + head * 64 + 32 * pt + 8 * g4 + 4 * h);
            bf16x8 cf[8];
#pragma unroll
            for (int ks = 0; ks < 8; ++ks) cf[ks] = *(const LAS bf16x8*)(L + SS_CN + (32 * lt + r) * SSP + (16 * ks + 8 * h) * 2);
            const float al = acs[l];
            f32x16 y1 = zero16();
            for (int st = 0; st <= lt; ++st) {
                f32x16 ga = zero16(), gb = zero16();
#pragma unroll
                for (int ks = 0; ks < 8; ks += 2) { const bf16x8 af0 = *(const LAS bf16x8*)(L + SS_BN + (32 * st + r) * SSP + (16 * ks + 8 * h) * 2), af1 = *(const LAS bf16x8*)(L + SS_BN + (32 * st + r) * SSP + (16 * ks + 16 + 8 * h) * 2);
                    ga = MFMA32(af0, cf[ks], ga); gb = MFMA32(af1, cf[ks + 1], gb); }
                if (st < lt) {
                    const float ur = __expf(al - acs[32 * st + 31]);
#pragma unroll
                    for (int i = 0; i < 16; ++i) { const int sidx = 32 * st + (i & 3) + 8 * (i >> 2) + 4 * h; ga[i] = (ga[i] + gb[i]) * (ur * vfac[sidx]); }
                } else {
#pragma unroll
                    for (int i = 0; i < 16; ++i) { const int sidx = 32 * st + (i & 3) + 8 * (i >> 2) + 4 * h; const float msk = (sidx <= l) ? 1.f : 0.f;
                        const float e = __expf(fminf(al - acs[sidx], 0.f)) * (dtv[sidx] * msk); ga[i] = (ga[i] + gb[i]) * e; }
                }
#pragma unroll
                for (int s2 = 0; s2 < 2; ++s2) { const bf16x8 pf = PACK_STEP(ga, s2);
                    const LAS unsigned char* xp = L + SS_XT + (32 * pt + r) * SSP + (32 * st + 16 * s2 + 4 * h) * 2;
                    const v2u lo = *(const LAS v2u*)xp, hi = *(const LAS v2u*)(xp + 16);
                    const bf16x8 xa = __builtin_bit_cast(bf16x8, ((v4u){lo.x, lo.y, hi.x, hi.y}));
                    y1 = MFMA32(xa, pf, y1); }
            }
            f32x16 y2 = zero16(), y2b = zero16();
#pragma unroll
            for (int ks = 0; ks < 8; ks += 2) { const bf16x8 hf0 = *(const LAS bf16x8*)(L + SS_HB + (32 * pt + r) * SSP + (16 * ks + 8 * h) * 2), hf1 = *(const LAS bf16x8*)(L + SS_HB + (32 * pt + r) * SSP + (16 * ks + 16 + 8 * h) * 2);
                y2 = MFMA32(hf0, cf[ks], y2); y2b = MFMA32(hf1, cf[ks + 1], y2b); }
            const float el = __expf(al);
            float sq = 0.f;
#pragma unroll
            for (int g4 = 0; g4 < 4; ++g4) { const int p0 = 32 * pt + 8 * g4 + 4 * h;
                const float z0 = bf2f(zw[g4].x & 0xffffu), z1 = __uint_as_float(zw[g4].x & 0xffff0000u), z2 = bf2f(zw[g4].y & 0xffffu), z3 = __uint_as_float(zw[g4].y & 0xffff0000u);
                float yv[4];
#pragma unroll
                for (int j = 0; j < 4; ++j) { const float xv = bf2f(*(const LAS unsigned short*)(L + SS_XT + (p0 + j) * SSP + l * 2)); yv[j] = y1[4 * g4 + j] + el * (y2[4 * g4 + j] + y2b[4 * g4 + j]) + dsk * xv; }
                yv[0] *= z0; yv[1] *= z1; yv[2] *= z2; yv[3] *= z3;
                sq += yv[0] * yv[0] + yv[1] * yv[1] + yv[2] * yv[2] + yv[3] * yv[3];
                *(GAS v2u*)(mix + tok * 1536 + 512 + head * 64 + p0) = (v2u){cvtpk(yv[0], yv[1]), cvtpk(yv[2], yv[3])}; }
            sq += __shfl_xor(sq, 32);
            if (h == 0) ssqp[tok * 32 + head * 2 + pt] = sq;
            const float cd = __expf(acs[127]);
            f32x16 sa = zero16(), sb = zero16();
#pragma unroll
            for (int ks = 0; ks < 8; ks += 2) {
                const bf16x8 xa0 = *(const LAS bf16x8*)(L + SS_XT + (32 * pt2 + r) * SSP + (16 * ks + 8 * h) * 2), xa1 = *(const LAS bf16x8*)(L + SS_XT + (32 * pt2 + r) * SSP + (16 * ks + 16 + 8 * h) * 2);
                const bf16x8 bd0 = *(const LAS bf16x8*)(L + SS_BTD + (32 * nt + r) * SSP + (16 * ks + 8 * h) * 2), bd1 = *(const LAS bf16x8*)(L + SS_BTD + (32 * nt + r) * SSP + (16 * ks + 16 + 8 * h) * 2);
                sa = MFMA32(xa0, bd0, sa); sb = MFMA32(xa1, bd1, sb); }
#pragma unroll
            for (int i = 0; i < 16; ++i) hacc[i] = hacc[i] * cd + (sa[i] + sb[i]);
        }
        LBAR();
#pragma unroll
        for (int i = 0; i < 16; ++i) { const int p = 32 * pt2 + (i & 3) + 8 * (i >> 2) + 4 * h; *(LAS unsigned short*)(L + SS_HB + p * SSP + (32 * nt + r) * 2) = (unsigned short)f2bf(hacc[i]); }
    }
    { const int r = F.lane & 31, h = F.lane >> 5;
#pragma unroll
    for (int i = 0; i < 16; ++i) { const int p = 32 * pt2 + (i & 3) + 8 * (i >> 2) + 4 * h; hout[(size_t)p * 128 + 32 * nt + r] = hacc[i]; } }
    __syncthreads();
}

__device__ __forceinline__ void ssd_sample_wave(Frame& F, const Args& A, int v) {
    int lane = F.lane; asm volatile("" : "+v"(lane));
    const int b = v >> 4, head = v & 15, g = head >> 3; const size_t row = (size_t)TP + b;
    LAS float* wl = (LAS float*)(F.lds + RING_OFF + F.wave * 17152);
    const bf16* xbc = WSP(bf16, WS_XBC); const float* cc = A.in[4]; const float* conv_w = A.in[16]; const float* conv_b = A.in[17];
#pragma unroll
    for (int i = 0; i < 5; ++i) { const int c = lane + 64 * i; const int col = c < 64 ? head * 64 + c : (c < 192 ? 1024 + g * 128 + (c - 64) : 1280 + g * 128 + (c - 192));
        float x = conv_b[col] + conv_w[3 * 1536 + col] * bf2f(xbc[row * 1536 + col]);
#pragma unroll
        for (int w = 0; w < 3; ++w) x += conv_w[w * 1536 + col] * cc[((size_t)b * 3 + w) * 1536 + col];
        wl[c] = silu_f(x); }
    const float dt = WSP(float, WS_DTB)[row * 16 + head], dec = __expf(-dt * __expf(A.in[19][head])), dsk = A.in[20][head];
    LDS_WAIT(); asm volatile("" ::: "memory");
    const float x = wl[lane], dtx = dt * x;
    const GAS f32x4* hp = (const GAS f32x4*)(A.in[5] + (size_t)v * 8192 + lane * 128); GAS f32x4* op = (GAS f32x4*)(F.out + O_SSS + (size_t)v * 8192 + lane * 128);
    float y = 0.f;
#pragma unroll
    for (int jb = 0; jb < 4; ++jb) { f32x4 hv[8];
#pragma unroll
        for (int j = 0; j < 8; ++j) hv[j] = hp[8 * jb + j];
#pragma unroll
        for (int j = 0; j < 8; ++j) { const f32x4 B4 = *(const LAS f32x4*)(wl + 64 + 4 * (8 * jb + j)), C4 = *(const LAS f32x4*)(wl + 192 + 4 * (8 * jb + j));
            const f32x4 hn = hv[j] * dec + B4 * dtx; y += (C4.x * hn.x + C4.y * hn.y) + (C4.z * hn.z + C4.w * hn.w); op[8 * jb + j] = hn; } }
    y = (y + dsk * x) * bf2f(WSP(bf16, WS_ZG)[row * 1024 + head * 64 + lane]);
    WSP(bf16, WS_MIX)[row * 1536 + 512 + head * 64 + lane] = (bf16)f2bf(y);
    const float sq = wave_sum(y * y);
    if (lane < 2) WSP(float, WS_SSQP)[row * 32 + head * 2 + lane] = lane == 0 ? sq : 0.f;
    asm volatile("s_waitcnt lgkmcnt(0)" ::: "memory");
}
__device__ __forceinline__ void attn_sample_wave(Frame& F, const Args& A, int v) {
    int lane = F.lane; asm volatile("" : "+v"(lane));
    const int bs = v >> 3, hd = v & 7; const size_t row = (size_t)TP + bs;
    LAS float* ql = (LAS float*)(F.lds + RING_OFF + F.wave * 17152);
    LAS float* T = ql + 64;
    const float* ck = A.in[2]; const float* cv = A.in[3]; const float* relb = A.in[9];
    const float qv = bf2f(WSP(bf16, WS_QB)[row * 512 + hd * 64 + lane]), kn = bf2f(WSP(bf16, WS_KB)[row * 512 + hd * 64 + lane]), vn = bf2f(WSP(bf16, WS_VB)[row * 512 + hd * 64 + lane]);
    ql[lane] = qv;
    const float s0 = wave_sum(qv * kn) + relb[hd] * 1.44269504f;
    LDS_WAIT(); asm volatile("" ::: "memory");
    float m = lane == 0 ? s0 : -1e30f, l = lane == 0 ? 3.f : 0.f, o[64];
#pragma unroll
    for (int d = 0; d < 64; ++d) { const float vd = __shfl(vn, d); o[d] = lane == 0 ? 3.f * vd : 0.f; }
#pragma unroll 1
    for (int t = 0; t < 6; ++t) {
        const int e = lane + 64 * t, p = e >> 7, j = (e & 127) + 1, dist = j << (2 * p);
        const size_t off = (((size_t)bs * 2048 + (2048 - dist)) * 8 + hd) * 64;
        float s = relb[t5_bucket(dist) * 8 + hd] * 1.44269504f;
        { const GAS f32x4* kp = (const GAS f32x4*)(ck + off); f32x4 kr[16];
#pragma unroll
          for (int c = 0; c < 16; ++c) kr[c] = kp[c];
#pragma unroll
          for (int c = 0; c < 16; ++c) { const f32x4 q4 = *(const LAS f32x4*)(ql + 4 * c); s += (q4.x * kr[c].x + q4.y * kr[c].y) + (q4.z * kr[c].z + q4.w * kr[c].w); } }
        const float mn = fmaxf(m, s), sc = __builtin_amdgcn_exp2f(m - mn), pe = __builtin_amdgcn_exp2f(s - mn); l = l * sc + pe; m = mn;
        { const GAS f32x4* vp = (const GAS f32x4*)(cv + off); f32x4 vr[16];
#pragma unroll
          for (int c = 0; c < 16; ++c) vr[c] = vp[c];
#pragma unroll
          for (int c = 0; c < 16; ++c) { o[4 * c] = o[4 * c] * sc + pe * vr[c].x; o[4 * c + 1] = o[4 * c + 1] * sc + pe * vr[c].y; o[4 * c + 2] = o[4 * c + 2] * sc + pe * vr[c].z; o[4 * c + 3] = o[4 * c + 3] * sc + pe * vr[c].w; } }
    }
    const float M = wave_max(m), f = __builtin_amdgcn_exp2f(m - M); const float Ls = wave_sum(l * f);
#pragma unroll
    for (int d = 0; d < 64; ++d) T[lane * 65 + d] = o[d] * f;
    LDS_WAIT(); asm volatile("" ::: "memory");
    float acc = 0.f;
#pragma unroll 8
    for (int r = 0; r < 64; ++r) acc += T[r * 65 + lane];
    WSP(bf16, WS_MIX)[row * 1536 + hd * 64 + lane] = (bf16)f2bf(acc / Ls);
    LDS_WAIT(); asm volatile("" ::: "memory");
}
__device__ __forceinline__ void cross_sample_block(Frame& F, const Args& A, int pair) {
    int lane = F.lane; asm volatile("" : "+v"(lane));
    const int w = F.wave, task = pair * 2 + (w >> 2), kq = w & 3, bs = task >> 2, hx = task & 3; const size_t row = (size_t)TP + bs;
    const float* cmk = A.in[6]; const float* cmv = A.in[7];
    LAS float* X = (LAS float*)(F.lds + RING_OFF);
    float q[4]; { const v2u qw = *(const GAS v2u*)(WSP(bf16, WS_QC) + row * 1024 + hx * 256 + lane * 4); q[0] = bf2f(qw.x & 0xffffu); q[1] = __uint_as_float(qw.x & 0xffff0000u); q[2] = bf2f(qw.y & 0xffffu); q[3] = __uint_as_float(qw.y & 0xffff0000u); }
    const size_t kbase = (((size_t)bs * 256 + kq * 64) * 4 + hx) * 256 + lane * 4;
    float keep = 0.f;
#pragma unroll 1
    for (int kb = 0; kb < 4; ++kb) { f32x4 kr[16]; float d[16];
#pragma unroll
        for (int i = 0; i < 16; ++i) kr[i] = *(const GAS f32x4*)(cmk + kbase + (size_t)(kb * 16 + i) * 1024);
#pragma unroll
        for (int i = 0; i < 16; ++i) d[i] = (q[0] * kr[i].x + q[1] * kr[i].y) + (q[2] * kr[i].z + q[3] * kr[i].w);
#pragma unroll
        for (int o = 1; o < 64; o <<= 1) {
#pragma unroll
            for (int i = 0; i < 16; ++i) d[i] += __shfl_xor(d[i], o); }
#pragma unroll
        for (int i = 0; i < 16; ++i) keep = (lane == kb * 16 + i) ? d[i] : keep; }
    const float mw = wave_max(keep), pe = __expf(keep - mw), lw = wave_sum(pe);
    float o[4] = {0.f, 0.f, 0.f, 0.f};
#pragma unroll 1
    for (int kb = 0; kb < 4; ++kb) { f32x4 vr[16];
#pragma unroll
        for (int i = 0; i < 16; ++i) vr[i] = *(const GAS f32x4*)(cmv + kbase + (size_t)(kb * 16 + i) * 1024);
#pragma unroll
        for (int i = 0; i < 16; ++i) { const float wgt = rdlane(pe, kb * 16 + i); o[0] += wgt * vr[i].x; o[1] += wgt * vr[i].y; o[2] += wgt * vr[i].z; o[3] += wgt * vr[i].w; } }
    __syncthreads();
    *(LAS f32x4*)(X + w * 260 + lane * 4) = (f32x4){o[0], o[1], o[2], o[3]};
    if (lane == 0) { X[w * 260 + 256] = mw; X[w * 260 + 257] = lw; }
    __syncthreads();
    if (kq == 0) { const int w0 = w;
        float mm[4], ll[4];
#pragma unroll
        for (int i = 0; i < 4; ++i) { mm[i] = X[(w0 + i) * 260 + 256]; ll[i] = X[(w0 + i) * 260 + 257]; }
        const float M = fmaxf(fmaxf(mm[0], mm[1]), fmaxf(mm[2], mm[3])); float Ls = 0.f; f32x4 acc = (f32x4){0.f, 0.f, 0.f, 0.f};
#pragma unroll
        for (int i = 0; i < 4; ++i) { const float f = __expf(mm[i] - M); Ls += f * ll[i]; acc += *(const LAS f32x4*)(X + (w0 + i) * 260 + lane * 4) * f; }
        const float inv = 1.f / Ls;
        *(GAS v2u*)(WSP(bf16, WS_OC) + row * 1024 + hx * 256 + lane * 4) = (v2u){pk2(acc.x * inv, acc.y * inv), pk2(acc.z * inv, acc.w * inv)}; }
    __syncthreads();
}

#define SAMPLE_SPLIT(EPI, E, g, KS, IDX) do { pg8::Gemm g2{(g).A, (g).Bt, 256, (g).N, 256, (g).lda, (g).ldb}; pg8::SplitOrder S2; S2.init((g).N, (KS), 256, F.G, (int)blockIdx.x); \
        pg8::EpiSplit<EPI> E2{(E), WSP(float, WS_SLAB), (unsigned*)(F.ctl + CW_TICK + (IDX) * TICK_WORDS), (KS)}; \
        pg8::gemm_phase<pg8::EpiSplit<EPI>, pg8::SplitOrder, PG8_ALIGN, PG8_SP2>(F.lds + RING_OFF, g2, S2, E2, F.wave); } while (0)
__global__ void __launch_bounds__(NWAVES * 64, 2) hymba_fwd(Args args) {
    extern __shared__ __attribute__((aligned(16))) unsigned char lds[];
    Frame F;
    F.lds = (LAS unsigned char*)lds; F.MISC = (volatile LAS unsigned*)(F.lds + MISC_OFF);
    F.wave = __builtin_amdgcn_readfirstlane(threadIdx.x >> 6); refresh(F);
    F.G = gridDim.x; { const int bx = blockIdx.x; F.vcu = (F.G % 8 == 0) ? (bx % 8) * (F.G / 8) + bx / 8 : bx; }
    F.out = args.out; F.ws = args.ws; F.ctl = (gu32*)(args.ws + WS_CTL);
    for (int u = F.tid; u < (LDS_BYTES - LDSCTL_OFF) / 4; u += NWAVES * 64) ((LAS unsigned*)(F.lds + LDSCTL_OFF))[u] = 0u;
    __syncthreads();
    XcdBarrier bar; bar.bar = (unsigned*)(F.ctl + CW_BAR); bar.x = 0; bar.st = nullptr;
    if (!MK_SPLIT) bar = xcd_barrier_post((unsigned*)(F.ctl + CW_BAR), F.MISC + 8, F.tid == 0);
    const int lo = args.ph_lo, hi = args.ph_hi;
#define IN(k) (lo <= (k) && (k) < hi)
#define SEAM(k) do { if (IN(k) && IN((k) + 1)) { refresh(F); xcd_barrier(bar, F.tid == 0); } } while (0)
    const int gw = F.vcu * NWAVES + F.wave, NGW = F.G * NWAVES;
    float* out = args.out;

    if (IN(0)) { refresh(F); p0_prologue(F, args); } SEAM(0);
    if (IN(1)) { refresh(F); pg8::Gemm g{WSP(bf16, WS_XB), WSP(bf16, WS_W1GU), TP, 2 * DFF, 1024, 1024, 1024}; pg8::StaticOrder S; S.init(TP, 2 * DFF, F.G, (int)blockIdx.x);
        pg8::EpiGateUp E{WSP(bf16, WS_U), WSP(float, WS_RQ0)};
        pg8::gemm_phase<pg8::EpiGateUp, pg8::StaticOrder, PG8_ALIGN, PG8_SP2>(F.lds + RING_OFF, g, S, E, F.wave);
        SAMPLE_SPLIT(pg8::EpiGateUp, E, g, 4, 0); } SEAM(1);
    if (IN(2)) { refresh(F); pg8::Gemm g{WSP(bf16, WS_U), WSP(bf16, WS_W1D), TP, 1024, DFF, DFF, DFF}; pg8::StaticOrder S; S.init(TP, 1024, F.G, (int)blockIdx.x);
        pg8::EpiResid E{WSP(bf16, WS_XB), 0.5f, WSP(float, WS_RQ1), nullptr, nullptr};
        pg8::gemm_phase<pg8::EpiResid, pg8::StaticOrder, PG8_ALIGN, PG8_SP2>(F.lds + RING_OFF, g, S, E, F.wave);
        SAMPLE_SPLIT(pg8::EpiResid, E, g, 11, 1); } SEAM(2);
    if (IN(3)) { refresh(F); pg8::Gemm g{WSP(bf16, WS_XB), WSP(bf16, WS_WIN), TP, NINP, 1024, 1024, 1024}; pg8::StaticOrder S; S.init(TP, NINP, F.G, (int)blockIdx.x);
        pg8::EpiInProj E{WSP(float, WS_RQ1), WSP(bf16, WS_QB), WSP(bf16, WS_KB), WSP(bf16, WS_VB), WSP(bf16, WS_ZG), WSP(bf16, WS_XBC), WSP(float, WS_DTB), args.in[18],
                         out + O_WKP, out + O_WVP, out + O_CVP, out + O_WKS, out + O_WVS, out + O_CVS};
        pg8::gemm_phase<pg8::EpiInProj, pg8::StaticOrder, PG8_ALIGN, PG8_SP2>(F.lds + RING_OFF, g, S, E, F.wave);
        SAMPLE_SPLIT(pg8::EpiInProj, E, g, 4, 2); } SEAM(3);
    if (IN(4)) { refresh(F);
        for (int v = gw; v < TS * NHB; v += NGW) ssd_sample_wave(F, args, v);
        for (int v = gw; v < TS * NHA; v += NGW) attn_sample_wave(F, args, v);
        bc_conv_prepass(F, args);
        attn_mfma_phase<false>(F, args, 0, 1024);
        refresh(F); xcd_barrier(bar, F.tid == 0);
        refresh(F);
        attn_mfma_phase<true>(F, args, 1024, 1536);
        refresh(F);
        for (int u = blockIdx.x; u < NB * NHB; u += F.G) { const int b = u >> 4, hd = u & 15; ssd_mfma_unit(F, args, b, hd, out + O_SSP + (size_t)u * 8192); }
    } SEAM(4);
    if (IN(5)) { refresh(F); bf16* mix = WSP(bf16, WS_MIX); const float* ssqp = WSP(float, WS_SSQP);
        { float* rs2 = WSP(float, WS_RS2);
          for (int m0 = gw * 2; m0 < TP; m0 += 2 * NGW) { const int m = m0 + (F.lane >> 5);
              float pv = ssqp[(size_t)m * 32 + (F.lane & 31)]; pv += __shfl_xor(pv, 1); pv += __shfl_xor(pv, 2); pv += __shfl_xor(pv, 4); pv += __shfl_xor(pv, 8);
              if ((F.lane & 15) == 0) rs2[2 * (size_t)m + ((F.lane >> 4) & 1)] = rsqrtf(pv * (1.f / 512.f) + EPS); } }
        for (int m = TP + gw; m < MROWS; m += NGW) {
            GAS v4u* p = (GAS v4u*)(mix + (size_t)m * 1536 + 512) + F.lane; v4u w0 = p[0], w1 = p[64];
            float pv = ssqp[(size_t)m * 32 + (F.lane & 31)]; pv += __shfl_xor(pv, 1); pv += __shfl_xor(pv, 2); pv += __shfl_xor(pv, 4); pv += __shfl_xor(pv, 8);
            const float s0 = rsqrtf(rdlane(pv, 0) * (1.f / 512.f) + EPS), s1 = rsqrtf(rdlane(pv, 16) * (1.f / 512.f) + EPS);
            float f[8]; unpack8(w0, f); v4u o; o.x = pk2(f[0] * s0, f[1] * s0); o.y = pk2(f[2] * s0, f[3] * s0); o.z = pk2(f[4] * s0, f[5] * s0); o.w = pk2(f[6] * s0, f[7] * s0); p[0] = o;
            unpack8(w1, f); o.x = pk2(f[0] * s1, f[1] * s1); o.y = pk2(f[2] * s1, f[3] * s1); o.z = pk2(f[4] * s1, f[5] * s1); o.w = pk2(f[6] * s1, f[7] * s1); p[64] = o;
        }
    } SEAM(5);
    if (IN(6)) { refresh(F); pg8::Gemm g{WSP(bf16, WS_MIX), WSP(bf16, WS_WOUT), TP, 1024, DMIX, DMIX, DMIX}; pg8::StaticOrder S; S.init(TP, 1024, F.G, (int)blockIdx.x);
        pg8::EpiResidKS EK{WSP(bf16, WS_XB), WSP(float, WS_RQ2), WSP(float, WS_RS2)};
        pg8::gemm_phase<pg8::EpiResidKS, pg8::StaticOrder, PG8_ALIGN, PG8_SP2>(F.lds + RING_OFF, g, S, EK, F.wave);
        pg8::EpiResid E{WSP(bf16, WS_XB), 1.0f, WSP(float, WS_RQ2), nullptr, nullptr};
        SAMPLE_SPLIT(pg8::EpiResid, E, g, 6, 3); } SEAM(6);
    if (IN(7)) { refresh(F);
        { pg8::Gemm g{WSP(bf16, WS_XB), WSP(bf16, WS_WCQ), TP, 1024, 1024, 1024, 1024}; pg8::StaticOrder S; S.init(TP, 1024, F.G, (int)blockIdx.x);
          pg8::EpiScale E{WSP(bf16, WS_QC), 1024, WSP(float, WS_RQ2), 0.0625f};
          pg8::gemm_phase<pg8::EpiScale, pg8::StaticOrder, PG8_ALIGN, PG8_SP2>(F.lds + RING_OFF, g, S, E, F.wave);
          SAMPLE_SPLIT(pg8::EpiScale, E, g, 4, 4); }
        { pg8::Gemm g{WSP(bf16, WS_MEMB), WSP(bf16, WS_WMEM), NB * NMEM, 2048, 1024, 1024, 1024}; pg8::StaticOrder S; S.init(NB * NMEM, 2048, F.G, (int)blockIdx.x);
          pg8::EpiMemKV E{WSP(float, WS_RMEM), out + O_MKP, out + O_MVP, WSP(bf16, WS_MKB), WSP(bf16, WS_MVB)};
          pg8::gemm_phase<pg8::EpiMemKV, pg8::StaticOrder, PG8_ALIGN, PG8_SP2>(F.lds + RING_OFF, g, S, E, F.wave); }
    } SEAM(7);
    if (IN(8)) { refresh(F); for (int pr = blockIdx.x; pr < TS * 4 / 2; pr += F.G) cross_sample_block(F, args, pr);
        cross_mfma_phase(F); } SEAM(8);
    if (IN(9)) { refresh(F); pg8::Gemm g{WSP(bf16, WS_OC), WSP(bf16, WS_WCO), TP, 1024, 1024, 1024, 1024}; pg8::StaticOrder S; S.init(TP, 1024, F.G, (int)blockIdx.x);
        pg8::EpiResid E{WSP(bf16, WS_XB), 1.0f, WSP(float, WS_RQ3), nullptr, nullptr};
        pg8::gemm_phase<pg8::EpiResid, pg8::StaticOrder, PG8_ALIGN, PG8_SP2>(F.lds + RING_OFF, g, S, E, F.wave);
        SAMPLE_SPLIT(pg8::EpiResid, E, g, 4, 5); } SEAM(9);
    if (IN(10)) { refresh(F); pg8::Gemm g{WSP(bf16, WS_XB), WSP(bf16, WS_W2GU), TP, 2 * DFF, 1024, 1024, 1024}; pg8::StaticOrder S; S.init(TP, 2 * DFF, F.G, (int)blockIdx.x);
        pg8::EpiGateUp E{WSP(bf16, WS_U), WSP(float, WS_RQ3)};
        pg8::gemm_phase<pg8::EpiGateUp, pg8::StaticOrder, PG8_ALIGN, PG8_SP2>(F.lds + RING_OFF, g, S, E, F.wave);
        SAMPLE_SPLIT(pg8::EpiGateUp, E, g, 4, 6); } SEAM(10);
    if (IN(11)) { refresh(F); pg8::Gemm g{WSP(bf16, WS_U), WSP(bf16, WS_W2D), TP, 1024, DFF, DFF, DFF}; pg8::StaticOrder S; S.init(TP, 1024, F.G, (int)blockIdx.x);
        pg8::EpiResid E{WSP(bf16, WS_XB), 0.5f, WSP(float, WS_RQ4), nullptr, nullptr};
        pg8::gemm_phase<pg8::EpiResid, pg8::StaticOrder, PG8_ALIGN, PG8_SP2>(F.lds + RING_OFF, g, S, E, F.wave);
        SAMPLE_SPLIT(pg8::EpiResid, E, g, 11, 7); } SEAM(11);
    if (IN(12)) { refresh(F); const float* rq = WSP(float, WS_RQ4); const GAS f32x4* gp = (const GAS f32x4*)args.in[33] + 2 * F.lane; const bf16* xb = WSP(bf16, WS_XB);
        f32x4 gg[2][2];
#pragma unroll
        for (int j = 0; j < 2; ++j) { gg[j][0] = gp[128 * j]; gg[j][1] = gp[128 * j + 1]; }
        for (int m0 = gw; m0 < MROWS; m0 += 4 * NGW) {
            v4u v[4][2]; float rs[4];
#pragma unroll
            for (int q = 0; q < 4; ++q) { const int m = min(m0 + q * NGW, MROWS - 1); { const GAS v4u* p = (const GAS v4u*)(xb + (size_t)m * 1024) + F.lane; v[q][0] = p[0]; v[q][1] = p[64]; rs[q] = rsqrtf(rq[m] * (1.f / 1024.f) + EPS); } }
#pragma unroll
            for (int q = 0; q < 4; ++q) { const int m = m0 + q * NGW; if (m < MROWS) { GAS f32x4* p = (GAS f32x4*)(m < TP ? out + O_YP + (size_t)m * 1024 : out + O_YS + (size_t)(m - TP) * 1024) + 2 * F.lane;
#pragma unroll
                for (int j = 0; j < 2; ++j) { float f[8]; unpack8(v[q][j], f);
                    p[128 * j] = (f32x4){f[0], f[1], f[2], f[3]} * rs[q] * gg[j][0]; p[128 * j + 1] = (f32x4){f[4], f[5], f[6], f[7]} * rs[q] * gg[j][1]; } } }
        }
    }
#undef IN
#undef SEAM
}

extern "C" void kernel_launch(void* const* d_in, const int* in_sizes, int n_in, void* d_out, int out_size, void* d_ws, size_t ws_size, hipStream_t stream) {
    static int grid = 0;
    if (grid == 0) {
        if (n_in != 34 || (size_t)out_size != O_END || ws_size < WS_END) { fprintf(stderr, "kernel_launch: unexpected sizes n_in %d out %d ws %zu\n", n_in, out_size, ws_size); grid = -1; return; }
        int dev = 0, cus = 0, per_cu = 0;
        if (hipGetDevice(&dev) != hipSuccess || hipDeviceGetAttribute(&cus, hipDeviceAttributeMultiprocessorCount, dev) != hipSuccess) { grid = -1; return; }
        if (hipFuncSetAttribute((const void*)hymba_fwd, hipFuncAttributeMaxDynamicSharedMemorySize, LDS_BYTES) != hipSuccess) { fprintf(stderr, "kernel_launch: hipFuncSetAttribute failed\n"); grid = -1; return; }
        if (hipOccupancyMaxActiveBlocksPerMultiprocessor(&per_cu, (const void*)hymba_fwd, NWAVES * 64, LDS_BYTES) != hipSuccess || per_cu < 1) fprintf(stderr, "kernel_launch: occupancy query reports %d\n", per_cu);
        (void)hipGetLastError();
        grid = cus;
    }
    if (grid < 0) return;
    if (hipMemsetAsync((char*)d_ws + WS_CTL, 0, CTL_ZERO_BYTES, stream) != hipSuccess) return;
    Args a{};
    for (int i = 0; i < 34; ++i) a.in[i] = (const float*)d_in[i];
    a.out = (float*)d_out; a.ws = (unsigned char*)d_ws; a.li = 0; a.pad = 0;
#if MK_SPLIT
    for (int ph = 0; ph < NPHASE; ++ph) { a.ph_lo = ph; a.ph_hi = ph + 1; hipLaunchKernelGGL(hymba_fwd, dim3(grid), dim3(NWAVES * 64), LDS_BYTES, stream, a); }
#else
    a.ph_lo = 0; a.ph_hi = NPHASE;
    hipLaunchKernelGGL(hymba_fwd, dim3(grid), dim3(NWAVES * 64), LDS_BYTES, stream, a);
#endif
}
```

```cpp
#include <hip/hip_runtime.h>
#include <cstdio>
#include <cstdint>
namespace pg8 {
#define PG8_LAS __attribute__((address_space(3)))
typedef unsigned short bf16_t;
typedef short bf16x8 __attribute__((ext_vector_type(8)));
typedef float f32x4 __attribute__((ext_vector_type(4)));
typedef unsigned u32x4 __attribute__((ext_vector_type(4)));
constexpr int BM = 256, BK = 64, HALF = 128, HTB = HALF * BK * 2  , STAGE_BYTES = 8 * HTB, NXCD = 8, WGM = 8;

__host__ __device__ __forceinline__ int lds_byte(int r, int c) { const int st = (r >> 4) * 2 + (c >> 5), rr = r & 15, cc = c & 31, ob = rr * 64 + cc * 2; return st * 1024 + (ob ^ (((ob >> 9) & 1) << 5)); }
__host__ __device__ __forceinline__ void stage_rc(int b, int& R, int& C) { const int st = b / 1024, sb = b % 1024, swz = sb ^ (((sb >> 9) & 1) << 5); R = (st >> 1) * 16 + swz / 64; C = (st & 1) * 32 + (swz % 64) / 2; }
__host__ __device__ __forceinline__ int perm32(int rho) { const int n = rho >> 4, i = rho & 15; return 8 * (i >> 2) + 4 * n + (i & 3); }

struct Unit { int pm, pn, koff, ks; };
struct Gemm { const bf16_t* A; const bf16_t* Bt; int M, N, K, lda, ldb; };

struct StaticOrder {
    int nM, nN, nwg, G, c;
    __host__ __device__ void init(int M, int N, int G_, int c_) { nM = M / BM; nN = N / BM; nwg = nM * nN; G = G_; c = c_; }
    __host__ __device__ bool next(int i, Unit& u) const {
        const long L = (long)i * G + c; if (L >= nwg) return false;
        int wgid = (int)L; { const int q = nwg / NXCD, r = nwg % NXCD, xcd = wgid % NXCD, off = wgid / NXCD; wgid = (xcd < r ? xcd * (q + 1) : r * (q + 1) + (xcd - r) * q) + off; }
        const int nig = WGM * nN, gid = wgid / nig, fm = gid * WGM, gsz = (nM - fm) < WGM ? (nM - fm) : WGM;
        u.pm = fm + ((wgid % nig) % gsz); u.pn = (wgid % nig) / gsz; u.koff = 0; u.ks = 0; return true;
    }
    __device__ __forceinline__ void a_ready(const Unit&) const {}
    __device__ __forceinline__ void done(const Unit&) const {}
};
__device__ __forceinline__ unsigned cvt_pk_bf16(float lo, float hi) { unsigned r; asm volatile("v_cvt_pk_bf16_f32 %0, %1, %2" : "=v"(r) : "v"(lo), "v"(hi)); return r; }
typedef float f32x2 __attribute__((ext_vector_type(2)));
template <class Epi, class Sched, bool ALIGN_EPI = false, bool SP2 = false>
__device__ __forceinline__ void gemm_phase(PG8_LAS unsigned char* lds, const Gemm g, const Sched& S, const Epi& E, const int wid) {
    int lane; asm volatile("v_mbcnt_lo_u32_b32 %0, -1, 0\n\tv_mbcnt_hi_u32_b32 %0, -1, %0" : "=v"(lane));
    const int tid = wid * 64 + lane, wr = wid >> 2, wc = wid & 3, fr = lane & 15, fq = lane >> 4;
    const int K = g.K, nt = K / BK;
    unsigned voffA[2], voffB[2];
#pragma unroll
    for (int i = 0; i < 2; ++i) { int R, C; stage_rc(tid * 16 + i * 8192, R, C); const int Rb = Epi::PERM ? ((R & ~31) + perm32(R & 31)) : R;
        voffA[i] = (unsigned)(R * g.lda + C) * 2u; voffB[i] = (unsigned)(Rb * g.ldb + C) * 2u; }
    const size_t kstep = (size_t)(BK * 2);
    const size_t hstepA = (size_t)HALF * g.lda * 2, hstepB = (size_t)HALF * g.ldb * 2;
    const size_t tstepA = 2 * hstepA, tstepB = 2 * hstepB;
    const unsigned ldsw = (unsigned)wid * 1024u;
    const int aoff = lds_byte(wr * 64 + fr, fq * 8), boff = lds_byte(wc * 32 + fr, fq * 8);
#define PG8_SA(b, h) (((b) * 2 + (h)) * HTB)
#define PG8_SB(b, h) ((4 + (b) * 2 + (h)) * HTB)
#define PG8_STAGE(bufoff, gbase, voff) do { _Pragma("unroll") for (int _i = 0; _i < 2; ++_i) \
        __builtin_amdgcn_global_load_lds((const unsigned*)((const char*)(gbase) + (voff)[_i]), (PG8_LAS unsigned*)(lds + (bufoff) + ldsw + _i * 8192), 16, 0, 0); } while (0)
#define PG8_LDA(dst, b, h) do { _Pragma("unroll") for (int m = 0; m < 4; ++m) _Pragma("unroll") for (int k = 0; k < 2; ++k) dst[m][k] = *(const PG8_LAS bf16x8*)(lds + PG8_SA(b, h) + aoff + m * 2048 + k * 1024); } while (0)
#define PG8_LDB(dst, b, h) do { _Pragma("unroll") for (int n = 0; n < 2; ++n) _Pragma("unroll") for (int k = 0; k < 2; ++k) dst[n][k] = *(const PG8_LAS bf16x8*)(lds + PG8_SB(b, h) + boff + n * 2048 + k * 1024); } while (0)
#define PG8_MMA(ai, bj, At, Bt) do { __builtin_amdgcn_s_setprio(1); _Pragma("unroll") for (int m = 0; m < 4; ++m) _Pragma("unroll") for (int n = 0; n < 2; ++n) _Pragma("unroll") for (int k = 0; k < 2; ++k) \
        acc[ai][bj][m][n] = __builtin_amdgcn_mfma_f32_16x16x32_bf16(Bt[n][k], At[m][k], acc[ai][bj][m][n], 0, 0, 0); __builtin_amdgcn_s_setprio(0); } while (0)
#define PG8_WAIT_V(n) asm volatile("s_waitcnt vmcnt(" #n ")" ::: "memory")
#define PG8_WAIT_L(n) asm volatile("s_waitcnt lgkmcnt(" #n ")" ::: "memory")
#define PG8_BAR __builtin_amdgcn_s_barrier()
#define PG8_SCHED __builtin_amdgcn_sched_barrier(0)
    Unit cur, nxt; int ui = 0;
    if (!S.next(0, cur)) return;
    float pre[8] = {0.f, 0.f, 0.f, 0.f, 0.f, 0.f, 0.f, 0.f};
    f32x4 acc[2][2][4][2];
#pragma unroll
    for (int a = 0; a < 2; ++a)
#pragma unroll
        for (int b = 0; b < 2; ++b)
#pragma unroll
            for (int m = 0; m < 4; ++m)
#pragma unroll
                for (int n = 0; n < 2; ++n) acc[a][b][m][n] = (f32x4){0.f, 0.f, 0.f, 0.f};
    bf16x8 At[4][2], B0[2][2], B1[2][2];
    const char* cA = (const char*)g.A + (size_t)cur.pm * tstepA + cur.koff; const char* cB = (const char*)g.Bt + (size_t)cur.pn * tstepB + cur.koff;
    S.a_ready(cur);
    if constexpr (SP2) {
        PG8_STAGE(PG8_SB(0, 0), cB, voffB); PG8_STAGE(PG8_SB(0, 1), cB + hstepB, voffB); PG8_STAGE(PG8_SA(0, 0), cA, voffA); PG8_STAGE(PG8_SA(0, 1), cA + hstepA, voffA);
        if (wr == 1) PG8_BAR;
        PG8_WAIT_V(2); PG8_BAR;
        PG8_STAGE(PG8_SB(1, 0), cB + kstep, voffB); PG8_STAGE(PG8_SA(1, 0), cA + kstep, voffA); PG8_STAGE(PG8_SB(1, 1), cB + hstepB + kstep, voffB);
        PG8_WAIT_V(6); PG8_BAR;
    } else {
        PG8_STAGE(PG8_SB(0, 0), cB, voffB); PG8_STAGE(PG8_SA(0, 0), cA, voffA); PG8_STAGE(PG8_SB(0, 1), cB + hstepB, voffB); PG8_STAGE(PG8_SA(0, 1), cA + hstepA, voffA);
        if (wr == 1) PG8_BAR;
        PG8_WAIT_V(4); PG8_BAR;
        PG8_STAGE(PG8_SB(1, 0), cB + kstep, voffB); PG8_STAGE(PG8_SA(1, 0), cA + kstep, voffA); PG8_STAGE(PG8_SB(1, 1), cB + hstepB + kstep, voffB);
        PG8_WAIT_V(6); PG8_BAR;
    }
    for (;;) {
        const bool has_next = S.next(ui + 1, nxt);
        const char* nA = has_next ? (const char*)g.A + (size_t)nxt.pm * tstepA + nxt.koff : cA; const char* nB = has_next ? (const char*)g.Bt + (size_t)nxt.pn * tstepB + nxt.koff : cB;
        for (int t = 0; t < nt; t += 2) {
            if constexpr (Epi::KSEG > 0) { if (t == Epi::KSEG || t == 2 * Epi::KSEG) E.kseg(acc, cur, t, wr, fr); }
            if constexpr (Epi::PRE) { if (t == nt - 2) E.preload(cur, wr, fr, pre); }
            const bool last = (t == nt - 2);
            const char* a1 = cA + (size_t)(t + 1) * kstep;
            const char* a2 = last ? nA : cA + (size_t)(t + 2) * kstep; const char* b2 = last ? nB : cB + (size_t)(t + 2) * kstep;
            const char* a3 = a2 + kstep; const char* b3 = b2 + kstep;
            if (last && has_next) S.a_ready(nxt);
            if constexpr (SP2) {
            PG8_LDB(B0, 0, 0); PG8_LDB(B1, 0, 1); PG8_SCHED; PG8_LDA(At, 0, 0); PG8_STAGE(PG8_SA(1, 1), a1 + hstepA, voffA);
            PG8_WAIT_V(8); PG8_WAIT_L(0); PG8_BAR; PG8_MMA(0, 0, At, B0); PG8_MMA(0, 1, At, B1); PG8_BAR; PG8_SCHED;
            PG8_LDA(At, 0, 1); PG8_STAGE(PG8_SB(0, 0), b2, voffB); PG8_STAGE(PG8_SB(0, 1), b2 + hstepB, voffB); PG8_STAGE(PG8_SA(0, 0), a2, voffA);
            PG8_WAIT_V(8); PG8_WAIT_L(0); PG8_BAR; PG8_MMA(1, 0, At, B0); PG8_MMA(1, 1, At, B1); PG8_BAR; PG8_SCHED;
            PG8_LDB(B0, 1, 0); PG8_LDB(B1, 1, 1); PG8_SCHED; PG8_LDA(At, 1, 0); PG8_STAGE(PG8_SA(0, 1), a2 + hstepA, voffA);
            PG8_WAIT_V(8); PG8_WAIT_L(0); PG8_BAR; PG8_MMA(0, 0, At, B0); PG8_MMA(0, 1, At, B1); PG8_BAR; PG8_SCHED;
            PG8_LDA(At, 1, 1); PG8_STAGE(PG8_SB(1, 0), b3, voffB); PG8_STAGE(PG8_SB(1, 1), b3 + hstepB, voffB); PG8_STAGE(PG8_SA(1, 0), a3, voffA);
            PG8_WAIT_V(8); PG8_WAIT_L(0); PG8_BAR; PG8_MMA(1, 0, At, B0); PG8_MMA(1, 1, At, B1); PG8_BAR; PG8_SCHED;
            } else {
            PG8_LDB(B0, 0, 0); PG8_SCHED; PG8_LDA(At, 0, 0); PG8_STAGE(PG8_SA(1, 1), a1 + hstepA, voffA);
            PG8_WAIT_L(8); PG8_BAR; PG8_WAIT_L(0); PG8_MMA(0, 0, At, B0); PG8_BAR; PG8_SCHED;
            PG8_LDB(B1, 0, 1); PG8_STAGE(PG8_SB(0, 0), b2, voffB);
            PG8_BAR; PG8_WAIT_L(0); PG8_MMA(0, 1, At, B1); PG8_BAR;
            PG8_LDA(At, 0, 1); PG8_STAGE(PG8_SA(0, 0), a2, voffA);
            PG8_BAR; PG8_WAIT_L(0); PG8_MMA(1, 0, At, B0); PG8_BAR; PG8_SCHED;
            PG8_STAGE(PG8_SB(0, 1), b2 + hstepB, voffB);
            PG8_WAIT_V(6); PG8_BAR; PG8_MMA(1, 1, At, B1); PG8_BAR;
            PG8_LDB(B0, 1, 0); PG8_SCHED; PG8_LDA(At, 1, 0); PG8_STAGE(PG8_SA(0, 1), a2 + hstepA, voffA);
            PG8_WAIT_L(8); PG8_BAR; PG8_WAIT_L(0); PG8_MMA(0, 0, At, B0); PG8_BAR; PG8_SCHED;
            PG8_LDB(B1, 1, 1); PG8_STAGE(PG8_SB(1, 0), b3, voffB);
            PG8_BAR; PG8_WAIT_L(0); PG8_MMA(0, 1, At, B1); PG8_BAR;
            PG8_LDA(At, 1, 1); PG8_STAGE(PG8_SA(1, 0), a3, voffA);
            PG8_BAR; PG8_WAIT_L(0); PG8_MMA(1, 0, At, B0); PG8_BAR; PG8_SCHED;
            PG8_STAGE(PG8_SB(1, 1), b3 + hstepB, voffB);
            PG8_WAIT_V(6); PG8_BAR; PG8_MMA(1, 1, At, B1); PG8_BAR;
            }
        }
        if constexpr (ALIGN_EPI) { if (wr == 0) PG8_BAR; }
        if constexpr (!Epi::AFTER_DRAIN) { if constexpr (Epi::PRE) E(acc, cur, wr, wc, fr, fq, pre); else E(acc, cur, wr, wc, fr, fq); S.done(cur); }
        if (!has_next) break;
#pragma unroll
        for (int a = 0; a < 2; ++a)
#pragma unroll
            for (int b = 0; b < 2; ++b)
#pragma unroll
                for (int m = 0; m < 4; ++m)
#pragma unroll
                    for (int n = 0; n < 2; ++n) acc[a][b][m][n] = (f32x4){0.f, 0.f, 0.f, 0.f};
        cur = nxt; cA = nA; cB = nB; ++ui;
        if constexpr (ALIGN_EPI) { if (wr == 1) PG8_BAR; }
    }
    PG8_WAIT_V(0);
    if constexpr (!ALIGN_EPI) { if (wr == 0) PG8_BAR; }
    PG8_BAR;
    if constexpr (Epi::AFTER_DRAIN) { E.fused(acc, cur, wr, wc, fr, fq, lds, wid, lane); S.done(cur); }
#undef PG8_SA
#undef PG8_SB
#undef PG8_STAGE
#undef PG8_LDA
#undef PG8_LDB
#undef PG8_MMA
#undef PG8_WAIT_V
#undef PG8_WAIT_L
#undef PG8_BAR
#undef PG8_SCHED
}
}

#define GAS __attribute__((address_space(1)))
#define LAS __attribute__((address_space(3)))
typedef unsigned short bf16;
typedef unsigned v4u __attribute__((ext_vector_type(4)));
typedef unsigned v2u __attribute__((ext_vector_type(2)));
typedef float f32x4 __attribute__((ext_vector_type(4)));
typedef GAS unsigned gu32;
#define RLX_AGENT __ATOMIC_RELAXED, __HIP_MEMORY_SCOPE_AGENT
#define LDS_WAIT() asm volatile("s_waitcnt lgkmcnt(0)" ::: "memory")
#define VM_WAIT() asm volatile("s_waitcnt vmcnt(0)" ::: "memory")
#define LBAR() do { asm volatile("s_waitcnt lgkmcnt(0)" ::: "memory"); __builtin_amdgcn_s_barrier(); asm volatile("" ::: "memory"); } while (0)

constexpr int DM = 1024, NB = 32, SEQ = 2048, TP = NB * SEQ, TS = 128, MROWS = TP + TS, MT = 65792;
constexpr int DATT = 512, DINNER = 1024, DXBC = 1536, DMIX = 1536, DFF = 2816, NIN = 4112, NINP = 4352, NHA = 8, NHB = 16, NMEM = 256;
constexpr float EPS = 1e-6f;
constexpr size_t O_YP = 0, O_YS = 67108864, O_WKP = 67239936, O_WVP = 100794368, O_CVP = 134348800, O_SSP = 134496256, O_MKP = 138690560, O_MVP = 147079168,
                 O_WKS = 155467776, O_WVS = 155533312, O_CVS = 155598848, O_SSS = 156188672, O_END = 172965888;
constexpr size_t MiB = 1u << 20;
constexpr size_t WS_CTL = 0, CTL_ZERO_BYTES = 4 * MiB;
constexpr size_t WS_RQ1 = 1 * MiB, WS_RQ2 = WS_RQ1 + 512 * 1024, WS_RQ3 = 2 * MiB, WS_RQ4 = WS_RQ3 + 512 * 1024, WS_SSQ = 3 * MiB;
constexpr size_t WS_RQ0 = 4 * MiB, WS_RMEM = WS_RQ0 + 512 * 1024, WS_RS2 = 5 * MiB;
constexpr size_t WS_W1GU = 8 * MiB, WS_W1D = 19 * MiB, WS_WIN = 25 * MiB, WS_WOUT = 34 * MiB, WS_WCQ = 37 * MiB, WS_WCO = 39 * MiB, WS_WMEM = 41 * MiB, WS_W2GU = 45 * MiB, WS_W2D = 56 * MiB;
constexpr size_t WS_XB = 64 * MiB, WS_U = 193 * MiB, WS_QB = 547 * MiB, WS_KB = 612 * MiB, WS_VB = 677 * MiB, WS_ZG = 742 * MiB, WS_XBC = 871 * MiB, WS_DTB = 1064 * MiB,
                 WS_MIX = 1069 * MiB, WS_QC = 1262 * MiB, WS_OC = 1391 * MiB, WS_MEMB = 1520 * MiB, WS_MKB = 1536 * MiB, WS_MVB = 1552 * MiB, WS_SLAB = 1568 * MiB, WS_END = 1584 * MiB;
constexpr int CW_BAR = 4096, CW_TICK = 16384, TICK_WORDS = 22 * 8 * 16;
constexpr int RING_OFF = 0, RING_BYTES = 131072, LDS_BYTES = 147456, LDSCTL_OFF = LDS_BYTES - 512, MISC_OFF = LDSCTL_OFF + 320;
constexpr int NWAVES = 8;
#ifndef MK_SPLIT
#define MK_SPLIT 0
#endif
constexpr int NPHASE = 13;

__device__ __forceinline__ float bf2f(unsigned b) { return __uint_as_float(b << 16); }
__device__ __forceinline__ unsigned f2bf(float f) { unsigned u = __float_as_uint(f); return (u + 0x7fffu + ((u >> 16) & 1u)) >> 16; }
__device__ __forceinline__ unsigned pk2(float lo, float hi) { return f2bf(lo) | (f2bf(hi) << 16); }
__device__ __forceinline__ float silu_f(float x) { return x * __builtin_amdgcn_rcpf(1.f + __expf(-x)); }
__device__ __forceinline__ float wave_sum(float v) {
#pragma unroll
    for (int o = 1; o < 64; o <<= 1) v += __shfl_xor(v, o);
    return v;
}
__device__ __forceinline__ float wave_max(float v) {
#pragma unroll
    for (int o = 1; o < 64; o <<= 1) v = fmaxf(v, __shfl_xor(v, o));
    return v;
}
__device__ __forceinline__ float rdlane(float v, int l) { return __int_as_float(__builtin_amdgcn_readlane(__float_as_int(v), l)); }
__device__ __forceinline__ void unpack8(const v4u w, float* f) {
    f[0] = __uint_as_float(w.x << 16); f[1] = __uint_as_float(w.x & 0xffff0000u); f[2] = __uint_as_float(w.y << 16); f[3] = __uint_as_float(w.y & 0xffff0000u);
    f[4] = __uint_as_float(w.z << 16); f[5] = __uint_as_float(w.z & 0xffff0000u); f[6] = __uint_as_float(w.w << 16); f[7] = __uint_as_float(w.w & 0xffff0000u);
}

namespace pg8 {
struct EpiGateUp {
    static constexpr bool PERM = true, AFTER_DRAIN = false; static constexpr int KSEG = 0; static constexpr bool PRE = true;
    bf16_t* U; const float* rq;
    __device__ __forceinline__ void preload(const Unit& u, int wr, int fr, float (&pre)[8]) const {
        const int row0 = u.pm * BM + wr * 64 + fr;
#pragma unroll
        for (int ai = 0; ai < 2; ++ai)
#pragma unroll
            for (int m = 0; m < 4; ++m) pre[ai * 4 + m] = rq[row0 + ai * HALF + m * 16];
    }
    __device__ __forceinline__ void operator()(const f32x4 (&acc)[2][2][4][2], const Unit& u, int wr, int wc, int fr, int fq, const float (&pre)[8]) const {
        const int row0 = u.pm * BM + wr * 64 + fr, col0 = u.pn * 128 + wc * 32 + 8 * fq;
#pragma unroll
        for (int ai = 0; ai < 2; ++ai)
#pragma unroll
            for (int m = 0; m < 4; ++m) {
                const int row = row0 + ai * HALF + m * 16; const float rs = rsqrtf(pre[ai * 4 + m] * (1.f / 1024.f) + 1e-6f);
                f32x2 o[4];
#pragma unroll
                for (int n = 0; n < 2; ++n)
#pragma unroll
                    for (int jp = 0; jp < 2; ++jp) { const f32x2 ga = {acc[ai][0][m][n][2 * jp], acc[ai][0][m][n][2 * jp + 1]}, ua = {acc[ai][1][m][n][2 * jp], acc[ai][1][m][n][2 * jp + 1]};
                        const f32x2 g = ga * rs, t = ga * (rs * -1.44269504f), uu = ua * rs;
                        f32x2 e; e.x = __builtin_amdgcn_exp2f(t.x); e.y = __builtin_amdgcn_exp2f(t.y);
                        const f32x2 d = e + 1.0f; f32x2 r; r.x = __builtin_amdgcn_rcpf(d.x); r.y = __builtin_amdgcn_rcpf(d.y);
                        o[2 * n + jp] = (g * r) * uu; }
                u32x4 w; w.x = cvt_pk_bf16(o[0].x, o[0].y); w.y = cvt_pk_bf16(o[1].x, o[1].y); w.z = cvt_pk_bf16(o[2].x, o[2].y); w.w = cvt_pk_bf16(o[3].x, o[3].y);
                *(u32x4*)(U + (size_t)row * 2816 + col0) = w; }
    }
};
struct EpiResid {
    static constexpr bool PERM = true, AFTER_DRAIN = false; static constexpr int KSEG = 0; static constexpr bool PRE = false;
    bf16_t* X; float alpha; float* rq; float* yp; float* ys;
    __device__ __forceinline__ void operator()(const f32x4 (&acc)[2][2][4][2], const Unit& u, int wr, int wc, int fr, int fq) const {
        const int row0 = u.pm * BM + wr * 64 + fr, col0 = u.pn * BM + wc * 32 + 8 * fq;
#pragma unroll
        for (int ai = 0; ai < 2; ++ai)
#pragma unroll
            for (int m = 0; m < 4; ++m) {
                const int row = row0 + ai * HALF + m * 16; float ss = 0.f;
#pragma unroll
                for (int bj = 0; bj < 2; ++bj) {
                    const int col = col0 + bj * HALF; bf16_t* xp = X + (size_t)row * 1024 + col;
                    const u32x4 ow = *(const u32x4*)xp; float v[8];
                    { f32x2 p0 = {__uint_as_float(ow.x << 16), __uint_as_float(ow.x & 0xffff0000u)}, p1 = {__uint_as_float(ow.y << 16), __uint_as_float(ow.y & 0xffff0000u)},
                            p2 = {__uint_as_float(ow.z << 16), __uint_as_float(ow.z & 0xffff0000u)}, p3 = {__uint_as_float(ow.w << 16), __uint_as_float(ow.w & 0xffff0000u)};
                      const f32x4 a0 = acc[ai][bj][m][0], a1 = acc[ai][bj][m][1];
                      p0 = p0 + (f32x2){a0[0], a0[1]} * alpha; p1 = p1 + (f32x2){a0[2], a0[3]} * alpha; p2 = p2 + (f32x2){a1[0], a1[1]} * alpha; p3 = p3 + (f32x2){a1[2], a1[3]} * alpha;
                      const f32x2 q = (p0 * p0 + p1 * p1) + (p2 * p2 + p3 * p3); ss += q.x + q.y;
                      v[0] = p0.x; v[1] = p0.y; v[2] = p1.x; v[3] = p1.y; v[4] = p2.x; v[5] = p2.y; v[6] = p3.x; v[7] = p3.y; }
                    if (yp) {
                        float* dst = row < 65536 ? yp + (size_t)row * 1024 + col : (row < 65664 ? ys + (size_t)(row - 65536) * 1024 + col : nullptr);
                        if (dst) { *(f32x4*)dst = (f32x4){v[0], v[1], v[2], v[3]}; *(f32x4*)(dst + 4) = (f32x4){v[4], v[5], v[6], v[7]}; }
                    } else {
                        u32x4 w; w.x = cvt_pk_bf16(v[0], v[1]); w.y = cvt_pk_bf16(v[2], v[3]); w.z = cvt_pk_bf16(v[4], v[5]); w.w = cvt_pk_bf16(v[6], v[7]);
                        *(u32x4*)xp = w; }
                }
                ss += __shfl_xor(ss, 16); ss += __shfl_xor(ss, 32);
                if (fq == 0) unsafeAtomicAdd(rq + row, ss);
            }
    }
};

struct EpiResidKS {
    static constexpr bool PERM = true, AFTER_DRAIN = false; static constexpr int KSEG = 8; static constexpr bool PRE = false;
    bf16_t* X; float* rq; const float* rs2;
    __device__ __forceinline__ void kseg(f32x4 (&acc)[2][2][4][2], const Unit& u, int t, int wr, int fr) const {
        const int row0 = u.pm * BM + wr * 64 + fr;
#pragma unroll
        for (int ai = 0; ai < 2; ++ai)
#pragma unroll
            for (int m = 0; m < 4; ++m) { const int row = row0 + ai * HALF + m * 16; const f32x2 sv = *(const f32x2*)(rs2 + 2 * row);
                const float f = (t == KSEG) ? __builtin_amdgcn_rcpf(sv.x) : sv.x * __builtin_amdgcn_rcpf(sv.y);
#pragma unroll
                for (int bj = 0; bj < 2; ++bj)
#pragma unroll
                    for (int n = 0; n < 2; ++n) acc[ai][bj][m][n] = acc[ai][bj][m][n] * f; }
    }
    __device__ __forceinline__ void operator()(const f32x4 (&acc)[2][2][4][2], const Unit& u, int wr, int wc, int fr, int fq) const {
        const int row0 = u.pm * BM + wr * 64 + fr, col0 = u.pn * BM + wc * 32 + 8 * fq;
#pragma unroll
        for (int ai = 0; ai < 2; ++ai)
#pragma unroll
            for (int m = 0; m < 4; ++m) {
                const int row = row0 + ai * HALF + m * 16; float ss = 0.f; const float alpha = rs2[2 * (size_t)row + 1];
#pragma unroll
                for (int bj = 0; bj < 2; ++bj) {
                    const int col = col0 + bj * HALF; bf16_t* xp = X + (size_t)row * 1024 + col;
                    const u32x4 ow = *(const u32x4*)xp; float v[8];
                    { f32x2 p0 = {__uint_as_float(ow.x << 16), __uint_as_float(ow.x & 0xffff0000u)}, p1 = {__uint_as_float(ow.y << 16), __uint_as_float(ow.y & 0xffff0000u)},
                            p2 = {__uint_as_float(ow.z << 16), __uint_as_float(ow.z & 0xffff0000u)}, p3 = {__uint_as_float(ow.w << 16), __uint_as_float(ow.w & 0xffff0000u)};
                      const f32x4 a0 = acc[ai][bj][m][0], a1 = acc[ai][bj][m][1];
                      p0 = p0 + (f32x2){a0[0], a0[1]} * alpha; p1 = p1 + (f32x2){a0[2], a0[3]} * alpha; p2 = p2 + (f32x2){a1[0], a1[1]} * alpha; p3 = p3 + (f32x2){a1[2], a1[3]} * alpha;
                      const f32x2 q = (p0 * p0 + p1 * p1) + (p2 * p2 + p3 * p3); ss += q.x + q.y;
                      v[0] = p0.x; v[1] = p0.y; v[2] = p1.x; v[3] = p1.y; v[4] = p2.x; v[5] = p2.y; v[6] = p3.x; v[7] = p3.y; }
                    u32x4 w; w.x = cvt_pk_bf16(v[0], v[1]); w.y = cvt_pk_bf16(v[2], v[3]); w.z = cvt_pk_bf16(v[4], v[5]); w.w = cvt_pk_bf16(v[6], v[7]);
                    *(u32x4*)xp = w;
                }
                ss += __shfl_xor(ss, 16); ss += __shfl_xor(ss, 32);
                if (fq == 0) unsafeAtomicAdd(rq + row, ss);
            }
    }
};
struct EpiScale {
    static constexpr bool PERM = true, AFTER_DRAIN = false; static constexpr int KSEG = 0; static constexpr bool PRE = false;
    bf16_t* O; int ldc; const float* rq; float scale;
    __device__ __forceinline__ void operator()(const f32x4 (&acc)[2][2][4][2], const Unit& u, int wr, int wc, int fr, int fq) const {
        const int row0 = u.pm * BM + wr * 64 + fr, col0 = u.pn * BM + wc * 32 + 8 * fq;
#pragma unroll
        for (int ai = 0; ai < 2; ++ai)
#pragma unroll
            for (int m = 0; m < 4; ++m) {
                const int row = row0 + ai * HALF + m * 16; const float rs = rsqrtf(rq[row] * (1.f / 1024.f) + 1e-6f) * scale;
#pragma unroll
                for (int bj = 0; bj < 2; ++bj) { const f32x4 v0 = acc[ai][bj][m][0] * rs, v1 = acc[ai][bj][m][1] * rs;
                    u32x4 w; w.x = cvt_pk_bf16(v0[0], v0[1]); w.y = cvt_pk_bf16(v0[2], v0[3]); w.z = cvt_pk_bf16(v1[0], v1[1]); w.w = cvt_pk_bf16(v1[2], v1[3]);
                    *(u32x4*)(O + (size_t)row * ldc + col0 + bj * HALF) = w; } }
    }
};
struct EpiMemKV {
    static constexpr bool PERM = true, AFTER_DRAIN = false; static constexpr int KSEG = 0; static constexpr bool PRE = false;
    const float* rmem; float* mkp; float* mvp; bf16_t* mkb; bf16_t* mvb;
    __device__ __forceinline__ void operator()(const f32x4 (&acc)[2][2][4][2], const Unit& u, int wr, int wc, int fr, int fq) const {
        const int row0 = u.pm * BM + wr * 64 + fr; const bool isv = u.pn >= 4; const int col0 = (u.pn & 3) * BM + wc * 32 + 8 * fq;
        float* of = isv ? mvp : mkp; bf16_t* ob = isv ? mvb : mkb;
#pragma unroll
        for (int ai = 0; ai < 2; ++ai)
#pragma unroll
            for (int m = 0; m < 4; ++m) {
                const int row = row0 + ai * HALF + m * 16; const float rs = rmem[row];
#pragma unroll
                for (int bj = 0; bj < 2; ++bj) { const f32x4 v0 = acc[ai][bj][m][0] * rs, v1 = acc[ai][bj][m][1] * rs; const size_t o = (size_t)row * 1024 + col0 + bj * HALF;
                    *(f32x4*)(of + o) = v0; *(f32x4*)(of + o + 4) = v1;
                    u32x4 w; w.x = cvt_pk_bf16(v0[0], v0[1]); w.y = cvt_pk_bf16(v0[2], v0[3]); w.z = cvt_pk_bf16(v1[0], v1[1]); w.w = cvt_pk_bf16(v1[2], v1[3]);
                    *(u32x4*)(ob + o) = w; } }
    }
};
struct EpiInProj {
    static constexpr bool PERM = true, AFTER_DRAIN = false; static constexpr int KSEG = 0; static constexpr bool PRE = false;
    const float* rq; bf16_t* qb; bf16_t* kb; bf16_t* vb; bf16_t* zg; bf16_t* xbc; float* dtb; const float* dt_bias;
    float* wkp; float* wvp; float* cvp; float* wks; float* wvs; float* cvs;
    __device__ __forceinline__ void operator()(const f32x4 (&acc)[2][2][4][2], const Unit& u, int wr, int wc, int fr, int fq) const {
        const int row0 = u.pm * BM + wr * 64 + fr, c0 = wc * 32 + 8 * fq, pn = u.pn;
#pragma unroll
        for (int ai = 0; ai < 2; ++ai)
#pragma unroll
            for (int m = 0; m < 4; ++m) {
                const int row = row0 + ai * HALF + m * 16; const float rs = rsqrtf(rq[row] * (1.f / 1024.f) + 1e-6f);
#pragma unroll
                for (int bj = 0; bj < 2; ++bj) {
                    const int c8 = c0 + bj * HALF; f32x4 v0 = acc[ai][bj][m][0] * rs, v1 = acc[ai][bj][m][1] * rs;
                    if (pn < 2) {
                        v0 = v0 * 0.180336880f; v1 = v1 * 0.180336880f;
                        u32x4 w; w.x = cvt_pk_bf16(v0[0], v0[1]); w.y = cvt_pk_bf16(v0[2], v0[3]); w.z = cvt_pk_bf16(v1[0], v1[1]); w.w = cvt_pk_bf16(v1[2], v1[3]);
                        *(u32x4*)(qb + (size_t)row * 512 + pn * 256 + c8) = w;
                    } else if (pn < 6) {
                        const bool isv = pn >= 4; const int col = (pn & 1) * 256 + c8;
                        u32x4 w; w.x = cvt_pk_bf16(v0[0], v0[1]); w.y = cvt_pk_bf16(v0[2], v0[3]); w.z = cvt_pk_bf16(v1[0], v1[1]); w.w = cvt_pk_bf16(v1[2], v1[3]);
                        *(u32x4*)((isv ? vb : kb) + (size_t)row * 512 + col) = w;
                        float* dst = row < 65536 ? (isv ? wvp : wkp) + (size_t)row * 512 + col : (row < 65664 ? (isv ? wvs : wks) + (size_t)(row - 65536) * 512 + col : nullptr);
                        if (dst) { *(f32x4*)dst = v0; *(f32x4*)(dst + 4) = v1; }
                    } else if (pn < 10) {
                        float o[8];
#pragma unroll
                        for (int j = 0; j < 4; ++j) { o[j] = v0[j] * __builtin_amdgcn_rcpf(1.f + __expf(-v0[j])); o[4 + j] = v1[j] * __builtin_amdgcn_rcpf(1.f + __expf(-v1[j])); }
                        u32x4 w; w.x = cvt_pk_bf16(o[0], o[1]); w.y = cvt_pk_bf16(o[2], o[3]); w.z = cvt_pk_bf16(o[4], o[5]); w.w = cvt_pk_bf16(o[6], o[7]);
                        *(u32x4*)(zg + (size_t)row * 1024 + (pn - 6) * 256 + c8) = w;
                    } else if (pn < 16) {
                        const int col = (pn - 10) * 256 + c8;
                        u32x4 w; w.x = cvt_pk_bf16(v0[0], v0[1]); w.y = cvt_pk_bf16(v0[2], v0[3]); w.z = cvt_pk_bf16(v1[0], v1[1]); w.w = cvt_pk_bf16(v1[2], v1[3]);
                        *(u32x4*)(xbc + (size_t)row * 1536 + col) = w;
                        float* dst = nullptr;
                        if (row < 65536) { const int t = row & 2047; if (t >= 2045) dst = cvp + ((size_t)(row >> 11) * 3 + (t - 2045)) * 1536 + col; }
                        else if (row < 65664) dst = cvs + ((size_t)(row - 65536) * 3 + 2) * 1536 + col;
                        if (dst) { *(f32x4*)dst = v0; *(f32x4*)(dst + 4) = v1; }
                    } else {
                        if (c8 < 16) {
                            float o[8];
#pragma unroll
                            for (int j = 0; j < 8; ++j) { const float x = (j < 4 ? v0[j & 3] : v1[j & 3]) + dt_bias[c8 + j]; o[j] = fmaxf(x, 0.f) + log1pf(__expf(-fabsf(x))); }
                            float* dst = dtb + (size_t)row * 16 + c8; *(f32x4*)dst = (f32x4){o[0], o[1], o[2], o[3]}; *(f32x4*)(dst + 4) = (f32x4){o[4], o[5], o[6], o[7]};
                        }
                    }
                }
            }
    }
};

struct SplitOrder {
    int nN, KS, G, c, kbytes;
    __host__ __device__ void init(int N, int KS_, int kper, int G_, int c_) { nN = N / BM; KS = KS_; G = G_; c = c_; kbytes = kper * 2; }
    __host__ __device__ bool next(int i, Unit& u) const { const int L = i * G + c; if (L >= nN * KS) return false; u.pm = 256; u.pn = L % nN; u.ks = L / nN; u.koff = u.ks * kbytes; return true; }
    __device__ __forceinline__ void a_ready(const Unit&) const {}
    __device__ __forceinline__ void done(const Unit&) const {}
};
template <class Inner> struct EpiSplit {
    static constexpr bool PERM = Inner::PERM, AFTER_DRAIN = false; static constexpr int KSEG = 0; static constexpr bool PRE = false;
    Inner in; float* slab; unsigned* tick; int KS;
    __device__ __forceinline__ void operator()(f32x4 (&acc)[2][2][4][2], const Unit& u, int wr, int wc, int fr, int fq) const {
        const int wave = wr * 4 + wc, lane = fr + 16 * fq;
        const __amdgpu_buffer_rsrc_t rs = __builtin_amdgcn_make_buffer_rsrc((void*)slab, 0, 0x7fffffff, 0x00020000);
        const int base = (((u.pn * KS + u.ks) * 8 + wave) * 16) * 1024 + lane * 16;
#pragma unroll
        for (int bj = 0; bj < 2; ++bj)
#pragma unroll
            for (int m = 0; m < 4; ++m)
#pragma unroll
                for (int n = 0; n < 2; ++n) __builtin_amdgcn_raw_buffer_store_b128(__builtin_bit_cast(u32x4, acc[0][bj][m][n]), rs, base + ((bj * 4 + m) * 2 + n) * 1024, 0, 16);
        asm volatile("s_waitcnt vmcnt(0)" ::: "memory");
        unsigned old = 0u;
        if (lane == 0) old = __hip_atomic_fetch_add(tick + (u.pn * 8 + wave) * 16, 1u, __ATOMIC_RELAXED, __HIP_MEMORY_SCOPE_AGENT);
        old = (unsigned)__builtin_amdgcn_readfirstlane((int)old);
        if (old == (unsigned)(KS - 1)) {
            __builtin_amdgcn_fence(__ATOMIC_ACQUIRE, "agent");
            asm volatile("s_waitcnt vmcnt(0)" ::: "memory");
#pragma unroll 1
            for (int s2 = 0; s2 < KS; ++s2) { if (s2 == u.ks) continue;
                const int ob = (((u.pn * KS + s2) * 8 + wave) * 16) * 1024 + lane * 16;
#pragma unroll
                for (int bj = 0; bj < 2; ++bj)
#pragma unroll
                    for (int m = 0; m < 4; ++m)
#pragma unroll
                        for (int n = 0; n < 2; ++n) acc[0][bj][m][n] += __builtin_bit_cast(f32x4, __builtin_amdgcn_raw_buffer_load_b128(rs, ob + ((bj * 4 + m) * 2 + n) * 1024, 0, 16)); }
#pragma unroll
            for (int bj = 0; bj < 2; ++bj)
#pragma unroll
                for (int m = 0; m < 4; ++m)
#pragma unroll
                    for (int n = 0; n < 2; ++n) acc[1][bj][m][n] = (f32x4){0.f, 0.f, 0.f, 0.f};
            int fr2 = fr, fq2 = fq; asm volatile("" : "+v"(fr2), "+v"(fq2));
            if constexpr (Inner::PRE) { float pre[8]; in.preload(u, wr, fr2, pre); in(acc, u, wr, wc, fr2, fq2, pre); } else in(acc, u, wr, wc, fr2, fq2);
        }
    }
};
}
#define PG8_SP2 true
#define PG8_ALIGN true

#define XB_TMO      128
#define XB_XCNT(j)  (256  + 64 * (j))
#define XB_XSUB(j)  (1280 + 64 * (j))
#define XB_XGEN(j)  (2304 + 64 * (j))
#define XB_TOP      3328
#define XB_TOPGEN   3392
#define XCD_BAR_WORDS 3456
#define XB_SPIN_CAP (1u << 18)

__device__ __forceinline__ unsigned xb_ld(unsigned* p)              { return __hip_atomic_load(p, __ATOMIC_RELAXED, __HIP_MEMORY_SCOPE_AGENT); }
__device__ __forceinline__ unsigned xb_add(unsigned* p, unsigned v) { return __hip_atomic_fetch_add(p, v, __ATOMIC_RELAXED, __HIP_MEMORY_SCOPE_AGENT); }
__device__ __forceinline__ unsigned xb_xcc_id() { return (unsigned)__builtin_amdgcn_s_getreg((3 << 11) | 20) & 0xFu; }
#define XB_SPIN(cond, bar) do { unsigned _sp = 0; while (cond) { __builtin_amdgcn_s_sleep(1); \
    if ((++_sp & 255u) == 0u) { if (xb_ld(&(bar)[XB_TMO])) break; if (_sp > XB_SPIN_CAP) { atomicAdd(&(bar)[XB_TMO], 1u); break; } } } } while (0)

struct XcdBarrier {
    unsigned* bar; unsigned x;
    volatile LAS unsigned* st;
};

__device__ __forceinline__ XcdBarrier xcd_barrier_post(unsigned* bar, volatile LAS unsigned* st, const bool leader) {
    XcdBarrier b; b.bar = bar; b.x = xb_xcc_id(); b.st = st;
    if (leader) (void)xb_add(&bar[XB_XCNT(b.x)], 1u);
    return b;
}
__device__ __forceinline__ void xcd_barrier_complete(unsigned* bar, unsigned x, unsigned& nloc, unsigned& nx) {
    const unsigned G = gridDim.x * gridDim.y * gridDim.z;
    unsigned sum, cnt, mine, sp = 0u;
    for (;;) {
        sum = 0u; cnt = 0u; mine = 0u;
#pragma unroll
        for (unsigned j = 0; j < 16; ++j) { const unsigned c = xb_ld(&bar[XB_XCNT(j)]); sum += c; cnt += (c > 0u) ? 1u : 0u; mine = (j == x) ? c : mine; }
        if (sum == G) break;
        __builtin_amdgcn_s_sleep(1);
        if ((++sp & 255u) == 0u) { if (xb_ld(&bar[XB_TMO])) break; if (sp > XB_SPIN_CAP) { atomicAdd(&bar[XB_TMO], 1u); break; } }
    }
    nloc = mine > 0u ? mine : 1u; nx = cnt > 0u ? cnt : 1u;
}

__device__ __forceinline__ void xcd_barrier(const XcdBarrier& b, const bool leader) {
    asm volatile("s_waitcnt vmcnt(0)" ::: "memory");
    __syncthreads();
    if (leader) {
        unsigned* bar = b.bar;
        __builtin_amdgcn_s_waitcnt(0);
        unsigned nloc = b.st[0], nx = b.st[1];
        if (nloc == 0u) { xcd_barrier_complete(bar, b.x, nloc, nx); b.st[0] = nloc; b.st[1] = nx; }
        const unsigned old = xb_add(&bar[XB_XSUB(b.x)], 1u);
        const unsigned gen = old / nloc;
        if (old + 1u == (gen + 1u) * nloc) {
            __builtin_amdgcn_fence(__ATOMIC_RELEASE, "agent");
            asm volatile("s_waitcnt vmcnt(0)" ::: "memory");
            const unsigned og = xb_add(&bar[XB_TOP], 1u);
            const unsigned tg = og / nx;
            if (og + 1u == (tg + 1u) * nx) xb_add(&bar[XB_TOPGEN], 1u);
            else XB_SPIN(xb_ld(&bar[XB_TOPGEN]) == tg, bar);
            __builtin_amdgcn_fence(__ATOMIC_ACQUIRE, "agent");
            xb_add(&bar[XB_XGEN(b.x)], 1u);
            asm volatile("s_waitcnt vmcnt(0)" ::: "memory");
        } else {
            XB_SPIN(xb_ld(&bar[XB_XGEN(b.x)]) == gen, bar);
            __builtin_amdgcn_fence(__ATOMIC_ACQUIRE, "agent");
            asm volatile("s_waitcnt vmcnt(0)" ::: "memory");
        }
    }
    __syncthreads();
}

struct Args { const float* in[34]; float* out; unsigned char* ws; int ph_lo, ph_hi, li, pad; };
struct Frame {
    LAS unsigned char* lds; volatile LAS unsigned* MISC; gu32* ctl;
    int tid, lane, wave, vcu, G;
    float* out; unsigned char* ws;
};
#define WSP(T, off) ((T*)(F.ws + (off)))
__device__ __forceinline__ void refresh(Frame& F) { int l; asm volatile("v_mbcnt_lo_u32_b32 %0, -1, 0\n\tv_mbcnt_hi_u32_b32 %0, -1, %0" : "=v"(l)); F.lane = l; F.tid = F.wave * 64 + l; }

__device__ __forceinline__ void tr_item(const float* W, int ldsrc, int ncols, int k0, int n0, bf16* WT, int K, int drow0, const float* gain, int gofs, LAS float* scr, int lane) {
    const int nn = n0 + (lane & 31); const bool okc = nn < ncols; const int nc = okc ? nn : ncols - 1;
    const float* gp = gain ? gain : W;
#pragma unroll
    for (int ib = 0; ib < 4; ++ib) { float v[8], gv[8];
#pragma unroll
        for (int j = 0; j < 8; ++j) { const int kk = 2 * (8 * ib + j) + (lane >> 5), k = k0 + kk; v[j] = W[(size_t)k * ldsrc + nc]; gv[j] = gp[max(k - gofs, 0)]; }
#pragma unroll
        for (int j = 0; j < 8; ++j) { const int kk = 2 * (8 * ib + j) + (lane >> 5), k = k0 + kk; float x = okc ? v[j] : 0.f; if (gain && k >= gofs) x *= gv[j]; scr[kk * 33 + (lane & 31)] = x; } }
    LDS_WAIT(); asm volatile("" ::: "memory");
    const int c = lane & 7;
#pragma unroll
    for (int j = 0; j < 4; ++j) { const int n = (lane >> 3) + 8 * j; const LAS float* s = scr + (8 * c) * 33 + n;
        v4u o; o.x = pk2(s[0 * 33], s[1 * 33]); o.y = pk2(s[2 * 33], s[3 * 33]); o.z = pk2(s[4 * 33], s[5 * 33]); o.w = pk2(s[6 * 33], s[7 * 33]);
        *(GAS v4u*)(WT + (size_t)(drow0 + n) * K + k0 + 8 * c) = o; }
    LDS_WAIT(); asm volatile("" ::: "memory");
}
__device__ __forceinline__ bool tr_job(int& r, const float* W, int K, int N, bf16* WT, int mode, int roff, const float* gain, int gofs, LAS float* scr, int lane) {
    const int nblk = (N + 31) / 32, items = (K / 64) * nblk;
    if (r >= items) { r -= items; return false; }
    const int kb = r / nblk, nb = r % nblk, n0 = nb * 32;
    const int drow0 = roff + (mode == 0 ? n0 : 256 * (n0 >> 7) + 128 * (mode - 1) + (n0 & 127));
    tr_item(W, N, N, kb * 64, n0, WT, K, drow0, gain, gofs, scr, lane);
    return true;
}
__device__ __forceinline__ void p0_prologue(Frame& F, const Args& A) {
    LAS float* scr = (LAS float*)(F.lds + RING_OFF + F.wave * 16384);
    const int gw = F.vcu * NWAVES + F.wave, NGW = F.G * NWAVES, lane = F.lane;
    constexpr int I_GU = 16 * 88, I_D = 44 * 32, I_IN = 16 * 129, I_OUT = 24 * 32, I_SQ = 16 * 32;
    constexpr int NITEMS = 4 * I_GU + 2 * I_D + I_IN + I_OUT + 4 * I_SQ;
    for (int it = gw; it < NITEMS; it += NGW) {
        int r = it;
        if (tr_job(r, A.in[11], 1024, 2816, WSP(bf16, WS_W1GU), 1, 0, A.in[10], 0, scr, lane)) continue;
        if (tr_job(r, A.in[12], 1024, 2816, WSP(bf16, WS_W1GU), 2, 0, A.in[10], 0, scr, lane)) continue;
        if (tr_job(r, A.in[13], 2816, 1024, WSP(bf16, WS_W1D), 0, 0, nullptr, 0, scr, lane)) continue;
        if (tr_job(r, A.in[15], 1024, 4112, WSP(bf16, WS_WIN), 0, 0, A.in[14], 0, scr, lane)) continue;
        if (tr_job(r, A.in[22], 1536, 1024, WSP(bf16, WS_WOUT), 0, 0, A.in[21], 512, scr, lane)) continue;
        if (tr_job(r, A.in[27], 1024, 1024, WSP(bf16, WS_WCQ), 0, 0, A.in[26], 0, scr, lane)) continue;
        if (tr_job(r, A.in[28], 1024, 1024, WSP(bf16, WS_WCO), 0, 0, nullptr, 0, scr, lane)) continue;
        if (tr_job(r, A.in[24], 1024, 1024, WSP(bf16, WS_WMEM), 0, 0, A.in[23], 0, scr, lane)) continue;
        if (tr_job(r, A.in[25], 1024, 1024, WSP(bf16, WS_WMEM), 0, 1024, A.in[23], 0, scr, lane)) continue;
        if (tr_job(r, A.in[30], 1024, 2816, WSP(bf16, WS_W2GU), 1, 0, A.in[29], 0, scr, lane)) continue;
        if (tr_job(r, A.in[31], 1024, 2816, WSP(bf16, WS_W2GU), 2, 0, A.in[29], 0, scr, lane)) continue;
        tr_job(r, A.in[32], 2816, 1024, WSP(bf16, WS_W2D), 0, 0, nullptr, 0, scr, lane);
    }
    { GAS v4u* z = (GAS v4u*)(WSP(bf16, WS_WIN) + (size_t)4128 * 1024); const int n16 = (4352 - 4128) * 1024 / 8;
      for (int i = gw * 64 + lane; i < n16; i += NGW * 64) z[i] = (v4u){0u, 0u, 0u, 0u}; }
    for (int m0 = gw; m0 < MT; m0 += 4 * NGW) {
        f32x4 v[4][4];
#pragma unroll
        for (int q = 0; q < 4; ++q) { const int m = m0 + q * NGW, mc = min(m, MROWS - 1);
            const float* src = mc < TP ? A.in[0] + (size_t)mc * 1024 : A.in[1] + (size_t)(mc - TP) * 1024; const GAS f32x4* xr = (const GAS f32x4*)src + lane;
#pragma unroll
            for (int j = 0; j < 4; ++j) v[q][j] = xr[64 * j]; }
#pragma unroll
        for (int q = 0; q < 4; ++q) { const int m = m0 + q * NGW; const float keep = m < MROWS ? 1.f : 0.f;
            if (m < MT) { float sq = 0.f;
#pragma unroll
            for (int j = 0; j < 4; ++j) { v[q][j] = v[q][j] * keep; sq += (v[q][j].x * v[q][j].x + v[q][j].y * v[q][j].y) + (v[q][j].z * v[q][j].z + v[q][j].w * v[q][j].w); }
            sq = wave_sum(sq);
            if (lane == 0) WSP(float, WS_RQ0)[m] = sq;
            GAS v2u* o8 = (GAS v2u*)(WSP(bf16, WS_XB) + (size_t)m * 1024) + lane;
#pragma unroll
            for (int j = 0; j < 4; ++j) o8[64 * j] = (v2u){pk2(v[q][j].x, v[q][j].y), pk2(v[q][j].z, v[q][j].w)}; } }
    }
    for (int m0 = gw; m0 < NB * NMEM; m0 += 4 * NGW) {
        f32x4 v[4][4];
#pragma unroll
        for (int q = 0; q < 4; ++q) { const int mc = min(m0 + q * NGW, NB * NMEM - 1); const GAS f32x4* xr = (const GAS f32x4*)(A.in[8] + (size_t)mc * 1024) + lane;
#pragma unroll
            for (int j = 0; j < 4; ++j) v[q][j] = xr[64 * j]; }
#pragma unroll
        for (int q = 0; q < 4; ++q) { const int m = m0 + q * NGW; if (m < NB * NMEM) { float sq = 0.f;
#pragma unroll
            for (int j = 0; j < 4; ++j) sq += (v[q][j].x * v[q][j].x + v[q][j].y * v[q][j].y) + (v[q][j].z * v[q][j].z + v[q][j].w * v[q][j].w);
            sq = wave_sum(sq);
            if (lane == 0) WSP(float, WS_RMEM)[m] = rsqrtf(sq * (1.f / 1024.f) + EPS);
            GAS v2u* o8 = (GAS v2u*)(WSP(bf16, WS_MEMB) + (size_t)m * 1024) + lane;
#pragma unroll
            for (int j = 0; j < 4; ++j) o8[64 * j] = (v2u){pk2(v[q][j].x, v[q][j].y), pk2(v[q][j].z, v[q][j].w)}; } }
    }
    for (int i = gw * 64 + lane; i < TS * 2 * DXBC; i += NGW * 64) { const int b = i / (2 * DXBC), r = i % (2 * DXBC); F.out[O_CVS + (size_t)b * 3 * DXBC + r] = A.in[4][(size_t)b * 3 * DXBC + DXBC + r]; }
}

__device__ __forceinline__ int t5_bucket(int d) {
    if (d < 16) return d;
    int b = 16;
    b += d >= 22; b += d >= 30; b += d >= 40; b += d >= 54; b += d >= 73; b += d >= 99; b += d >= 134; b += d >= 182; b += d >= 246; b += d >= 332; b += d >= 450; b += d >= 609; b += d >= 825; b += d >= 1117; b += d >= 1513;
    return b;
}

typedef float f32x16 __attribute__((ext_vector_type(16)));
typedef short s16x4 __attribute__((ext_vector_type(4)));
typedef short v4i16_t __attribute__((ext_vector_type(4)));
typedef float f32x2_t __attribute__((ext_vector_type(2)));
typedef __bf16 bf16x2_t __attribute__((ext_vector_type(2)));
using pg8::bf16x8; using pg8::f32x2;
#define MFMA32(a, b, c) __builtin_amdgcn_mfma_f32_32x32x16_bf16((a), (b), (c), 0, 0, 0)
__device__ __forceinline__ unsigned cvtpk(float lo, float hi) { f32x2_t v = {lo, hi}; bf16x2_t b = __builtin_convertvector(v, bf16x2_t); return __builtin_bit_cast(unsigned, b); }
__device__ __forceinline__ bf16x8 pack8(float a0, float a1, float a2, float a3, float a4, float a5, float a6, float a7) { v4u w; w.x = cvtpk(a0, a1); w.y = cvtpk(a2, a3); w.z = cvtpk(a4, a5); w.w = cvtpk(a6, a7); return __builtin_bit_cast(bf16x8, w); }
#define PACK_STEP(x, s) pack8((x)[8 * (s)], (x)[8 * (s) + 1], (x)[8 * (s) + 2], (x)[8 * (s) + 3], (x)[8 * (s) + 4], (x)[8 * (s) + 5], (x)[8 * (s) + 6], (x)[8 * (s) + 7])
__device__ __forceinline__ s16x4 tr_read(const LAS unsigned char* p) { return __builtin_bit_cast(s16x4, __builtin_amdgcn_ds_read_tr16_b64_v4i16((LAS v4i16_t*)p)); }
__device__ __forceinline__ f32x16 zero16() { f32x16 z;
#pragma unroll
    for (int i = 0; i < 16; ++i) z[i] = 0.f; return z; }

constexpr size_t WS_PX = WS_U + 16 * MiB;
__device__ __forceinline__ void cross_mfma_phase(Frame& F) {
    const bf16* qc = WSP(bf16, WS_QC); const bf16* mkb = WSP(bf16, WS_MKB); const bf16* mvb = WSP(bf16, WS_MVB); bf16* oc = WSP(bf16, WS_OC); v4u* px = WSP(v4u, WS_PX);
    LAS unsigned char* L = F.lds + RING_OFF;
    for (int su = F.vcu; su < NB * 4 * 2; su += F.G) {
        const int bh = su >> 1, b = bh >> 2, hx = bh & 3, half = su & 1;
        __syncthreads();
        for (int c = F.tid; c < 8192; c += 512) { const int key = c >> 5, ch = c & 31;
            const v4u x = *(const GAS v4u*)(mkb + ((size_t)(b * 256 + key)) * 1024 + hx * 256 + ch * 8);
            *(LAS v4u*)(L + key * 512 + ((ch ^ (key & 15)) << 4)) = x; }
        __syncthreads();
        for (int qb = 0; qb < 4; ++qb) {
            int lane = F.lane; asm volatile("" : "+v"(lane));
            const int r = lane & 31, h = lane >> 5;
            const int m0 = b * SEQ + (half * 4 + qb) * 256 + F.wave * 32;
            bf16x8 qf[16];
            { const bf16* qrow = qc + (size_t)(m0 + r) * 1024 + hx * 256 + 8 * h;
#pragma unroll
              for (int ks = 0; ks < 16; ++ks) qf[ks] = *(const GAS bf16x8*)(qrow + 16 * ks); }
            asm volatile("" : "+v"(qf[0]), "+v"(qf[1]), "+v"(qf[2]), "+v"(qf[3]), "+v"(qf[4]), "+v"(qf[5]), "+v"(qf[6]), "+v"(qf[7]));
            asm volatile("" : "+v"(qf[8]), "+v"(qf[9]), "+v"(qf[10]), "+v"(qf[11]), "+v"(qf[12]), "+v"(qf[13]), "+v"(qf[14]), "+v"(qf[15]));
            f32x16 S[8];
#pragma unroll
            for (int kt = 0; kt < 8; ++kt) S[kt] = zero16();
            const LAS unsigned char* kb0 = L + r * 512;
            bf16x8 ka[4], kb_[4];
            { const int off = ((h ^ (r & 15)) << 4);
#pragma unroll
              for (int j = 0; j < 4; ++j) ka[j] = *(const LAS bf16x8*)(kb0 + j * 16384 + off); }
#pragma unroll
            for (int ks = 0; ks < 16; ++ks) { const int off = (((2 * ks + h) ^ (r & 15)) << 4), offn = (((2 * ks + 2 + h) ^ (r & 15)) << 4);
#pragma unroll
                for (int j = 0; j < 4; ++j) kb_[j] = *(const LAS bf16x8*)(kb0 + (4 + j) * 16384 + off);
                asm volatile("" : "+v"(ka[0]), "+v"(ka[1]), "+v"(ka[2]), "+v"(ka[3]));
#pragma unroll
                for (int j = 0; j < 4; ++j) S[j] = MFMA32(ka[j], qf[ks], S[j]);
                if (ks < 15) {
#pragma unroll
                    for (int j = 0; j < 4; ++j) ka[j] = *(const LAS bf16x8*)(kb0 + j * 16384 + offn); }
                asm volatile("" : "+v"(kb_[0]), "+v"(kb_[1]), "+v"(kb_[2]), "+v"(kb_[3]));
#pragma unroll
                for (int j = 0; j < 4; ++j) S[4 + j] = MFMA32(kb_[j], qf[ks], S[4 + j]);
            }
            float mx = -1e30f;
#pragma unroll
            for (int kt = 0; kt < 8; ++kt)
#pragma unroll
                for (int i = 0; i < 16; ++i) mx = fmaxf(mx, S[kt][i]);
            mx = fmaxf(mx, __shfl_xor(mx, 32));
            float sum = 0.f;
            { f32x2 s2v = {0.f, 0.f}; const float mxl = mx * 1.44269504f;
#pragma unroll
              for (int kt = 0; kt < 8; ++kt)
#pragma unroll
                for (int i2 = 0; i2 < 8; ++i2) { const f32x2 x = (f32x2){S[kt][2 * i2], S[kt][2 * i2 + 1]} * 1.44269504f - mxl; f32x2 e; e.x = __builtin_amdgcn_exp2f(x.x); e.y = __builtin_amdgcn_exp2f(x.y);
                    S[kt][2 * i2] = e.x; S[kt][2 * i2 + 1] = e.y; s2v = s2v + e; }
              sum = s2v.x + s2v.y; }
            sum += __shfl_xor(sum, 32);
            const float inv = 1.f / sum;
            v4u* pw = px + ((size_t)(m0 >> 5) * 4 + hx) * 1024 + lane;
#pragma unroll
            for (int kt = 0; kt < 8; ++kt)
#pragma unroll
                for (int s2 = 0; s2 < 2; ++s2) { v4u w; w.x = cvtpk(S[kt][8 * s2] * inv, S[kt][8 * s2 + 1] * inv); w.y = cvtpk(S[kt][8 * s2 + 2] * inv, S[kt][8 * s2 + 3] * inv);
                    w.z = cvtpk(S[kt][8 * s2 + 4] * inv, S[kt][8 * s2 + 5] * inv); w.w = cvtpk(S[kt][8 * s2 + 6] * inv, S[kt][8 * s2 + 7] * inv);
                    *(GAS v4u*)(pw + (kt * 2 + s2) * 64) = w; }
        }
        asm volatile("s_waitcnt vmcnt(0)" ::: "memory");
        __syncthreads();
        for (int c = F.tid; c < 8192; c += 512) { const int key = c >> 5, c16 = c & 31;
            const v4u x = *(const GAS v4u*)(mvb + ((size_t)(b * 256 + key)) * 1024 + hx * 256 + c16 * 8);
            *(LAS v4u*)(L + key * 512 + ((c16 * 16) ^ ((key & 3) << 6))) = x; }
        __syncthreads();
        for (int qb = 0; qb < 4; ++qb) {
            int lane = F.lane; asm volatile("" : "+v"(lane));
            const int r = lane & 31, h = lane >> 5, q4 = (lane & 15) >> 2, p4 = lane & 3, blk = (lane >> 4) & 1;
            const int m0 = b * SEQ + (half * 4 + qb) * 256 + F.wave * 32;
            const v4u* pw = px + ((size_t)(m0 >> 5) * 4 + hx) * 1024 + lane;
            bf16x8 P[8][2];
#pragma unroll
            for (int kt = 0; kt < 8; ++kt)
#pragma unroll
                for (int s2 = 0; s2 < 2; ++s2) P[kt][s2] = __builtin_bit_cast(bf16x8, *(const GAS v4u*)(pw + (kt * 2 + s2) * 64));
            asm volatile("" : "+v"(P[0][0]), "+v"(P[0][1]), "+v"(P[1][0]), "+v"(P[1][1]), "+v"(P[2][0]), "+v"(P[2][1]), "+v"(P[3][0]), "+v"(P[3][1]));
            asm volatile("" : "+v"(P[4][0]), "+v"(P[4][1]), "+v"(P[5][0]), "+v"(P[5][1]), "+v"(P[6][0]), "+v"(P[6][1]), "+v"(P[7][0]), "+v"(P[7][1]));
            f32x16 O[8];
#pragma unroll
            for (int dt = 0; dt < 8; ++dt) O[dt] = zero16();
            const LAS unsigned char* vb0 = L + (4 * h + q4) * 512 + 32 * blk + 8 * p4;
            bf16x8 va[4], vb_[4];
#define CX_VREAD(dst, step, d0) do { _Pragma("unroll") for (int j = 0; j < 4; ++j) { const LAS unsigned char* a0 = vb0 + (step) * 8192 + 64 * (((d0) + j) ^ q4); \
                const s16x4 lo = tr_read(a0), hi = tr_read(a0 + 8 * 512); dst[j] = __builtin_shufflevector(lo, hi, 0, 1, 2, 3, 4, 5, 6, 7); } } while (0)
            CX_VREAD(va, 0, 0);
#pragma unroll
            for (int st = 0; st < 16; ++st) {
                CX_VREAD(vb_, st, 4);
                asm volatile("" : "+v"(va[0]), "+v"(va[1]), "+v"(va[2]), "+v"(va[3]));
#pragma unroll
                for (int j = 0; j < 4; ++j) O[j] = MFMA32(P[st >> 1][st & 1], va[j], O[j]);
                if (st < 15) CX_VREAD(va, st + 1, 0);
                asm volatile("" : "+v"(vb_[0]), "+v"(vb_[1]), "+v"(vb_[2]), "+v"(vb_[3]));
#pragma unroll
                for (int j = 0; j < 4; ++j) O[4 + j] = MFMA32(P[st >> 1][st & 1], vb_[j], O[4 + j]);
            }
#undef CX_VREAD
            bf16* ocol = oc + (size_t)(m0 + 4 * h) * 1024 + hx * 256 + r;
#pragma unroll
            for (int dt = 0; dt < 8; ++dt)
#pragma unroll
                for (int i = 0; i < 16; ++i) ocol[(size_t)((i & 3) + 8 * (i >> 2)) * 1024 + 32 * dt] = (bf16)f2bf(O[dt][i]);
        }
    }
    __syncthreads();
}

constexpr size_t WS_PART = WS_QC, WS_LSE = WS_U, WS_SSQP = WS_U + 8 * MiB;
__device__ __forceinline__ void attn_step(const bf16x8 (&kf)[4], const bf16x8 (&vf)[2][2], const bf16x8 (&qf)[4], const LAS float* tbk, int dl, const int mode, float& m, float& l, f32x16 (&O)[2]) {
    f32x16 acc = zero16();
#pragma unroll
    for (int ks = 0; ks < 4; ++ks) acc = MFMA32(kf[ks], qf[ks], acc);
#pragma unroll
    for (int hb = 0; hb < 4; ++hb) {
        const f32x2 b01 = {tbk[-(8 * hb)], tbk[-(8 * hb + 1)]}, b23 = {tbk[-(8 * hb + 2)], tbk[-(8 * hb + 3)]};
        const f32x2 a01 = (f32x2){acc[4 * hb], acc[4 * hb + 1]} + b01, a23 = (f32x2){acc[4 * hb + 2], acc[4 * hb + 3]} + b23;
        acc[4 * hb] = a01.x; acc[4 * hb + 1] = a01.y; acc[4 * hb + 2] = a23.x; acc[4 * hb + 3] = a23.y; }
    if (mode == 1) {
#pragma unroll
        for (int i = 0; i < 16; ++i) { const int ci = (i & 3) + 8 * (i >> 2); acc[i] = (dl - ci <= 128) ? acc[i] : -1e30f; }
    } else if (mode == 2) {
#pragma unroll
        for (int i = 0; i < 16; ++i) { const int ci = (i & 3) + 8 * (i >> 2); acc[i] = (dl - ci >= 0) ? acc[i] : -1e30f; }
    }
    float tmax = -1e30f;
#pragma unroll
    for (int i = 0; i < 16; ++i) tmax = fmaxf(tmax, acc[i]);
    tmax = fmaxf(tmax, __shfl_xor(tmax, 32));
    const bool grow = tmax > m + 8.f;
    if (__builtin_amdgcn_ballot_w64(grow) != 0ull) {
        const float mn = grow ? tmax : m, scl = __builtin_amdgcn_exp2f(m - mn); m = mn; l *= scl;
#pragma unroll
        for (int i = 0; i < 16; ++i) { O[0][i] *= scl; O[1][i] *= scl; }
    }
    f32x2 ps = {0.f, 0.f}; const float mv = m;
#pragma unroll
    for (int i2 = 0; i2 < 8; ++i2) { const f32x2 x = (f32x2){acc[2 * i2], acc[2 * i2 + 1]} - mv; f32x2 e; e.x = __builtin_amdgcn_exp2f(x.x); e.y = __builtin_amdgcn_exp2f(x.y); acc[2 * i2] = e.x; acc[2 * i2 + 1] = e.y; ps = ps + e; }
    l += ps.x + ps.y;
#pragma unroll
    for (int s2 = 0; s2 < 2; ++s2) { const bf16x8 pf = PACK_STEP(acc, s2);
        O[0] = MFMA32(vf[s2][0], pf, O[0]); O[1] = MFMA32(vf[s2][1], pf, O[1]); }
}
__device__ __forceinline__ void attn_step_kt(const bf16x8 (&kf)[4], const bf16x8 (&vf)[2][2], const bf16x8 (&qf)[4], const LAS float* tb0, int d0, int kt, float& m, float& l, f32x16 (&O)[2]) {
    const LAS float* tbk = tb0 - 32 * kt; const int dl = d0 - 32 * kt;
    attn_step(kf, vf, qf, tbk, dl, kt == 0 ? 1 : (kt == 4 ? 2 : 0), m, l, O);
}
__device__ __forceinline__ void attn_mfma_phase(Frame& F, const Args& A) {
    const int w = F.wave;
    LAS float* tab = (LAS float*)(F.lds + RING_OFF);
    LAS unsigned char* kl = F.lds + RING_OFF + 20480 + w * 8704;
    LAS unsigned char* vl = kl + 4608;
    const bf16* qb = WSP(bf16, WS_QB); const bf16* kb = WSP(bf16, WS_KB); const bf16* vb = WSP(bf16, WS_VB);
    bf16* part = WSP(bf16, WS_PART); float* lsep = WSP(float, WS_LSE); const float* relb = A.in[9];
    __syncthreads();
    for (int idx = F.tid; idx < 3 * 8 * 192; idx += 512) { const int p = idx / (8 * 192), rem = idx % (8 * 192), hh = rem / 192, d = min(max(rem % 192 - 32, 0), 128); tab[idx] = relb[t5_bucket(d << (2 * p)) * 8 + hh] * 1.44269504f; }
    __syncthreads();
    for (int u = F.vcu; u < 1536; u += F.G) {
        const int p = u >> 9, v = u & 511, lg = 2 * p, b = v >> 4, w2 = v & 15, nbk = w2 >> lg, rcls = w2 & ((1 << lg) - 1);
        const size_t tokbase = (size_t)b * SEQ + rcls;
        const LAS float* tb = tab + (p * 8 + w) * 192 + 32;
        for (int pr = 0; pr < 2; ++pr) {
            int lane = F.lane; asm volatile("" : "+v"(lane));
            const int r = lane & 31, h = lane >> 5, q4 = (lane & 15) >> 2, p4 = lane & 3, blk = (lane >> 4) & 1, vxor = ((q4 >> 1) & 1) << 6;
            const int i0 = 128 * nbk + 64 * pr, jbase = i0 - 128, amin = jbase >= 0 ? 0 : ((-jbase) >> 5);
            const int d0 = 128 + r - 4 * h; const LAS float* tb0 = tb + d0;
            const int skey = lane >> 3, sc16 = lane & 7; const size_t hoff = (size_t)w * 64 + sc16 * 8;
            v4u ka[4], va[4];
            { const int j0 = jbase + 32 * amin;
#pragma unroll
              for (int i = 0; i < 4; ++i) { const size_t g = (tokbase + ((size_t)(j0 + skey + 8 * i) << lg)) * 512 + hoff; ka[i] = *(const GAS v4u*)(kb + g); va[i] = *(const GAS v4u*)(vb + g); } }
            bf16x8 qfa[4], qfb[4];
            { const bf16* qrow = qb + (tokbase + ((size_t)(i0 + r) << lg)) * 512 + w * 64 + 8 * h; const size_t qstep = ((size_t)32 << lg) * 512;
#pragma unroll
              for (int ks = 0; ks < 4; ++ks) { qfa[ks] = *(const GAS bf16x8*)(qrow + 16 * ks); qfb[ks] = *(const GAS bf16x8*)(qrow + qstep + 16 * ks); } }
            float ma = -1e30f, la = 0.f, mb = -1e30f, lb = 0.f; f32x16 Oa[2], Ob[2]; Oa[0] = zero16(); Oa[1] = zero16(); Ob[0] = zero16(); Ob[1] = zero16();
#pragma unroll 1
            for (int a = amin; a < 6; ++a) {
                {
                    asm volatile("" ::: "memory");
#pragma unroll
                    for (int i = 0; i < 4; ++i) { const int key = skey + 8 * i;
                        *(LAS v4u*)(kl + key * 144 + sc16 * 16) = ka[i];
                        *(LAS v4u*)(vl + key * 128 + ((sc16 * 16) ^ (((key >> 1) & 1) << 6))) = va[i]; }
                    if (a < 5) { const int j1 = jbase + 32 * (a + 1);
#pragma unroll
                        for (int i = 0; i < 4; ++i) { const size_t g = (tokbase + ((size_t)(j1 + skey + 8 * i) << lg)) * 512 + hoff; ka[i] = *(const GAS v4u*)(kb + g); va[i] = *(const GAS v4u*)(vb + g); } }
                    asm volatile("s_waitcnt lgkmcnt(0)" ::: "memory");
                    bf16x8 kf[4], vf[2][2];
#pragma unroll
                    for (int ks = 0; ks < 4; ++ks) kf[ks] = *(const LAS bf16x8*)(kl + r * 144 + (2 * ks + h) * 16);
#pragma unroll
                    for (int s2 = 0; s2 < 2; ++s2)
#pragma unroll
                        for (int dt = 0; dt < 2; ++dt) { const LAS unsigned char* a0 = vl + (16 * s2 + 4 * h + q4) * 128 + ((64 * dt + 32 * blk + 8 * p4) ^ vxor);
                            const s16x4 lo = tr_read(a0), hi = tr_read(a0 + 8 * 128); vf[s2][dt] = __builtin_shufflevector(lo, hi, 0, 1, 2, 3, 4, 5, 6, 7); }
                    if (a < 5) attn_step_kt(kf, vf, qfa, tb0, d0, a, ma, la, Oa);
                    if (a > 0) attn_step_kt(kf, vf, qfb, tb0, d0, a - 1, mb, lb, Ob);
                    asm volatile("s_waitcnt lgkmcnt(0)" ::: "memory");
                }
            }
#pragma unroll
            for (int sb = 0; sb < 2; ++sb) {
                float lsum = sb ? lb : la; const float mm = sb ? mb : ma; lsum += __shfl_xor(lsum, 32);
                const float inv = 1.f / lsum;
                const size_t tok = tokbase + ((size_t)(i0 + 32 * sb + r) << lg);
                bf16* orow = part + ((size_t)p * TP + tok) * 512 + w * 64 + 4 * h;
#pragma unroll
                for (int dt = 0; dt < 2; ++dt)
#pragma unroll
                    for (int g = 0; g < 4; ++g) { const f32x16& O = sb ? Ob[dt] : Oa[dt]; v2u x; x.x = cvtpk(O[4 * g] * inv, O[4 * g + 1] * inv); x.y = cvtpk(O[4 * g + 2] * inv, O[4 * g + 3] * inv);
                        *(GAS v2u*)(orow + 32 * dt + 8 * g) = x; }
                if (h == 0) lsep[((size_t)p * TP + tok) * 8 + w] = (mm + __builtin_amdgcn_logf(lsum)) * 0.69314718f;
            }
        }
    }
    __syncthreads();
}

constexpr int SSP = 272;
constexpr int SS_CN = 0, SS_BN = 34816, SS_BTD = 69632, SS_XT = 104448, SS_HB = 121856, SS_ACS = 139264;
static_assert(SS_ACS + 2 * 1536 <= LDSCTL_OFF, "SSD LDS map");

__device__ __forceinline__ void unpack8x2(const v4u w, f32x2 (&f)[4]) {
    f[0] = (f32x2){__uint_as_float(w.x << 16), __uint_as_float(w.x & 0xffff0000u)}; f[1] = (f32x2){__uint_as_float(w.y << 16), __uint_as_float(w.y & 0xffff0000u)};
    f[2] = (f32x2){__uint_as_float(w.z << 16), __uint_as_float(w.z & 0xffff0000u)}; f[3] = (f32x2){__uint_as_float(w.w << 16), __uint_as_float(w.w & 0xffff0000u)};
}
__device__ __forceinline__ f32x2 silu2(f32x2 v) { const f32x2 t = v * -1.44269504f; f32x2 e; e.x = __builtin_amdgcn_exp2f(t.x); e.y = __builtin_amdgcn_exp2f(t.y); const f32x2 d = e + 1.0f; f32x2 r; r.x = __builtin_amdgcn_rcpf(d.x); r.y = __builtin_amdgcn_rcpf(d.y); return v * r; }
constexpr size_t WS_BCC = 1455 * MiB;
__device__ __forceinline__ void bc_conv_prepass(Frame& F, const Args& A) {
    const bf16* xbc = WSP(bf16, WS_XBC); bf16* bcc = WSP(bf16, WS_BCC); const float* conv_w = A.in[16]; const float* conv_b = A.in[17];
    const int nthr = F.G * 512;
    for (int sidx = F.vcu * 512 + F.tid; sidx < (TP / 8) * 64; sidx += nthr) {
        const int cg = sidx & 63, rb = sidx >> 6, colg = 1024 + 8 * cg, row = rb * 8, t0 = row & 2047;
        v4u raw[11];
#pragma unroll
        for (int q = 0; q < 11; ++q) { const bool ok = t0 - 3 + q >= 0; const v4u x = *(const GAS v4u*)(xbc + (size_t)(ok ? row - 3 + q : row) * 1536 + colg);
            raw[q].x = ok ? x.x : 0u; raw[q].y = ok ? x.y : 0u; raw[q].z = ok ? x.z : 0u; raw[q].w = ok ? x.w : 0u; }
        f32x2 cw[4][4], cb[4];
#pragma unroll
        for (int w = 0; w < 4; ++w) { const f32x4 a = *(const GAS f32x4*)(conv_w + w * 1536 + colg), c = *(const GAS f32x4*)(conv_w + w * 1536 + colg + 4);
            cw[w][0] = (f32x2){a.x, a.y}; cw[w][1] = (f32x2){a.z, a.w}; cw[w][2] = (f32x2){c.x, c.y}; cw[w][3] = (f32x2){c.z, c.w}; }
        { const f32x4 a = *(const GAS f32x4*)(conv_b + colg), c = *(const GAS f32x4*)(conv_b + colg + 4); cb[0] = (f32x2){a.x, a.y}; cb[1] = (f32x2){a.z, a.w}; cb[2] = (f32x2){c.x, c.y}; cb[3] = (f32x2){c.z, c.w}; }
#pragma unroll
        for (int i = 0; i < 8; ++i) { f32x2 f0[4], f1[4], f2[4], f3[4], o[4]; unpack8x2(raw[i], f0); unpack8x2(raw[i + 1], f1); unpack8x2(raw[i + 2], f2); unpack8x2(raw[i + 3], f3);
#pragma unroll
            for (int e = 0; e < 4; ++e) o[e] = silu2(cb[e] + cw[0][e] * f0[e] + cw[1][e] * f1[e] + cw[2][e] * f2[e] + cw[3][e] * f3[e]);
            *(GAS v4u*)(bcc + (size_t)(row + i) * 512 + 8 * cg) = (v4u){cvtpk(o[0].x, o[0].y), cvtpk(o[1].x, o[1].y), cvtpk(o[2].x, o[2].y), cvtpk(o[3].x, o[3].y)}; }
    }
}
__device__ __forceinline__ void xstrip_load(v4u (&raw)[5], const bf16* xbc, size_t row0, int c, int k, int head) {
    const int cg = k & 7, rb = k >> 3, t0 = c * 128 + 2 * rb;
#pragma unroll
    for (int q = 0; q < 5; ++q) { const bool ok = t0 - 3 + q >= 0; const v4u x = *(const GAS v4u*)(xbc + (row0 + (ok ? t0 - 3 + q : 0)) * 1536 + head * 64 + 8 * cg);
        raw[q].x = ok ? x.x : 0u; raw[q].y = ok ? x.y : 0u; raw[q].z = ok ? x.z : 0u; raw[q].w = ok ? x.w : 0u; }
}
__device__ __forceinline__ void xstrip_compute(const v4u (&raw)[5], LAS unsigned char* L, const float* conv_w, const float* conv_b, int k, int head) {
    const int cg = k & 7, rb = k >> 3, colg = head * 64 + 8 * cg, s0 = 2 * rb;
    f32x2 cw[4][4], cb[4];
#pragma unroll
    for (int w = 0; w < 4; ++w) { const f32x4 a = *(const GAS f32x4*)(conv_w + w * 1536 + colg), c = *(const GAS f32x4*)(conv_w + w * 1536 + colg + 4);
        cw[w][0] = (f32x2){a.x, a.y}; cw[w][1] = (f32x2){a.z, a.w}; cw[w][2] = (f32x2){c.x, c.y}; cw[w][3] = (f32x2){c.z, c.w}; }
    { const f32x4 a = *(const GAS f32x4*)(conv_b + colg), c = *(const GAS f32x4*)(conv_b + colg + 4); cb[0] = (f32x2){a.x, a.y}; cb[1] = (f32x2){a.z, a.w}; cb[2] = (f32x2){c.x, c.y}; cb[3] = (f32x2){c.z, c.w}; }
    f32x2 o[2][4];
#pragma unroll
    for (int i = 0; i < 2; ++i) { f32x2 f0[4], f1[4], f2[4], f3[4]; unpack8x2(raw[i], f0); unpack8x2(raw[i + 1], f1); unpack8x2(raw[i + 2], f2); unpack8x2(raw[i + 3], f3);
#pragma unroll
        for (int e = 0; e < 4; ++e) o[i][e] = silu2(cb[e] + cw[0][e] * f0[e] + cw[1][e] * f1[e] + cw[2][e] * f2[e] + cw[3][e] * f3[e]); }
#pragma unroll
    for (int e = 0; e < 4; ++e) { *(LAS unsigned*)(L + SS_XT + (8 * cg + 2 * e) * SSP + s0 * 2) = cvtpk(o[0][e].x, o[1][e].x); *(LAS unsigned*)(L + SS_XT + (8 * cg + 2 * e + 1) * SSP + s0 * 2) = cvtpk(o[0][e].y, o[1][e].y); }
}
__device__ __forceinline__ void bcstrip_load(v4u (&raw)[8], const bf16* bcc, size_t row0, int c, int k, int g, int reg) {
    const int cg = k & 15, rb = k >> 4;
#pragma unroll
    for (int q = 0; q < 8; ++q) raw[q] = *(const GAS v4u*)(bcc + (row0 + c * 128 + 8 * rb + q) * 512 + (reg == 1 ? 0 : 256) + g * 128 + 8 * cg);
}
template <int REG> __device__ __forceinline__ void bcstrip_compute(const v4u (&raw)[8], LAS unsigned char* L, int k, const LAS float* acs, const LAS float* dtv) {
    const int cg = k & 15, rb = k >> 4, s0 = 8 * rb;
#pragma unroll
    for (int i = 0; i < 8; ++i) *(LAS v4u*)(L + (REG == 1 ? SS_BN : SS_CN) + (s0 + i) * SSP + cg * 16) = raw[i];
    if (REG == 1) { const float atot = acs[127]; float fd[8], f[8][8];
#pragma unroll
        for (int i = 0; i < 8; ++i) { fd[i] = dtv[s0 + i] * __expf(atot - acs[s0 + i]); unpack8(raw[i], f[i]); }
#pragma unroll
        for (int e = 0; e < 8; ++e) *(LAS v4u*)(L + SS_BTD + (8 * cg + e) * SSP + s0 * 2) =
            (v4u){cvtpk(f[0][e] * fd[0], f[1][e] * fd[1]), cvtpk(f[2][e] * fd[2], f[3][e] * fd[3]), cvtpk(f[4][e] * fd[4], f[5][e] * fd[5]), cvtpk(f[6][e] * fd[6], f[7][e] * fd[7])}; }
}
__device__ __forceinline__ void ssd_scan(LAS float* buf, float d0, float d1, float a, int lane) {
    float s0 = d0 * a, s1 = d1 * a;
#pragma unroll
    for (int o = 1; o < 64; o <<= 1) { const float t0 = __shfl_up(s0, o), t1 = __shfl_up(s1, o); if (lane >= o) { s0 += t0; s1 += t1; } }
    const float tot0 = __shfl(s0, 63); s1 += tot0;
    const float r0 = __shfl(s0, (lane & 32) + 31), r1 = __shfl(s1, (lane & 32) + 31);
    buf[lane] = s0; buf[64 + lane] = s1; buf[128 + lane] = d0; buf[192 + lane] = d1; buf[256 + lane] = d0 * __expf(r0 - s0); buf[320 + lane] = d1 * __expf(r1 - s1);
}
__device__ __forceinline__ void ssd_mfma_unit(Frame& F, const Args& A, int b, int head, float* hout) {
    const int w = F.wave, g = head >> 3;
    LAS unsigned char* L = F.lds + RING_OFF;
    const bf16* xbc = WSP(bf16, WS_XBC); const bf16* bcc = WSP(bf16, WS_BCC); const float* dtb = WSP(float, WS_DTB); const bf16* zg = WSP(bf16, WS_ZG); bf16* mix = WSP(bf16, WS_MIX); float* ssqp = WSP(float, WS_SSQP);
    const float* conv_w = A.in[16]; const float* conv_b = A.in[17];
    const float a = -__expf(A.in[19][head]), dsk = A.in[20][head];
    const size_t row0 = (size_t)b * SEQ;
    const int pt = w & 1, lt = (0x11002233 >> (4 * w)) & 3, pt2 = w >> 2, nt = w & 3, breg = w < 4 ? 1 : 2;
    f32x16 hacc = zero16();
    v4u rawx[5], rawb[8];
    float dn0 = 0.f, dn1 = 0.f;
    __syncthreads();
    { int lane0 = F.lane; asm volatile("" : "+v"(lane0)); const int tid0 = w * 64 + lane0;
      for (int i = tid0; i < 17408 / 16; i += 512) *(LAS v4u*)(L + SS_HB + i * 16) = (v4u){0u, 0u, 0u, 0u};
      xstrip_load(rawx, xbc, row0, 0, tid0, head); bcstrip_load(rawb, bcc, row0, 0, tid0 & 255, g, breg);
      if (w == 4) ssd_scan((LAS float*)(L + SS_ACS), dtb[(row0 + lane0) * 16 + head], dtb[(row0 + 64 + lane0) * 16 + head], a, lane0); }
    __syncthreads();
    for (int c = 0; c < 16; ++c) {
        int lane = F.lane; asm volatile("" : "+v"(lane));
        const int tid = w * 64 + lane, r = lane & 31, h = lane >> 5;
        const LAS float* acs = (const LAS float*)(L + SS_ACS + (c & 1) * 1536); const LAS float* dtv = acs + 128; const LAS float* vfac = acs + 256;
        if (w == 4 && c < 15) { dn0 = dtb[(row0 + (c + 1) * 128 + lane) * 16 + head]; dn1 = dtb[(row0 + (c + 1) * 128 + 64 + lane) * 16 + head]; }
        xstrip_compute(rawx, L, conv_w, conv_b, tid, head);
        if (w < 4) bcstrip_compute<1>(rawb, L, tid & 255, acs, dtv); else bcstrip_compute<2>(rawb, L, tid & 255, acs, dtv);
        LBAR();
        {
            if (c < 15) {
                int tc = tid; asm volatile("" : "+v"(tc));
                xstrip_load(rawx, xbc, row0, c + 1, tc, head); bcstrip_load(rawb, bcc, row0, c + 1, tc & 255, g, breg);
                if (w == 4) ssd_scan((LAS float*)(L + SS_ACS + ((c + 1) & 1) * 1536), dn0, dn1, a, lane); }
            const int l = 32 * lt + r; const size_t tok = row0 + c * 128 + l;
            v2u zw[4];
#pragma unroll
            for (int g4 = 0; g4 < 4; ++g4) zw[g4] = *(const GAS v2u*)(zg + tok * 1024 + head * 64 + 32 * pt + 8 * g4 + 4 * h);
            bf16x8 cf[8];
#pragma unroll
            for (int ks = 0; ks < 8; ++ks) cf[ks] = *(const LAS bf16x8*)(L + SS_CN + (32 * lt + r) * SSP + (16 * ks + 8 * h) * 2);
            const float al = acs[l];
            f32x16 y1 = zero16();
            for (int st = 0; st <= lt; ++st) {
                f32x16 ga = zero16(), gb = zero16();
#pragma unroll
                for (int ks = 0; ks < 8; ks += 2) { const bf16x8 af0 = *(const LAS bf16x8*)(L + SS_BN + (32 * st + r) * SSP + (16 * ks + 8 * h) * 2), af1 = *(const LAS bf16x8*)(L + SS_BN + (32 * st + r) * SSP + (16 * ks + 16 + 8 * h) * 2);
                    ga = MFMA32(af0, cf[ks], ga); gb = MFMA32(af1, cf[ks + 1], gb); }
                if (st < lt) {
                    const float ur = __expf(al - acs[32 * st + 31]);
#pragma unroll
                    for (int i = 0; i < 16; ++i) { const int sidx = 32 * st + (i & 3) + 8 * (i >> 2) + 4 * h; ga[i] = (ga[i] + gb[i]) * (ur * vfac[sidx]); }
                } else {
#pragma unroll
                    for (int i = 0; i < 16; ++i) { const int sidx = 32 * st + (i & 3) + 8 * (i >> 2) + 4 * h; const float msk = (sidx <= l) ? 1.f : 0.f;
                        const float e = __expf(fminf(al - acs[sidx], 0.f)) * (dtv[sidx] * msk); ga[i] = (ga[i] + gb[i]) * e; }
                }
#pragma unroll
                for (int s2 = 0; s2 < 2; ++s2) { const bf16x8 pf = PACK_STEP(ga, s2);
                    const LAS unsigned char* xp = L + SS_XT + (32 * pt + r) * SSP + (32 * st + 16 * s2 + 4 * h) * 2;
                    const v2u lo = *(const LAS v2u*)xp, hi = *(const LAS v2u*)(xp + 16);
                    const bf16x8 xa = __builtin_bit_cast(bf16x8, ((v4u){lo.x, lo.y, hi.x, hi.y}));
                    y1 = MFMA32(xa, pf, y1); }
            }
            f32x16 y2 = zero16(), y2b = zero16();
#pragma unroll
            for (int ks = 0; ks < 8; ks += 2) { const bf16x8 hf0 = *(const LAS bf16x8*)(L + SS_HB + (32 * pt + r) * SSP + (16 * ks + 8 * h) * 2), hf1 = *(const LAS bf16x8*)(L + SS_HB + (32 * pt + r) * SSP + (16 * ks + 16 + 8 * h) * 2);
                y2 = MFMA32(hf0, cf[ks], y2); y2b = MFMA32(hf1, cf[ks + 1], y2b); }
            const float el = __expf(al);
            float sq = 0.f;
#pragma unroll
            for (int g4 = 0; g4 < 4; ++g4) { const int p0 = 32 * pt + 8 * g4 + 4 * h;
                const float z0 = bf2f(zw[g4].x & 0xffffu), z1 = __uint_as_float(zw[g4].x & 0xffff0000u), z2 = bf2f(zw[g4].y & 0xffffu), z3 = __uint_as_float(zw[g4].y & 0xffff0000u);
                float yv[4];
#pragma unroll
                for (int j = 0; j < 4; ++j) { const float xv = bf2f(*(const LAS unsigned short*)(L + SS_XT + (p0 + j) * SSP + l * 2)); yv[j] = y1[4 * g4 + j] + el * (y2[4 * g4 + j] + y2b[4 * g4 + j]) + dsk * xv; }
                yv[0] *= z0; yv[1] *= z1; yv[2] *= z2; yv[3] *= z3;
                sq += yv[0] * yv[0] + yv[1] * yv[1] + yv[2] * yv[2] + yv[3] * yv[3];
                *(GAS v2u*)(mix + tok * 1536 + 512 + head * 64 + p0) = (v2u){cvtpk(yv[0], yv[1]), cvtpk(yv[2], yv[3])}; }
            sq += __shfl_xor(sq, 32);
            if (h == 0) ssqp[tok * 32 + head * 2 + pt] = sq;
            const float cd = __expf(acs[127]);
            f32x16 sa = zero16(), sb = zero16();
#pragma unroll
            for (int ks = 0; ks < 8; ks += 2) {
                const bf16x8 xa0 = *(const LAS bf16x8*)(L + SS_XT + (32 * pt2 + r) * SSP + (16 * ks + 8 * h) * 2), xa1 = *(const LAS bf16x8*)(L + SS_XT + (32 * pt2 + r) * SSP + (16 * ks + 16 + 8 * h) * 2);
                const bf16x8 bd0 = *(const LAS bf16x8*)(L + SS_BTD + (32 * nt + r) * SSP + (16 * ks + 8 * h) * 2), bd1 = *(const LAS bf16x8*)(L + SS_BTD + (32 * nt + r) * SSP + (16 * ks + 16 + 8 * h) * 2);
                sa = MFMA32(xa0, bd0, sa); sb = MFMA32(xa1, bd1, sb); }
#pragma unroll
            for (int i = 0; i < 16; ++i) hacc[i] = hacc[i] * cd + (sa[i] + sb[i]);
        }
        LBAR();
#pragma unroll
        for (int i = 0; i < 16; ++i) { const int p = 32 * pt2 + (i & 3) + 8 * (i >> 2) + 4 * h; *(LAS unsigned short*)(L + SS_HB + p * SSP + (32 * nt + r) * 2) = (unsigned short)f2bf(hacc[i]); }
    }
    { const int r = F.lane & 31, h = F.lane >> 5;
#pragma unroll
    for (int i = 0; i < 16; ++i) { const int p = 32 * pt2 + (i & 3) + 8 * (i >> 2) + 4 * h; hout[(size_t)p * 128 + 32 * nt + r] = hacc[i]; } }
    __syncthreads();
}

__device__ __forceinline__ void ssd_sample_wave(Frame& F, const Args& A, int v) {
    int lane = F.lane; asm volatile("" : "+v"(lane));
    const int b = v >> 4, head = v & 15, g = head >> 3; const size_t row = (size_t)TP + b;
    LAS float* wl = (LAS float*)(F.lds + RING_OFF + F.wave * 17152);
    const bf16* xbc = WSP(bf16, WS_XBC); const float* cc = A.in[4]; const float* conv_w = A.in[16]; const float* conv_b = A.in[17];
#pragma unroll
    for (int i = 0; i < 5; ++i) { const int c = lane + 64 * i; const int col = c < 64 ? head * 64 + c : (c < 192 ? 1024 + g * 128 + (c - 64) : 1280 + g * 128 + (c - 192));
        float x = conv_b[col] + conv_w[3 * 1536 + col] * bf2f(xbc[row * 1536 + col]);
#pragma unroll
        for (int w = 0; w < 3; ++w) x += conv_w[w * 1536 + col] * cc[((size_t)b * 3 + w) * 1536 + col];
        wl[c] = silu_f(x); }
    const float dt = WSP(float, WS_DTB)[row * 16 + head], dec = __expf(-dt * __expf(A.in[19][head])), dsk = A.in[20][head];
    LDS_WAIT(); asm volatile("" ::: "memory");
    const float x = wl[lane], dtx = dt * x;
    const GAS f32x4* hp = (const GAS f32x4*)(A.in[5] + (size_t)v * 8192 + lane * 128); GAS f32x4* op = (GAS f32x4*)(F.out + O_SSS + (size_t)v * 8192 + lane * 128);
    float y = 0.f;
#pragma unroll
    for (int jb = 0; jb < 4; ++jb) { f32x4 hv[8];
#pragma unroll
        for (int j = 0; j < 8; ++j) hv[j] = hp[8 * jb + j];
#pragma unroll
        for (int j = 0; j < 8; ++j) { const f32x4 B4 = *(const LAS f32x4*)(wl + 64 + 4 * (8 * jb + j)), C4 = *(const LAS f32x4*)(wl + 192 + 4 * (8 * jb + j));
            const f32x4 hn = hv[j] * dec + B4 * dtx; y += (C4.x * hn.x + C4.y * hn.y) + (C4.z * hn.z + C4.w * hn.w); op[8 * jb + j] = hn; } }
    y = (y + dsk * x) * bf2f(WSP(bf16, WS_ZG)[row * 1024 + head * 64 + lane]);
    WSP(bf16, WS_MIX)[row * 1536 + 512 + head * 64 + lane] = (bf16)f2bf(y);
    const float sq = wave_sum(y * y);
    if (lane < 2) WSP(float, WS_SSQP)[row * 32 + head * 2 + lane] = lane == 0 ? sq : 0.f;
    asm volatile("s_waitcnt lgkmcnt(0)" ::: "memory");
}
__device__ __forceinline__ void attn_sample_wave(Frame& F, const Args& A, int v) {
    int lane = F.lane; asm volatile("" : "+v"(lane));
    const int bs = v >> 3, hd = v & 7; const size_t row = (size_t)TP + bs;
    LAS float* ql = (LAS float*)(F.lds + RING_OFF + F.wave * 17152);
    LAS float* T = ql + 64;
    const float* ck = A.in[2]; const float* cv = A.in[3]; const float* relb = A.in[9];
    const float qv = bf2f(WSP(bf16, WS_QB)[row * 512 + hd * 64 + lane]), kn = bf2f(WSP(bf16, WS_KB)[row * 512 + hd * 64 + lane]), vn = bf2f(WSP(bf16, WS_VB)[row * 512 + hd * 64 + lane]);
    ql[lane] = qv;
    const float s0 = wave_sum(qv * kn) + relb[hd] * 1.44269504f;
    LDS_WAIT(); asm volatile("" ::: "memory");
    float m = lane == 0 ? s0 : -1e30f, l = lane == 0 ? 3.f : 0.f, o[64];
#pragma unroll
    for (int d = 0; d < 64; ++d) { const float vd = __shfl(vn, d); o[d] = lane == 0 ? 3.f * vd : 0.f; }
#pragma unroll 1
    for (int t = 0; t < 6; ++t) {
        const int e = lane + 64 * t, p = e >> 7, j = (e & 127) + 1, dist = j << (2 * p);
        const size_t off = (((size_t)bs * 2048 + (2048 - dist)) * 8 + hd) * 64;
        float s = relb[t5_bucket(dist) * 8 + hd] * 1.44269504f;
        { const GAS f32x4* kp = (const GAS f32x4*)(ck + off); f32x4 kr[16];
#pragma unroll
          for (int c = 0; c < 16; ++c) kr[c] = kp[c];
#pragma unroll
          for (int c = 0; c < 16; ++c) { const f32x4 q4 = *(const LAS f32x4*)(ql + 4 * c); s += (q4.x * kr[c].x + q4.y * kr[c].y) + (q4.z * kr[c].z + q4.w * kr[c].w); } }
        const float mn = fmaxf(m, s), sc = __builtin_amdgcn_exp2f(m - mn), pe = __builtin_amdgcn_exp2f(s - mn); l = l * sc + pe; m = mn;
        { const GAS f32x4* vp = (const GAS f32x4*)(cv + off); f32x4 vr[16];
#pragma unroll
          for (int c = 0; c < 16; ++c) vr[c] = vp[c];
#pragma unroll
          for (int c = 0; c < 16; ++c) { o[4 * c] = o[4 * c] * sc + pe * vr[c].x; o[4 * c + 1] = o[4 * c + 1] * sc + pe * vr[c].y; o[4 * c + 2] = o[4 * c + 2] * sc + pe * vr[c].z; o[4 * c + 3] = o[4 * c + 3] * sc + pe * vr[c].w; } }
    }
    const float M = wave_max(m), f = __builtin_amdgcn_exp2f(m - M); const float Ls = wave_sum(l * f);
#pragma unroll
    for (int d = 0; d < 64; ++d) T[lane * 65 + d] = o[d] * f;
    LDS_WAIT(); asm volatile("" ::: "memory");
    float acc = 0.f;
#pragma unroll 8
    for (int r = 0; r < 64; ++r) acc += T[r * 65 + lane];
    WSP(bf16, WS_MIX)[row * 1536 + hd * 64 + lane] = (bf16)f2bf(acc / Ls);
    LDS_WAIT(); asm volatile("" ::: "memory");
}
__device__ __forceinline__ void cross_sample_block(Frame& F, const Args& A, int pair) {
    int lane = F.lane; asm volatile("" : "+v"(lane));
    const int w = F.wave, task = pair * 2 + (w >> 2), kq = w & 3, bs = task >> 2, hx = task & 3; const size_t row = (size_t)TP + bs;
    const float* cmk = A.in[6]; const float* cmv = A.in[7];
    LAS float* X = (LAS float*)(F.lds + RING_OFF);
    float q[4]; { const v2u qw = *(const GAS v2u*)(WSP(bf16, WS_QC) + row * 1024 + hx * 256 + lane * 4); q[0] = bf2f(qw.x & 0xffffu); q[1] = __uint_as_float(qw.x & 0xffff0000u); q[2] = bf2f(qw.y & 0xffffu); q[3] = __uint_as_float(qw.y & 0xffff0000u); }
    const size_t kbase = (((size_t)bs * 256 + kq * 64) * 4 + hx) * 256 + lane * 4;
    float keep = 0.f;
#pragma unroll 1
    for (int kb = 0; kb < 4; ++kb) { f32x4 kr[16]; float d[16];
#pragma unroll
        for (int i = 0; i < 16; ++i) kr[i] = *(const GAS f32x4*)(cmk + kbase + (size_t)(kb * 16 + i) * 1024);
#pragma unroll
        for (int i = 0; i < 16; ++i) d[i] = (q[0] * kr[i].x + q[1] * kr[i].y) + (q[2] * kr[i].z + q[3] * kr[i].w);
#pragma unroll
        for (int o = 1; o < 64; o <<= 1) {
#pragma unroll
            for (int i = 0; i < 16; ++i) d[i] += __shfl_xor(d[i], o); }
#pragma unroll
        for (int i = 0; i < 16; ++i) keep = (lane == kb * 16 + i) ? d[i] : keep; }
    const float mw = wave_max(keep), pe = __expf(keep - mw), lw = wave_sum(pe);
    float o[4] = {0.f, 0.f, 0.f, 0.f};
#pragma unroll 1
    for (int kb = 0; kb < 4; ++kb) { f32x4 vr[16];
#pragma unroll
        for (int i = 0; i < 16; ++i) vr[i] = *(const GAS f32x4*)(cmv + kbase + (size_t)(kb * 16 + i) * 1024);
#pragma unroll
        for (int i = 0; i < 16; ++i) { const float wgt = rdlane(pe, kb * 16 + i); o[0] += wgt * vr[i].x; o[1] += wgt * vr[i].y; o[2] += wgt * vr[i].z; o[3] += wgt * vr[i].w; } }
    __syncthreads();
    *(LAS f32x4*)(X + w * 260 + lane * 4) = (f32x4){o[0], o[1], o[2], o[3]};
    if (lane == 0) { X[w * 260 + 256] = mw; X[w * 260 + 257] = lw; }
    __syncthreads();
    if (kq == 0) { const int w0 = w;
        float mm[4], ll[4];
#pragma unroll
        for (int i = 0; i < 4; ++i) { mm[i] = X[(w0 + i) * 260 + 256]; ll[i] = X[(w0 + i) * 260 + 257]; }
        const float M = fmaxf(fmaxf(mm[0], mm[1]), fmaxf(mm[2], mm[3])); float Ls = 0.f; f32x4 acc = (f32x4){0.f, 0.f, 0.f, 0.f};
#pragma unroll
        for (int i = 0; i < 4; ++i) { const float f = __expf(mm[i] - M); Ls += f * ll[i]; acc += *(const LAS f32x4*)(X + (w0 + i) * 260 + lane * 4) * f; }
        const float inv = 1.f / Ls;
        *(GAS v2u*)(WSP(bf16, WS_OC) + row * 1024 + hx * 256 + lane * 4) = (v2u){pk2(acc.x * inv, acc.y * inv), pk2(acc.z * inv, acc.w * inv)}; }
    __syncthreads();
}

#define SAMPLE_SPLIT(EPI, E, g, KS, IDX) do { pg8::Gemm g2{(g).A, (g).Bt, 256, (g).N, 256, (g).lda, (g).ldb}; pg8::SplitOrder S2; S2.init((g).N, (KS), 256, F.G, (int)blockIdx.x); \
        pg8::EpiSplit<EPI> E2{(E), WSP(float, WS_SLAB), (unsigned*)(F.ctl + CW_TICK + (IDX) * TICK_WORDS), (KS)}; \
        pg8::gemm_phase<pg8::EpiSplit<EPI>, pg8::SplitOrder, PG8_ALIGN, PG8_SP2>(F.lds + RING_OFF, g2, S2, E2, F.wave); } while (0)
__global__ void __launch_bounds__(NWAVES * 64, 2) hymba_fwd(Args args) {
    extern __shared__ __attribute__((aligned(16))) unsigned char lds[];
    Frame F;
    F.lds = (LAS unsigned char*)lds; F.MISC = (volatile LAS unsigned*)(F.lds + MISC_OFF);
    F.wave = __builtin_amdgcn_readfirstlane(threadIdx.x >> 6); refresh(F);
    F.G = gridDim.x; { const int bx = blockIdx.x; F.vcu = (F.G % 8 == 0) ? (bx % 8) * (F.G / 8) + bx / 8 : bx; }
    F.out = args.out; F.ws = args.ws; F.ctl = (gu32*)(args.ws + WS_CTL);
    for (int u = F.tid; u < (LDS_BYTES - LDSCTL_OFF) / 4; u += NWAVES * 64) ((LAS unsigned*)(F.lds + LDSCTL_OFF))[u] = 0u;
    __syncthreads();
    XcdBarrier bar; bar.bar = (unsigned*)(F.ctl + CW_BAR); bar.x = 0; bar.st = nullptr;
    if (!MK_SPLIT) bar = xcd_barrier_post((unsigned*)(F.ctl + CW_BAR), F.MISC + 8, F.tid == 0);
    const int lo = args.ph_lo, hi = args.ph_hi;
#define IN(k) (lo <= (k) && (k) < hi)
#define SEAM(k) do { if (IN(k) && IN((k) + 1)) { refresh(F); xcd_barrier(bar, F.tid == 0); } } while (0)
    const int gw = F.vcu * NWAVES + F.wave, NGW = F.G * NWAVES;
    float* out = args.out;

    if (IN(0)) { refresh(F); p0_prologue(F, args); } SEAM(0);
    if (IN(1)) { refresh(F); pg8::Gemm g{WSP(bf16, WS_XB), WSP(bf16, WS_W1GU), TP, 2 * DFF, 1024, 1024, 1024}; pg8::StaticOrder S; S.init(TP, 2 * DFF, F.G, (int)blockIdx.x);
        pg8::EpiGateUp E{WSP(bf16, WS_U), WSP(float, WS_RQ0)};
        pg8::gemm_phase<pg8::EpiGateUp, pg8::StaticOrder, PG8_ALIGN, PG8_SP2>(F.lds + RING_OFF, g, S, E, F.wave);
        SAMPLE_SPLIT(pg8::EpiGateUp, E, g, 4, 0); } SEAM(1);
    if (IN(2)) { refresh(F); pg8::Gemm g{WSP(bf16, WS_U), WSP(bf16, WS_W1D), TP, 1024, DFF, DFF, DFF}; pg8::StaticOrder S; S.init(TP, 1024, F.G, (int)blockIdx.x);
        pg8::EpiResid E{WSP(bf16, WS_XB), 0.5f, WSP(float, WS_RQ1), nullptr, nullptr};
        pg8::gemm_phase<pg8::EpiResid, pg8::StaticOrder, PG8_ALIGN, PG8_SP2>(F.lds + RING_OFF, g, S, E, F.wave);
        SAMPLE_SPLIT(pg8::EpiResid, E, g, 11, 1); } SEAM(2);
    if (IN(3)) { refresh(F); pg8::Gemm g{WSP(bf16, WS_XB), WSP(bf16, WS_WIN), TP, NINP, 1024, 1024, 1024}; pg8::StaticOrder S; S.init(TP, NINP, F.G, (int)blockIdx.x);
        pg8::EpiInProj E{WSP(float, WS_RQ1), WSP(bf16, WS_QB), WSP(bf16, WS_KB), WSP(bf16, WS_VB), WSP(bf16, WS_ZG), WSP(bf16, WS_XBC), WSP(float, WS_DTB), args.in[18],
                         out + O_WKP, out + O_WVP, out + O_CVP, out + O_WKS, out + O_WVS, out + O_CVS};
        pg8::gemm_phase<pg8::EpiInProj, pg8::StaticOrder, PG8_ALIGN, PG8_SP2>(F.lds + RING_OFF, g, S, E, F.wave);
        SAMPLE_SPLIT(pg8::EpiInProj, E, g, 4, 2); } SEAM(3);
    if (IN(4)) { refresh(F);
        for (int v = gw; v < TS * NHB; v += NGW) ssd_sample_wave(F, args, v);
        for (int v = gw; v < TS * NHA; v += NGW) attn_sample_wave(F, args, v);
        bc_conv_prepass(F, args);
        attn_mfma_phase(F, args);
        refresh(F); xcd_barrier(bar, F.tid == 0);
        refresh(F);
        for (int u = blockIdx.x; u < NB * NHB; u += F.G) { const int b = u >> 4, hd = u & 15; ssd_mfma_unit(F, args, b, hd, out + O_SSP + (size_t)u * 8192); }
    } SEAM(4);
    if (IN(5)) { refresh(F); bf16* mix = WSP(bf16, WS_MIX); const float* ssqp = WSP(float, WS_SSQP);
        { const bf16* part = WSP(bf16, WS_PART); const float* lsep = WSP(float, WS_LSE); const int hd = F.lane >> 3;
          for (int m0 = gw; m0 < TP; m0 += 4 * NGW) {
              v4u pa[4][3]; float ls[4][3];
#pragma unroll
              for (int q = 0; q < 4; ++q) { const int m = min(m0 + q * NGW, TP - 1);
#pragma unroll
                  for (int p = 0; p < 3; ++p) { ls[q][p] = lsep[((size_t)p * TP + m) * 8 + hd]; pa[q][p] = *(const GAS v4u*)(part + ((size_t)p * TP + m) * 512 + F.lane * 8); } }
#pragma unroll
              for (int q = 0; q < 4; ++q) { const int m = m0 + q * NGW; if (m >= TP) continue;
                  const float mx = fmaxf(ls[q][0], fmaxf(ls[q][1], ls[q][2])); float e0 = __expf(ls[q][0] - mx), e1 = __expf(ls[q][1] - mx), e2 = __expf(ls[q][2] - mx); const float inv = 1.f / (e0 + e1 + e2); e0 *= inv; e1 *= inv; e2 *= inv;
                  float a[8], bq[8], c[8]; unpack8(pa[q][0], a); unpack8(pa[q][1], bq); unpack8(pa[q][2], c);
                  v4u o; o.x = pk2(e0 * a[0] + e1 * bq[0] + e2 * c[0], e0 * a[1] + e1 * bq[1] + e2 * c[1]); o.y = pk2(e0 * a[2] + e1 * bq[2] + e2 * c[2], e0 * a[3] + e1 * bq[3] + e2 * c[3]);
                  o.z = pk2(e0 * a[4] + e1 * bq[4] + e2 * c[4], e0 * a[5] + e1 * bq[5] + e2 * c[5]); o.w = pk2(e0 * a[6] + e1 * bq[6] + e2 * c[6], e0 * a[7] + e1 * bq[7] + e2 * c[7]);
                  *(GAS v4u*)(mix + (size_t)m * 1536 + F.lane * 8) = o; } } }
        { float* rs2 = WSP(float, WS_RS2);
          for (int m0 = gw * 2; m0 < TP; m0 += 2 * NGW) { const int m = m0 + (F.lane >> 5);
              float pv = ssqp[(size_t)m * 32 + (F.lane & 31)]; pv += __shfl_xor(pv, 1); pv += __shfl_xor(pv, 2); pv += __shfl_xor(pv, 4); pv += __shfl_xor(pv, 8);
              if ((F.lane & 15) == 0) rs2[2 * (size_t)m + ((F.lane >> 4) & 1)] = rsqrtf(pv * (1.f / 512.f) + EPS); } }
        for (int m = TP + gw; m < MROWS; m += NGW) {
            GAS v4u* p = (GAS v4u*)(mix + (size_t)m * 1536 + 512) + F.lane; v4u w0 = p[0], w1 = p[64];
            float pv = ssqp[(size_t)m * 32 + (F.lane & 31)]; pv += __shfl_xor(pv, 1); pv += __shfl_xor(pv, 2); pv += __shfl_xor(pv, 4); pv += __shfl_xor(pv, 8);
            const float s0 = rsqrtf(rdlane(pv, 0) * (1.f / 512.f) + EPS), s1 = rsqrtf(rdlane(pv, 16) * (1.f / 512.f) + EPS);
            float f[8]; unpack8(w0, f); v4u o; o.x = pk2(f[0] * s0, f[1] * s0); o.y = pk2(f[2] * s0, f[3] * s0); o.z = pk2(f[4] * s0, f[5] * s0); o.w = pk2(f[6] * s0, f[7] * s0); p[0] = o;
            unpack8(w1, f); o.x = pk2(f[0] * s1, f[1] * s1); o.y = pk2(f[2] * s1, f[3] * s1); o.z = pk2(f[4] * s1, f[5] * s1); o.w = pk2(f[6] * s1, f[7] * s1); p[64] = o;
        }
    } SEAM(5);
    if (IN(6)) { refresh(F); pg8::Gemm g{WSP(bf16, WS_MIX), WSP(bf16, WS_WOUT), TP, 1024, DMIX, DMIX, DMIX}; pg8::StaticOrder S; S.init(TP, 1024, F.G, (int)blockIdx.x);
        pg8::EpiResidKS EK{WSP(bf16, WS_XB), WSP(float, WS_RQ2), WSP(float, WS_RS2)};
        pg8::gemm_phase<pg8::EpiResidKS, pg8::StaticOrder, PG8_ALIGN, PG8_SP2>(F.lds + RING_OFF, g, S, EK, F.wave);
        pg8::EpiResid E{WSP(bf16, WS_XB), 1.0f, WSP(float, WS_RQ2), nullptr, nullptr};
        SAMPLE_SPLIT(pg8::EpiResid, E, g, 6, 3); } SEAM(6);
    if (IN(7)) { refresh(F);
        { pg8::Gemm g{WSP(bf16, WS_XB), WSP(bf16, WS_WCQ), TP, 1024, 1024, 1024, 1024}; pg8::StaticOrder S; S.init(TP, 1024, F.G, (int)blockIdx.x);
          pg8::EpiScale E{WSP(bf16, WS_QC), 1024, WSP(float, WS_RQ2), 0.0625f};
          pg8::gemm_phase<pg8::EpiScale, pg8::StaticOrder, PG8_ALIGN, PG8_SP2>(F.lds + RING_OFF, g, S, E, F.wave);
          SAMPLE_SPLIT(pg8::EpiScale, E, g, 4, 4); }
        { pg8::Gemm g{WSP(bf16, WS_MEMB), WSP(bf16, WS_WMEM), NB * NMEM, 2048, 1024, 1024, 1024}; pg8::StaticOrder S; S.init(NB * NMEM, 2048, F.G, (int)blockIdx.x);
          pg8::EpiMemKV E{WSP(float, WS_RMEM), out + O_MKP, out + O_MVP, WSP(bf16, WS_MKB), WSP(bf16, WS_MVB)};
          pg8::gemm_phase<pg8::EpiMemKV, pg8::StaticOrder, PG8_ALIGN, PG8_SP2>(F.lds + RING_OFF, g, S, E, F.wave); }
    } SEAM(7);
    if (IN(8)) { refresh(F); for (int pr = blockIdx.x; pr < TS * 4 / 2; pr += F.G) cross_sample_block(F, args, pr);
        cross_mfma_phase(F); } SEAM(8);
    if (IN(9)) { refresh(F); pg8::Gemm g{WSP(bf16, WS_OC), WSP(bf16, WS_WCO), TP, 1024, 1024, 1024, 1024}; pg8::StaticOrder S; S.init(TP, 1024, F.G, (int)blockIdx.x);
        pg8::EpiResid E{WSP(bf16, WS_XB), 1.0f, WSP(float, WS_RQ3), nullptr, nullptr};
        pg8::gemm_phase<pg8::EpiResid, pg8::StaticOrder, PG8_ALIGN, PG8_SP2>(F.lds + RING_OFF, g, S, E, F.wave);
        SAMPLE_SPLIT(pg8::EpiResid, E, g, 4, 5); } SEAM(9);
    if (IN(10)) { refresh(F); pg8::Gemm g{WSP(bf16, WS_XB), WSP(bf16, WS_W2GU), TP, 2 * DFF, 1024, 1024, 1024}; pg8::StaticOrder S; S.init(TP, 2 * DFF, F.G, (int)blockIdx.x);
        pg8::EpiGateUp E{WSP(bf16, WS_U), WSP(float, WS_RQ3)};
        pg8::gemm_phase<pg8::EpiGateUp, pg8::StaticOrder, PG8_ALIGN, PG8_SP2>(F.lds + RING_OFF, g, S, E, F.wave);
        SAMPLE_SPLIT(pg8::EpiGateUp, E, g, 4, 6); } SEAM(10);
    if (IN(11)) { refresh(F); pg8::Gemm g{WSP(bf16, WS_U), WSP(bf16, WS_W2D), TP, 1024, DFF, DFF, DFF}; pg8::StaticOrder S; S.init(TP, 1024, F.G, (int)blockIdx.x);
        pg8::EpiResid E{WSP(bf16, WS_XB), 0.5f, WSP(float, WS_RQ4), nullptr, nullptr};
        pg8::gemm_phase<pg8::EpiResid, pg8::StaticOrder, PG8_ALIGN, PG8_SP2>(F.lds + RING_OFF, g, S, E, F.wave);
        SAMPLE_SPLIT(pg8::EpiResid, E, g, 11, 7); } SEAM(11);
    if (IN(12)) { refresh(F); const float* rq = WSP(float, WS_RQ4); const GAS f32x4* gp = (const GAS f32x4*)args.in[33] + 2 * F.lane; const bf16* xb = WSP(bf16, WS_XB);
        f32x4 gg[2][2];
#pragma unroll
        for (int j = 0; j < 2; ++j) { gg[j][0] = gp[128 * j]; gg[j][1] = gp[128 * j + 1]; }
        for (int m0 = gw; m0 < MROWS; m0 += 4 * NGW) {
            v4u v[4][2]; float rs[4];
#pragma unroll
            for (int q = 0; q < 4; ++q) { const int m = min(m0 + q * NGW, MROWS - 1); { const GAS v4u* p = (const GAS v4u*)(xb + (size_t)m * 1024) + F.lane; v[q][0] = p[0]; v[q][1] = p[64]; rs[q] = rsqrtf(rq[m] * (1.f / 1024.f) + EPS); } }
#pragma unroll
            for (int q = 0; q < 4; ++q) { const int m = m0 + q * NGW; if (m < MROWS) { GAS f32x4* p = (GAS f32x4*)(m < TP ? out + O_YP + (size_t)m * 1024 : out + O_YS + (size_t)(m - TP) * 1024) + 2 * F.lane;
#pragma unroll
                for (int j = 0; j < 2; ++j) { float f[8]; unpack8(v[q][j], f);
                    p[128 * j] = (f32x4){f[0], f[1], f[2], f[3]} * rs[q] * gg[j][0]; p[128 * j + 1] = (f32x4){f[4], f[5], f[6], f[7]} * rs[q] * gg[j][1]; } } }
        }
    }
#undef IN
#undef SEAM
}

extern "C" void kernel_launch(void* const* d_in, const int* in_sizes, int n_in, void* d_out, int out_size, void* d_ws, size_t ws_size, hipStream_t stream) {
    static int grid = 0;
    if (grid == 0) {
        if (n_in != 34 || (size_t)out_size != O_END || ws_size < WS_END) { fprintf(stderr, "kernel_launch: unexpected sizes n_in %d out %d ws %zu\n", n_in, out_size, ws_size); grid = -1; return; }
        int dev = 0, cus = 0, per_cu = 0;
        if (hipGetDevice(&dev) != hipSuccess || hipDeviceGetAttribute(&cus, hipDeviceAttributeMultiprocessorCount, dev) != hipSuccess) { grid = -1; return; }
        if (hipFuncSetAttribute((const void*)hymba_fwd, hipFuncAttributeMaxDynamicSharedMemorySize, LDS_BYTES) != hipSuccess) { fprintf(stderr, "kernel_launch: hipFuncSetAttribute failed\n"); grid = -1; return; }
        if (hipOccupancyMaxActiveBlocksPerMultiprocessor(&per_cu, (const void*)hymba_fwd, NWAVES * 64, LDS_BYTES) != hipSuccess || per_cu < 1) fprintf(stderr, "kernel_launch: occupancy query reports %d\n", per_cu);
        (void)hipGetLastError();
        grid = cus;
    }
    if (grid < 0) return;
    if (hipMemsetAsync((char*)d_ws + WS_CTL, 0, CTL_ZERO_BYTES, stream) != hipSuccess) return;
    Args a{};
    for (int i = 0; i < 34; ++i) a.in[i] = (const float*)d_in[i];
    a.out = (float*)d_out; a.ws = (unsigned char*)d_ws; a.li = 0; a.pad = 0;
#if MK_SPLIT
    for (int ph = 0; ph < NPHASE; ++ph) { a.ph_lo = ph; a.ph_hi = ph + 1; hipLaunchKernelGGL(hymba_fwd, dim3(grid), dim3(NWAVES * 64), LDS_BYTES, stream, a); }
#else
    a.ph_lo = 0; a.ph_hi = NPHASE;
    hipLaunchKernelGGL(hymba_fwd, dim3(grid), dim3(NWAVES * 64), LDS_BYTES, stream, a);
#endif
}
```

```cpp
#include <hip/hip_runtime.h>
#include <cstdio>
#include <cstdint>
namespace pg8 {
#define PG8_LAS __attribute__((address_space(3)))
typedef unsigned short bf16_t;
typedef short bf16x8 __attribute__((ext_vector_type(8)));
typedef float f32x4 __attribute__((ext_vector_type(4)));
typedef unsigned u32x4 __attribute__((ext_vector_type(4)));
constexpr int BM = 256, BK = 64, HALF = 128, HTB = HALF * BK * 2  , STAGE_BYTES = 8 * HTB, NXCD = 8, WGM = 8;

__host__ __device__ __forceinline__ int lds_byte(int r, int c) { const int st = (r >> 4) * 2 + (c >> 5), rr = r & 15, cc = c & 31, ob = rr * 64 + cc * 2; return st * 1024 + (ob ^ (((ob >> 9) & 1) << 5)); }
__host__ __device__ __forceinline__ void stage_rc(int b, int& R, int& C) { const int st = b / 1024, sb = b % 1024, swz = sb ^ (((sb >> 9) & 1) << 5); R = (st >> 1) * 16 + swz / 64; C = (st & 1) * 32 + (swz % 64) / 2; }
__host__ __device__ __forceinline__ int perm32(int rho) { const int n = rho >> 4, i = rho & 15; return 8 * (i >> 2) + 4 * n + (i & 3); }

struct Unit { int pm, pn, koff, ks; };
struct Gemm { const bf16_t* A; const bf16_t* Bt; int M, N, K, lda, ldb; };

struct StaticOrder {
    int nM, nN, nwg, G, c;
    __host__ __device__ void init(int M, int N, int G_, int c_) { nM = M / BM; nN = N / BM; nwg = nM * nN; G = G_; c = c_; }
    __host__ __device__ bool next(int i, Unit& u) const {
        const long L = (long)i * G + c; if (L >= nwg) return false;
        int wgid = (int)L; { const int q = nwg / NXCD, r = nwg % NXCD, xcd = wgid % NXCD, off = wgid / NXCD; wgid = (xcd < r ? xcd * (q + 1) : r * (q + 1) + (xcd - r) * q) + off; }
        const int nig = WGM * nN, gid = wgid / nig, fm = gid * WGM, gsz = (nM - fm) < WGM ? (nM - fm) : WGM;
        u.pm = fm + ((wgid % nig) % gsz); u.pn = (wgid % nig) / gsz; u.koff = 0; u.ks = 0; return true;
    }
    __device__ __forceinline__ void a_ready(const Unit&) const {}
    __device__ __forceinline__ void done(const Unit&) const {}
};
__device__ __forceinline__ unsigned cvt_pk_bf16(float lo, float hi) { unsigned r; asm volatile("v_cvt_pk_bf16_f32 %0, %1, %2" : "=v"(r) : "v"(lo), "v"(hi)); return r; }
typedef float f32x2 __attribute__((ext_vector_type(2)));
template <class Epi, class Sched, bool ALIGN_EPI = false, bool SP2 = false>
__device__ __forceinline__ void gemm_phase(PG8_LAS unsigned char* lds, const Gemm g, const Sched& S, const Epi& E, const int wid) {
    int lane; asm volatile("v_mbcnt_lo_u32_b32 %0, -1, 0\n\tv_mbcnt_hi_u32_b32 %0, -1, %0" : "=v"(lane));
    const int tid = wid * 64 + lane, wr = wid >> 2, wc = wid & 3, fr = lane & 15, fq = lane >> 4;
    const int K = g.K, nt = K / BK;
    unsigned voffA[2], voffB[2];
#pragma unroll
    for (int i = 0; i < 2; ++i) { int R, C; stage_rc(tid * 16 + i * 8192, R, C); const int Rb = Epi::PERM ? ((R & ~31) + perm32(R & 31)) : R;
        voffA[i] = (unsigned)(R * g.lda + C) * 2u; voffB[i] = (unsigned)(Rb * g.ldb + C) * 2u; }
    const size_t kstep = (size_t)(BK * 2);
    const size_t hstepA = (size_t)HALF * g.lda * 2, hstepB = (size_t)HALF * g.ldb * 2;
    const size_t tstepA = 2 * hstepA, tstepB = 2 * hstepB;
    const unsigned ldsw = (unsigned)wid * 1024u;
    const int aoff = lds_byte(wr * 64 + fr, fq * 8), boff = lds_byte(wc * 32 + fr, fq * 8);
#define PG8_SA(b, h) (((b) * 2 + (h)) * HTB)
#define PG8_SB(b, h) ((4 + (b) * 2 + (h)) * HTB)
#define PG8_STAGE(bufoff, gbase, voff) do { _Pragma("unroll") for (int _i = 0; _i < 2; ++_i) \
        __builtin_amdgcn_global_load_lds((const unsigned*)((const char*)(gbase) + (voff)[_i]), (PG8_LAS unsigned*)(lds + (bufoff) + ldsw + _i * 8192), 16, 0, 0); } while (0)
#define PG8_LDA(dst, b, h) do { _Pragma("unroll") for (int m = 0; m < 4; ++m) _Pragma("unroll") for (int k = 0; k < 2; ++k) dst[m][k] = *(const PG8_LAS bf16x8*)(lds + PG8_SA(b, h) + aoff + m * 2048 + k * 1024); } while (0)
#define PG8_LDB(dst, b, h) do { _Pragma("unroll") for (int n = 0; n < 2; ++n) _Pragma("unroll") for (int k = 0; k < 2; ++k) dst[n][k] = *(const PG8_LAS bf16x8*)(lds + PG8_SB(b, h) + boff + n * 2048 + k * 1024); } while (0)
#define PG8_MMA(ai, bj, At, Bt) do { __builtin_amdgcn_s_setprio(1); _Pragma("unroll") for (int m = 0; m < 4; ++m) _Pragma("unroll") for (int n = 0; n < 2; ++n) _Pragma("unroll") for (int k = 0; k < 2; ++k) \
        acc[ai][bj][m][n] = __builtin_amdgcn_mfma_f32_16x16x32_bf16(Bt[n][k], At[m][k], acc[ai][bj][m][n], 0, 0, 0); __builtin_amdgcn_s_setprio(0); } while (0)
#define PG8_WAIT_V(n) asm volatile("s_waitcnt vmcnt(" #n ")" ::: "memory")
#define PG8_WAIT_L(n) asm volatile("s_waitcnt lgkmcnt(" #n ")" ::: "memory")
#define PG8_BAR __builtin_amdgcn_s_barrier()
#define PG8_SCHED __builtin_amdgcn_sched_barrier(0)
    Unit cur, nxt; int ui = 0;
    if (!S.next(0, cur)) return;
    float pre[8] = {0.f, 0.f, 0.f, 0.f, 0.f, 0.f, 0.f, 0.f};
    f32x4 acc[2][2][4][2];
#pragma unroll
    for (int a = 0; a < 2; ++a)
#pragma unroll
        for (int b = 0; b < 2; ++b)
#pragma unroll
            for (int m = 0; m < 4; ++m)
#pragma unroll
                for (int n = 0; n < 2; ++n) acc[a][b][m][n] = (f32x4){0.f, 0.f, 0.f, 0.f};
    bf16x8 At[4][2], B0[2][2], B1[2][2];
    const char* cA = (const char*)g.A + (size_t)cur.pm * tstepA + cur.koff; const char* cB = (const char*)g.Bt + (size_t)cur.pn * tstepB + cur.koff;
    S.a_ready(cur);
    if constexpr (SP2) {
        PG8_STAGE(PG8_SB(0, 0), cB, voffB); PG8_STAGE(PG8_SB(0, 1), cB + hstepB, voffB); PG8_STAGE(PG8_SA(0, 0), cA, voffA); PG8_STAGE(PG8_SA(0, 1), cA + hstepA, voffA);
        if (wr == 1) PG8_BAR;
        PG8_WAIT_V(2); PG8_BAR;
        PG8_STAGE(PG8_SB(1, 0), cB + kstep, voffB); PG8_STAGE(PG8_SA(1, 0), cA + kstep, voffA); PG8_STAGE(PG8_SB(1, 1), cB + hstepB + kstep, voffB);
        PG8_WAIT_V(6); PG8_BAR;
    } else {
        PG8_STAGE(PG8_SB(0, 0), cB, voffB); PG8_STAGE(PG8_SA(0, 0), cA, voffA); PG8_STAGE(PG8_SB(0, 1), cB + hstepB, voffB); PG8_STAGE(PG8_SA(0, 1), cA + hstepA, voffA);
        if (wr == 1) PG8_BAR;
        PG8_WAIT_V(4); PG8_BAR;
        PG8_STAGE(PG8_SB(1, 0), cB + kstep, voffB); PG8_STAGE(PG8_SA(1, 0), cA + kstep, voffA); PG8_STAGE(PG8_SB(1, 1), cB + hstepB + kstep, voffB);
        PG8_WAIT_V(6); PG8_BAR;
    }
    for (;;) {
        const bool has_next = S.next(ui + 1, nxt);
        const char* nA = has_next ? (const char*)g.A + (size_t)nxt.pm * tstepA + nxt.koff : cA; const char* nB = has_next ? (const char*)g.Bt + (size_t)nxt.pn * tstepB + nxt.koff : cB;
        for (int t = 0; t < nt; t += 2) {
            if constexpr (Epi::KSEG > 0) { if (t == Epi::KSEG || t == 2 * Epi::KSEG) E.kseg(acc, cur, t, wr, fr); }
            if constexpr (Epi::PRE) { if (t == nt - 2) E.preload(cur, wr, fr, pre); }
            const bool last = (t == nt - 2);
            const char* a1 = cA + (size_t)(t + 1) * kstep;
            const char* a2 = last ? nA : cA + (size_t)(t + 2) * kstep; const char* b2 = last ? nB : cB + (size_t)(t + 2) * kstep;
            const char* a3 = a2 + kstep; const char* b3 = b2 + kstep;
            if (last && has_next) S.a_ready(nxt);
            if constexpr (SP2) {
            PG8_LDB(B0, 0, 0); PG8_LDB(B1, 0, 1); PG8_SCHED; PG8_LDA(At, 0, 0); PG8_STAGE(PG8_SA(1, 1), a1 + hstepA, voffA);
            PG8_WAIT_V(8); PG8_WAIT_L(0); PG8_BAR; PG8_MMA(0, 0, At, B0); PG8_MMA(0, 1, At, B1); PG8_BAR; PG8_SCHED;
            PG8_LDA(At, 0, 1); PG8_STAGE(PG8_SB(0, 0), b2, voffB); PG8_STAGE(PG8_SB(0, 1), b2 + hstepB, voffB); PG8_STAGE(PG8_SA(0, 0), a2, voffA);
            PG8_WAIT_V(8); PG8_WAIT_L(0); PG8_BAR; PG8_MMA(1, 0, At, B0); PG8_MMA(1, 1, At, B1); PG8_BAR; PG8_SCHED;
            PG8_LDB(B0, 1, 0); PG8_LDB(B1, 1, 1); PG8_SCHED; PG8_LDA(At, 1, 0); PG8_STAGE(PG8_SA(0, 1), a2 + hstepA, voffA);
            PG8_WAIT_V(8); PG8_WAIT_L(0); PG8_BAR; PG8_MMA(0, 0, At, B0); PG8_MMA(0, 1, At, B1); PG8_BAR; PG8_SCHED;
            PG8_LDA(At, 1, 1); PG8_STAGE(PG8_SB(1, 0), b3, voffB); PG8_STAGE(PG8_SB(1, 1), b3 + hstepB, voffB); PG8_STAGE(PG8_SA(1, 0), a3, voffA);
            PG8_WAIT_V(8); PG8_WAIT_L(0); PG8_BAR; PG8_MMA(1, 0, At, B0); PG8_MMA(1, 1, At, B1); PG8_BAR; PG8_SCHED;
            } else {
            PG8_LDB(B0, 0, 0); PG8_SCHED; PG8_LDA(At, 0, 0); PG8_STAGE(PG8_SA(1, 1), a1 + hstepA, voffA);
            PG8_WAIT_L(8); PG8_BAR; PG8_WAIT_L(0); PG8_MMA(0, 0, At, B0); PG8_BAR; PG8_SCHED;
            PG8_LDB(B1, 0, 1); PG8_STAGE(PG8_SB(0, 0), b2, voffB);
            PG8_BAR; PG8_WAIT_L(0); PG8_MMA(0, 1, At, B1); PG8_BAR;
            PG8_LDA(At, 0, 1); PG8_STAGE(PG8_SA(0, 0), a2, voffA);
            PG8_BAR; PG8_WAIT_L(0); PG8_MMA(1, 0, At, B0); PG8_BAR; PG8_SCHED;
            PG8_STAGE(PG8_SB(0, 1), b2 + hstepB, voffB);
            PG8_WAIT_V(6); PG8_BAR; PG8_MMA(1, 1, At, B1); PG8_BAR;
            PG8_LDB(B0, 1, 0); PG8_SCHED; PG8_LDA(At, 1, 0); PG8_STAGE(PG8_SA(0, 1), a2 + hstepA, voffA);
            PG8_WAIT_L(8); PG8_BAR; PG8_WAIT_L(0); PG8_MMA(0, 0, At, B0); PG8_BAR; PG8_SCHED;
            PG8_LDB(B1, 1, 1); PG8_STAGE(PG8_SB(1, 0), b3, voffB);
            PG8_BAR; PG8_WAIT_L(0); PG8_MMA(0, 1, At, B1); PG8_BAR;
            PG8_LDA(At, 1, 1); PG8_STAGE(PG8_SA(1, 0), a3, voffA);
            PG8_BAR; PG8_WAIT_L(0); PG8_MMA(1, 0, At, B0); PG8_BAR; PG8_SCHED;
            PG8_STAGE(PG8_SB(1, 1), b3 + hstepB, voffB);
            PG8_WAIT_V(6); PG8_BAR; PG8_MMA(1, 1, At, B1); PG8_BAR;
            }
        }
        if constexpr (ALIGN_EPI) { if (wr == 0) PG8_BAR; }
        if constexpr (!Epi::AFTER_DRAIN) { if constexpr (Epi::PRE) E(acc, cur, wr, wc, fr, fq, pre); else E(acc, cur, wr, wc, fr, fq); S.done(cur); }
        if (!has_next) break;
#pragma unroll
        for (int a = 0; a < 2; ++a)
#pragma unroll
            for (int b = 0; b < 2; ++b)
#pragma unroll
                for (int m = 0; m < 4; ++m)
#pragma unroll
                    for (int n = 0; n < 2; ++n) acc[a][b][m][n] = (f32x4){0.f, 0.f, 0.f, 0.f};
        cur = nxt; cA = nA; cB = nB; ++ui;
        if constexpr (ALIGN_EPI) { if (wr == 1) PG8_BAR; }
    }
    PG8_WAIT_V(0);
    if constexpr (!ALIGN_EPI) { if (wr == 0) PG8_BAR; }
    PG8_BAR;
    if constexpr (Epi::AFTER_DRAIN) { E.fused(acc, cur, wr, wc, fr, fq, lds, wid, lane); S.done(cur); }
#undef PG8_SA
#undef PG8_SB
#undef PG8_STAGE
#undef PG8_LDA
#undef PG8_LDB
#undef PG8_MMA
#undef PG8_WAIT_V
#undef PG8_WAIT_L
#undef PG8_BAR
#undef PG8_SCHED
}
}

#define GAS __attribute__((address_space(1)))
#define LAS __attribute__((address_space(3)))
typedef unsigned short bf16;
typedef unsigned v4u __attribute__((ext_vector_type(4)));
typedef unsigned v2u __attribute__((ext_vector_type(2)));
typedef float f32x4 __attribute__((ext_vector_type(4)));
typedef GAS unsigned gu32;
#define RLX_AGENT __ATOMIC_RELAXED, __HIP_MEMORY_SCOPE_AGENT
#define LDS_WAIT() asm volatile("s_waitcnt lgkmcnt(0)" ::: "memory")
#define VM_WAIT() asm volatile("s_waitcnt vmcnt(0)" ::: "memory")
#define LBAR() do { asm volatile("s_waitcnt lgkmcnt(0)" ::: "memory"); __builtin_amdgcn_s_barrier(); asm volatile("" ::: "memory"); } while (0)

constexpr int DM = 1024, NB = 32, SEQ = 2048, TP = NB * SEQ, TS = 128, MROWS = TP + TS, MT = 65792;
constexpr int DATT = 512, DINNER = 1024, DXBC = 1536, DMIX = 1536, DFF = 2816, NIN = 4112, NINP = 4352, NHA = 8, NHB = 16, NMEM = 256;
constexpr float EPS = 1e-6f;
constexpr size_t O_YP = 0, O_YS = 67108864, O_WKP = 67239936, O_WVP = 100794368, O_CVP = 134348800, O_SSP = 134496256, O_MKP = 138690560, O_MVP = 147079168,
                 O_WKS = 155467776, O_WVS = 155533312, O_CVS = 155598848, O_SSS = 156188672, O_END = 172965888;
constexpr size_t MiB = 1u << 20;
constexpr size_t WS_CTL = 0, CTL_ZERO_BYTES = 4 * MiB;
constexpr size_t WS_RQ1 = 1 * MiB, WS_RQ2 = WS_RQ1 + 512 * 1024, WS_RQ3 = 2 * MiB, WS_RQ4 = WS_RQ3 + 512 * 1024, WS_SSQ = 3 * MiB;
constexpr size_t WS_RQ0 = 4 * MiB, WS_RMEM = WS_RQ0 + 512 * 1024, WS_RS2 = 5 * MiB;
constexpr size_t WS_W1GU = 8 * MiB, WS_W1D = 19 * MiB, WS_WIN = 25 * MiB, WS_WOUT = 34 * MiB, WS_WCQ = 37 * MiB, WS_WCO = 39 * MiB, WS_WMEM = 41 * MiB, WS_W2GU = 45 * MiB, WS_W2D = 56 * MiB;
constexpr size_t WS_XB = 64 * MiB, WS_U = 193 * MiB, WS_QB = 547 * MiB, WS_KB = 612 * MiB, WS_VB = 677 * MiB, WS_ZG = 742 * MiB, WS_XBC = 871 * MiB, WS_DTB = 1064 * MiB,
                 WS_MIX = 1069 * MiB, WS_QC = 1262 * MiB, WS_OC = 1391 * MiB, WS_MEMB = 1520 * MiB, WS_MKB = 1536 * MiB, WS_MVB = 1552 * MiB, WS_SLAB = 1568 * MiB, WS_END = 1584 * MiB;
constexpr int CW_BAR = 4096, CW_TICK = 16384, TICK_WORDS = 22 * 8 * 16;
constexpr int RING_OFF = 0, RING_BYTES = 131072, LDS_BYTES = 147456, LDSCTL_OFF = LDS_BYTES - 512, MISC_OFF = LDSCTL_OFF + 320;
constexpr int NWAVES = 8;
#ifndef MK_SPLIT
#define MK_SPLIT 0
#endif
constexpr int NPHASE = 13;

__device__ __forceinline__ float bf2f(unsigned b) { return __uint_as_float(b << 16); }
__device__ __forceinline__ unsigned f2bf(float f) { unsigned u = __float_as_uint(f); return (u + 0x7fffu + ((u >> 16) & 1u)) >> 16; }
__device__ __forceinline__ unsigned pk2(float lo, float hi) { return f2bf(lo) | (f2bf(hi) << 16); }
__device__ __forceinline__ float silu_f(float x) { return x * __builtin_amdgcn_rcpf(1.f + __expf(-x)); }
__device__ __forceinline__ float wave_sum(float v) {
#pragma unroll
    for (int o = 1; o < 64; o <<= 1) v += __shfl_xor(v, o);
    return v;
}
__device__ __forceinline__ float wave_max(float v) {
#pragma unroll
    for (int o = 1; o < 64; o <<= 1) v = fmaxf(v, __shfl_xor(v, o));
    return v;
}
__device__ __forceinline__ float rdlane(float v, int l) { return __int_as_float(__builtin_amdgcn_readlane(__float_as_int(v), l)); }
__device__ __forceinline__ void unpack8(const v4u w, float* f) {
    f[0] = __uint_as_float(w.x << 16); f[1] = __uint_as_float(w.x & 0xffff0000u); f[2] = __uint_as_float(w.y << 16); f[3] = __uint_as_float(w.y & 0xffff0000u);
    f[4] = __uint_as_float(w.z << 16); f[5] = __uint_as_float(w.z & 0xffff0000u); f[6] = __uint_as_float(w.w << 16); f[7] = __uint_as_float(w.w & 0xffff0000u);
}

namespace pg8 {
struct EpiGateUp {
    static constexpr bool PERM = true, AFTER_DRAIN = false; static constexpr int KSEG = 0; static constexpr bool PRE = true;
    bf16_t* U; const float* rq;
    __device__ __forceinline__ void preload(const Unit& u, int wr, int fr, float (&pre)[8]) const {
        const int row0 = u.pm * BM + wr * 64 + fr;
#pragma unroll
        for (int ai = 0; ai < 2; ++ai)
#pragma unroll
            for (int m = 0; m < 4; ++m) pre[ai * 4 + m] = rq[row0 + ai * HALF + m * 16];
    }
    __device__ __forceinline__ void operator()(const f32x4 (&acc)[2][2][4][2], const Unit& u, int wr, int wc, int fr, int fq, const float (&pre)[8]) const {
        const int row0 = u.pm * BM + wr * 64 + fr, col0 = u.pn * 128 + wc * 32 + 8 * fq;
#pragma unroll
        for (int ai = 0; ai < 2; ++ai)
#pragma unroll
            for (int m = 0; m < 4; ++m) {
                const int row = row0 + ai * HALF + m * 16; const float rs = rsqrtf(pre[ai * 4 + m] * (1.f / 1024.f) + 1e-6f);
                f32x2 o[4];
#pragma unroll
                for (int n = 0; n < 2; ++n)
#pragma unroll
                    for (int jp = 0; jp < 2; ++jp) { const f32x2 ga = {acc[ai][0][m][n][2 * jp], acc[ai][0][m][n][2 * jp + 1]}, ua = {acc[ai][1][m][n][2 * jp], acc[ai][1][m][n][2 * jp + 1]};
                        const f32x2 g = ga * rs, t = ga * (rs * -1.44269504f), uu = ua * rs;
                        f32x2 e; e.x = __builtin_amdgcn_exp2f(t.x); e.y = __builtin_amdgcn_exp2f(t.y);
                        const f32x2 d = e + 1.0f; f32x2 r; r.x = __builtin_amdgcn_rcpf(d.x); r.y = __builtin_amdgcn_rcpf(d.y);
                        o[2 * n + jp] = (g * r) * uu; }
                u32x4 w; w.x = cvt_pk_bf16(o[0].x, o[0].y); w.y = cvt_pk_bf16(o[1].x, o[1].y); w.z = cvt_pk_bf16(o[2].x, o[2].y); w.w = cvt_pk_bf16(o[3].x, o[3].y);
                *(u32x4*)(U + (size_t)row * 2816 + col0) = w; }
    }
};
struct EpiResid {
    static constexpr bool PERM = true, AFTER_DRAIN = false; static constexpr int KSEG = 0; static constexpr bool PRE = false;
    bf16_t* X; float alpha; float* rq; float* yp; float* ys;
    __device__ __forceinline__ void operator()(const f32x4 (&acc)[2][2][4][2], const Unit& u, int wr, int wc, int fr, int fq) const {
        const int row0 = u.pm * BM + wr * 64 + fr, col0 = u.pn * BM + wc * 32 + 8 * fq;
#pragma unroll
        for (int ai = 0; ai < 2; ++ai)
#pragma unroll
            for (int m = 0; m < 4; ++m) {
                const int row = row0 + ai * HALF + m * 16; float ss = 0.f;
#pragma unroll
                for (int bj = 0; bj < 2; ++bj) {
                    const int col = col0 + bj * HALF; bf16_t* xp = X + (size_t)row * 1024 + col;
                    const u32x4 ow = *(const u32x4*)xp; float v[8];
                    { f32x2 p0 = {__uint_as_float(ow.x << 16), __uint_as_float(ow.x & 0xffff0000u)}, p1 = {__uint_as_float(ow.y << 16), __uint_as_float(ow.y & 0xffff0000u)},
                            p2 = {__uint_as_float(ow.z << 16), __uint_as_float(ow.z & 0xffff0000u)}, p3 = {__uint_as_float(ow.w << 16), __uint_as_float(ow.w & 0xffff0000u)};
                      const f32x4 a0 = acc[ai][bj][m][0], a1 = acc[ai][bj][m][1];
                      p0 = p0 + (f32x2){a0[0], a0[1]} * alpha; p1 = p1 + (f32x2){a0[2], a0[3]} * alpha; p2 = p2 + (f32x2){a1[0], a1[1]} * alpha; p3 = p3 + (f32x2){a1[2], a1[3]} * alpha;
                      const f32x2 q = (p0 * p0 + p1 * p1) + (p2 * p2 + p3 * p3); ss += q.x + q.y;
                      v[0] = p0.x; v[1] = p0.y; v[2] = p1.x; v[3] = p1.y; v[4] = p2.x; v[5] = p2.y; v[6] = p3.x; v[7] = p3.y; }
                    if (yp) {
                        float* dst = row < 65536 ? yp + (size_t)row * 1024 + col : (row < 65664 ? ys + (size_t)(row - 65536) * 1024 + col : nullptr);
                        if (dst) { *(f32x4*)dst = (f32x4){v[0], v[1], v[2], v[3]}; *(f32x4*)(dst + 4) = (f32x4){v[4], v[5], v[6], v[7]}; }
                    } else {
                        u32x4 w; w.x = cvt_pk_bf16(v[0], v[1]); w.y = cvt_pk_bf16(v[2], v[3]); w.z = cvt_pk_bf16(v[4], v[5]); w.w = cvt_pk_bf16(v[6], v[7]);
                        *(u32x4*)xp = w; }
                }
                ss += __shfl_xor(ss, 16); ss += __shfl_xor(ss, 32);
                if (fq == 0) unsafeAtomicAdd(rq + row, ss);
            }
    }
};

struct EpiResidKS {
    static constexpr bool PERM = true, AFTER_DRAIN = false; static constexpr int KSEG = 8; static constexpr bool PRE = false;
    bf16_t* X; float* rq; const float* rs2;
    __device__ __forceinline__ void kseg(f32x4 (&acc)[2][2][4][2], const Unit& u, int t, int wr, int fr) const {
        const int row0 = u.pm * BM + wr * 64 + fr;
#pragma unroll
        for (int ai = 0; ai < 2; ++ai)
#pragma unroll
            for (int m = 0; m < 4; ++m) { const int row = row0 + ai * HALF + m * 16; const f32x2 sv = *(const f32x2*)(rs2 + 2 * row);
                const float f = (t == KSEG) ? __builtin_amdgcn_rcpf(sv.x) : sv.x * __builtin_amdgcn_rcpf(sv.y);
#pragma unroll
                for (int bj = 0; bj < 2; ++bj)
#pragma unroll
                    for (int n = 0; n < 2; ++n) acc[ai][bj][m][n] = acc[ai][bj][m][n] * f; }
    }
    __device__ __forceinline__ void operator()(const f32x4 (&acc)[2][2][4][2], const Unit& u, int wr, int wc, int fr, int fq) const {
        const int row0 = u.pm * BM + wr * 64 + fr, col0 = u.pn * BM + wc * 32 + 8 * fq;
#pragma unroll
        for (int ai = 0; ai < 2; ++ai)
#pragma unroll
            for (int m = 0; m < 4; ++m) {
                const int row = row0 + ai * HALF + m * 16; float ss = 0.f; const float alpha = rs2[2 * (size_t)row + 1];
#pragma unroll
                for (int bj = 0; bj < 2; ++bj) {
                    const int col = col0 + bj * HALF; bf16_t* xp = X + (size_t)row * 1024 + col;
                    const u32x4 ow = *(const u32x4*)xp; float v[8];
                    { f32x2 p0 = {__uint_as_float(ow.x << 16), __uint_as_float(ow.x & 0xffff0000u)}, p1 = {__uint_as_float(ow.y << 16), __uint_as_float(ow.y & 0xffff0000u)},
                            p2 = {__uint_as_float(ow.z << 16), __uint_as_float(ow.z & 0xffff0000u)}, p3 = {__uint_as_float(ow.w << 16), __uint_as_float(ow.w & 0xffff0000u)};
                      const f32x4 a0 = acc[ai][bj][m][0], a1 = acc[ai][bj][m][1];
                      p0 = p0 + (f32x2){a0[0], a0[1]} * alpha; p1 = p1 + (f32x2){a0[2], a0[3]} * alpha; p2 = p2 + (f32x2){a1[0], a1[1]} * alpha; p3 = p3 + (f32x2){a1[2], a1[3]} * alpha;
                      const f32x2 q = (p0 * p0 + p1 * p1) + (p2 * p2 + p3 * p3); ss += q.x + q.y;
                      v[0] = p0.x; v[1] = p0.y; v[2] = p1.x; v[3] = p1.y; v[4] = p2.x; v[5] = p2.y; v[6] = p3.x; v[7] = p3.y; }
                    u32x4 w; w.x = cvt_pk_bf16(v[0], v[1]); w.y = cvt_pk_bf16(v[2], v[3]); w.z = cvt_pk_bf16(v[4], v[5]); w.w = cvt_pk_bf16(v[6], v[7]);
                    *(u32x4*)xp = w;
                }
                ss += __shfl_xor(ss, 16); ss += __shfl_xor(ss, 32);
                if (fq == 0) unsafeAtomicAdd(rq + row, ss);
            }
    }
};
struct EpiScale {
    static constexpr bool PERM = true, AFTER_DRAIN = false; static constexpr int KSEG = 0; static constexpr bool PRE = false;
    bf16_t* O; int ldc; const float* rq; float scale;
    __device__ __forceinline__ void operator()(const f32x4 (&acc)[2][2][4][2], const Unit& u, int wr, int wc, int fr, int fq) const {
        const int row0 = u.pm * BM + wr * 64 + fr, col0 = u.pn * BM + wc * 32 + 8 * fq;
#pragma unroll
        for (int ai = 0; ai < 2; ++ai)
#pragma unroll
            for (int m = 0; m < 4; ++m) {
                const int row = row0 + ai * HALF + m * 16; const float rs = rsqrtf(rq[row] * (1.f / 1024.f) + 1e-6f) * scale;
#pragma unroll
                for (int bj = 0; bj < 2; ++bj) { const f32x4 v0 = acc[ai][bj][m][0] * rs, v1 = acc[ai][bj][m][1] * rs;
                    u32x4 w; w.x = cvt_pk_bf16(v0[0], v0[1]); w.y = cvt_pk_bf16(v0[2], v0[3]); w.z = cvt_pk_bf16(v1[0], v1[1]); w.w = cvt_pk_bf16(v1[2], v1[3]);
                    *(u32x4*)(O + (size_t)row * ldc + col0 + bj * HALF) = w; } }
    }
};
struct EpiMemKV {
    static constexpr bool PERM = true, AFTER_DRAIN = false; static constexpr int KSEG = 0; static constexpr bool PRE = false;
    const float* rmem; float* mkp; float* mvp; bf16_t* mkb; bf16_t* mvb;
    __device__ __forceinline__ void operator()(const f32x4 (&acc)[2][2][4][2], const Unit& u, int wr, int wc, int fr, int fq) const {
        const int row0 = u.pm * BM + wr * 64 + fr; const bool isv = u.pn >= 4; const int col0 = (u.pn & 3) * BM + wc * 32 + 8 * fq;
        float* of = isv ? mvp : mkp; bf16_t* ob = isv ? mvb : mkb;
#pragma unroll
        for (int ai = 0; ai < 2; ++ai)
#pragma unroll
            for (int m = 0; m < 4; ++m) {
                const int row = row0 + ai * HALF + m * 16; const float rs = rmem[row];
#pragma unroll
                for (int bj = 0; bj < 2; ++bj) { const f32x4 v0 = acc[ai][bj][m][0] * rs, v1 = acc[ai][bj][m][1] * rs; const size_t o = (size_t)row * 1024 + col0 + bj * HALF;
                    *(f32x4*)(of + o) = v0; *(f32x4*)(of + o + 4) = v1;
                    u32x4 w; w.x = cvt_pk_bf16(v0[0], v0[1]); w.y = cvt_pk_bf16(v0[2], v0[3]); w.z = cvt_pk_bf16(v1[0], v1[1]); w.w = cvt_pk_bf16(v1[2], v1[3]);
                    *(u32x4*)(ob + o) = w; } }
    }
};
struct EpiInProj {
    static constexpr bool PERM = true, AFTER_DRAIN = false; static constexpr int KSEG = 0; static constexpr bool PRE = false;
    const float* rq; bf16_t* qb; bf16_t* kb; bf16_t* vb; bf16_t* zg; bf16_t* xbc; float* dtb; const float* dt_bias;
    float* wkp; float* wvp; float* cvp; float* wks; float* wvs; float* cvs;
    __device__ __forceinline__ void operator()(const f32x4 (&acc)[2][2][4][2], const Unit& u, int wr, int wc, int fr, int fq) const {
        const int row0 = u.pm * BM + wr * 64 + fr, c0 = wc * 32 + 8 * fq, pn = u.pn;
#pragma unroll
        for (int ai = 0; ai < 2; ++ai)
#pragma unroll
            for (int m = 0; m < 4; ++m) {
                const int row = row0 + ai * HALF + m * 16; const float rs = rsqrtf(rq[row] * (1.f / 1024.f) + 1e-6f);
#pragma unroll
                for (int bj = 0; bj < 2; ++bj) {
                    const int c8 = c0 + bj * HALF; f32x4 v0 = acc[ai][bj][m][0] * rs, v1 = acc[ai][bj][m][1] * rs;
                    if (pn < 2) {
                        v0 = v0 * 0.180336880f; v1 = v1 * 0.180336880f;
                        u32x4 w; w.x = cvt_pk_bf16(v0[0], v0[1]); w.y = cvt_pk_bf16(v0[2], v0[3]); w.z = cvt_pk_bf16(v1[0], v1[1]); w.w = cvt_pk_bf16(v1[2], v1[3]);
                        *(u32x4*)(qb + (size_t)row * 512 + pn * 256 + c8) = w;
                    } else if (pn < 6) {
                        const bool isv = pn >= 4; const int col = (pn & 1) * 256 + c8;
                        u32x4 w; w.x = cvt_pk_bf16(v0[0], v0[1]); w.y = cvt_pk_bf16(v0[2], v0[3]); w.z = cvt_pk_bf16(v1[0], v1[1]); w.w = cvt_pk_bf16(v1[2], v1[3]);
                        *(u32x4*)((isv ? vb : kb) + (size_t)row * 512 + col) = w;
                        float* dst = row < 65536 ? (isv ? wvp : wkp) + (size_t)row * 512 + col : (row < 65664 ? (isv ? wvs : wks) + (size_t)(row - 65536) * 512 + col : nullptr);
                        if (dst) { *(f32x4*)dst = v0; *(f32x4*)(dst + 4) = v1; }
                    } else if (pn < 10) {
                        float o[8];
#pragma unroll
                        for (int j = 0; j < 4; ++j) { o[j] = v0[j] * __builtin_amdgcn_rcpf(1.f + __expf(-v0[j])); o[4 + j] = v1[j] * __builtin_amdgcn_rcpf(1.f + __expf(-v1[j])); }
                        u32x4 w; w.x = cvt_pk_bf16(o[0], o[1]); w.y = cvt_pk_bf16(o[2], o[3]); w.z = cvt_pk_bf16(o[4], o[5]); w.w = cvt_pk_bf16(o[6], o[7]);
                        *(u32x4*)(zg + (size_t)row * 1024 + (pn - 6) * 256 + c8) = w;
                    } else if (pn < 16) {
                        const int col = (pn - 10) * 256 + c8;
                        u32x4 w; w.x = cvt_pk_bf16(v0[0], v0[1]); w.y = cvt_pk_bf16(v0[2], v0[3]); w.z = cvt_pk_bf16(v1[0], v1[1]); w.w = cvt_pk_bf16(v1[2], v1[3]);
                        *(u32x4*)(xbc + (size_t)row * 1536 + col) = w;
                        float* dst = nullptr;
                        if (row < 65536) { const int t = row & 2047; if (t >= 2045) dst = cvp + ((size_t)(row >> 11) * 3 + (t - 2045)) * 1536 + col; }
                        else if (row < 65664) dst = cvs + ((size_t)(row - 65536) * 3 + 2) * 1536 + col;
                        if (dst) { *(f32x4*)dst = v0; *(f32x4*)(dst + 4) = v1; }
                    } else {
                        if (c8 < 16) {
                            float o[8];
#pragma unroll
                            for (int j = 0; j < 8; ++j) { const float x = (j < 4 ? v0[j & 3] : v1[j & 3]) + dt_bias[c8 + j]; o[j] = fmaxf(x, 0.f) + log1pf(__expf(-fabsf(x))); }
                            float* dst = dtb + (size_t)row * 16 + c8; *(f32x4*)dst = (f32x4){o[0], o[1], o[2], o[3]}; *(f32x4*)(dst + 4) = (f32x4){o[4], o[5], o[6], o[7]};
                        }
                    }
                }
            }
    }
};

struct SplitOrder {
    int nN, KS, G, c, kbytes;
    __host__ __device__ void init(int N, int KS_, int kper, int G_, int c_) { nN = N / BM; KS = KS_; G = G_; c = c_; kbytes = kper * 2; }
    __host__ __device__ bool next(int i, Unit& u) const { const int L = i * G + c; if (L >= nN * KS) return false; u.pm = 256; u.pn = L % nN; u.ks = L / nN; u.koff = u.ks * kbytes; return true; }
    __device__ __forceinline__ void a_ready(const Unit&) const {}
    __device__ __forceinline__ void done(const Unit&) const {}
};
template <class Inner> struct EpiSplit {
    static constexpr bool PERM = Inner::PERM, AFTER_DRAIN = false; static constexpr int KSEG = 0; static constexpr bool PRE = false;
    Inner in; float* slab; unsigned* tick; int KS;
    __device__ __forceinline__ void operator()(f32x4 (&acc)[2][2][4][2], const Unit& u, int wr, int wc, int fr, int fq) const {
        const int wave = wr * 4 + wc, lane = fr + 16 * fq;
        const __amdgpu_buffer_rsrc_t rs = __builtin_amdgcn_make_buffer_rsrc((void*)slab, 0, 0x7fffffff, 0x00020000);
        const int base = (((u.pn * KS + u.ks) * 8 + wave) * 16) * 1024 + lane * 16;
#pragma unroll
        for (int bj = 0; bj < 2; ++bj)
#pragma unroll
            for (int m = 0; m < 4; ++m)
#pragma unroll
                for (int n = 0; n < 2; ++n) __builtin_amdgcn_raw_buffer_store_b128(__builtin_bit_cast(u32x4, acc[0][bj][m][n]), rs, base + ((bj * 4 + m) * 2 + n) * 1024, 0, 16);
        asm volatile("s_waitcnt vmcnt(0)" ::: "memory");
        unsigned old = 0u;
        if (lane == 0) old = __hip_atomic_fetch_add(tick + (u.pn * 8 + wave) * 16, 1u, __ATOMIC_RELAXED, __HIP_MEMORY_SCOPE_AGENT);
        old = (unsigned)__builtin_amdgcn_readfirstlane((int)old);
        if (old == (unsigned)(KS - 1)) {
            __builtin_amdgcn_fence(__ATOMIC_ACQUIRE, "agent");
            asm volatile("s_waitcnt vmcnt(0)" ::: "memory");
#pragma unroll 1
            for (int s2 = 0; s2 < KS; ++s2) { if (s2 == u.ks) continue;
                const int ob = (((u.pn * KS + s2) * 8 + wave) * 16) * 1024 + lane * 16;
#pragma unroll
                for (int bj = 0; bj < 2; ++bj)
#pragma unroll
                    for (int m = 0; m < 4; ++m)
#pragma unroll
                        for (int n = 0; n < 2; ++n) acc[0][bj][m][n] += __builtin_bit_cast(f32x4, __builtin_amdgcn_raw_buffer_load_b128(rs, ob + ((bj * 4 + m) * 2 + n) * 1024, 0, 16)); }
#pragma unroll
            for (int bj = 0; bj < 2; ++bj)
#pragma unroll
                for (int m = 0; m < 4; ++m)
#pragma unroll
                    for (int n = 0; n < 2; ++n) acc[1][bj][m][n] = (f32x4){0.f, 0.f, 0.f, 0.f};
            int fr2 = fr, fq2 = fq; asm volatile("" : "+v"(fr2), "+v"(fq2));
            if constexpr (Inner::PRE) { float pre[8]; in.preload(u, wr, fr2, pre); in(acc, u, wr, wc, fr2, fq2, pre); } else in(acc, u, wr, wc, fr2, fq2);
        }
    }
};
}
#define PG8_SP2 true
#define PG8_ALIGN true

#define XB_TMO      128
#define XB_XCNT(j)  (256  + 64 * (j))
#define XB_XSUB(j)  (1280 + 64 * (j))
#define XB_XGEN(j)  (2304 + 64 * (j))
#define XB_TOP      3328
#define XB_TOPGEN   3392
#define XCD_BAR_WORDS 3456
#define XB_SPIN_CAP (1u << 18)

__device__ __forceinline__ unsigned xb_ld(unsigned* p)              { return __hip_atomic_load(p, __ATOMIC_RELAXED, __HIP_MEMORY_SCOPE_AGENT); }
__device__ __forceinline__ unsigned xb_add(unsigned* p, unsigned v) { return __hip_atomic_fetch_add(p, v, __ATOMIC_RELAXED, __HIP_MEMORY_SCOPE_AGENT); }
__device__ __forceinline__ unsigned xb_xcc_id() { return (unsigned)__builtin_amdgcn_s_getreg((3 << 11) | 20) & 0xFu; }
#define XB_SPIN(cond, bar) do { unsigned _sp = 0; while (cond) { __builtin_amdgcn_s_sleep(1); \
    if ((++_sp & 255u) == 0u) { if (xb_ld(&(bar)[XB_TMO])) break; if (_sp > XB_SPIN_CAP) { atomicAdd(&(bar)[XB_TMO], 1u); break; } } } } while (0)

struct XcdBarrier {
    unsigned* bar; unsigned x;
    volatile LAS unsigned* st;
};

__device__ __forceinline__ XcdBarrier xcd_barrier_post(unsigned* bar, volatile LAS unsigned* st, const bool leader) {
    XcdBarrier b; b.bar = bar; b.x = xb_xcc_id(); b.st = st;
    if (leader) (void)xb_add(&bar[XB_XCNT(b.x)], 1u);
    return b;
}
__device__ __forceinline__ void xcd_barrier_complete(unsigned* bar, unsigned x, unsigned& nloc, unsigned& nx) {
    const unsigned G = gridDim.x * gridDim.y * gridDim.z;
    unsigned sum, cnt, mine, sp = 0u;
    for (;;) {
        sum = 0u; cnt = 0u; mine = 0u;
#pragma unroll
        for (unsigned j = 0; j < 16; ++j) { const unsigned c = xb_ld(&bar[XB_XCNT(j)]); sum += c; cnt += (c > 0u) ? 1u : 0u; mine = (j == x) ? c : mine; }
        if (sum == G) break;
        __builtin_amdgcn_s_sleep(1);
        if ((++sp & 255u) == 0u) { if (xb_ld(&bar[XB_TMO])) break; if (sp > XB_SPIN_CAP) { atomicAdd(&bar[XB_TMO], 1u); break; } }
    }
    nloc = mine > 0u ? mine : 1u; nx = cnt > 0u ? cnt : 1u;
}

__device__ __forceinline__ void xcd_barrier(const XcdBarrier& b, const bool leader) {
    asm volatile("s_waitcnt vmcnt(0)" ::: "memory");
    __syncthreads();
    if (leader) {
        unsigned* bar = b.bar;
        __builtin_amdgcn_s_waitcnt(0);
        unsigned nloc = b.st[0], nx = b.st[1];
        if (nloc == 0u) { xcd_barrier_complete(bar, b.x, nloc, nx); b.st[0] = nloc; b.st[1] = nx; }
        const unsigned old = xb_add(&bar[XB_XSUB(b.x)], 1u);
        const unsigned gen = old / nloc;
        if (old + 1u == (gen + 1u) * nloc) {
            __builtin_amdgcn_fence(__ATOMIC_RELEASE, "agent");
            asm volatile("s_waitcnt vmcnt(0)" ::: "memory");
            const unsigned og = xb_add(&bar[XB_TOP], 1u);
            const unsigned tg = og / nx;
            if (og + 1u == (tg + 1u) * nx) xb_add(&bar[XB_TOPGEN], 1u);
            else XB_SPIN(xb_ld(&bar[XB_TOPGEN]) == tg, bar);
            __builtin_amdgcn_fence(__ATOMIC_ACQUIRE, "agent");
            xb_add(&bar[XB_XGEN(b.x)], 1u);
            asm volatile("s_waitcnt vmcnt(0)" ::: "memory");
        } else {
            XB_SPIN(xb_ld(&bar[XB_XGEN(b.x)]) == gen, bar);
            __builtin_amdgcn_fence(__ATOMIC_ACQUIRE, "agent");
            asm volatile("s_waitcnt vmcnt(0)" ::: "memory");
        }
    }
    __syncthreads();
}

struct Args { const float* in[34]; float* out; unsigned char* ws; int ph_lo, ph_hi, li, pad; };
struct Frame {
    LAS unsigned char* lds; volatile LAS unsigned* MISC; gu32* ctl;
    int tid, lane, wave, vcu, G;
    float* out; unsigned char* ws;
};
#define WSP(T, off) ((T*)(F.ws + (off)))
__device__ __forceinline__ void refresh(Frame& F) { int l; asm volatile("v_mbcnt_lo_u32_b32 %0, -1, 0\n\tv_mbcnt_hi_u32_b32 %0, -1, %0" : "=v"(l)); F.lane = l; F.tid = F.wave * 64 + l; }

__device__ __forceinline__ void tr_item(const float* W, int ldsrc, int ncols, int k0, int n0, bf16* WT, int K, int drow0, const float* gain, int gofs, LAS float* scr, int lane) {
    const int nn = n0 + (lane & 31); const bool okc = nn < ncols; const int nc = okc ? nn : ncols - 1;
    const float* gp = gain ? gain : W;
#pragma unroll
    for (int ib = 0; ib < 4; ++ib) { float v[8], gv[8];
#pragma unroll
        for (int j = 0; j < 8; ++j) { const int kk = 2 * (8 * ib + j) + (lane >> 5), k = k0 + kk; v[j] = W[(size_t)k * ldsrc + nc]; gv[j] = gp[max(k - gofs, 0)]; }
#pragma unroll
        for (int j = 0; j < 8; ++j) { const int kk = 2 * (8 * ib + j) + (lane >> 5), k = k0 + kk; float x = okc ? v[j] : 0.f; if (gain && k >= gofs) x *= gv[j]; scr[kk * 33 + (lane & 31)] = x; } }
    LDS_WAIT(); asm volatile("" ::: "memory");
    const int c = lane & 7;
#pragma unroll
    for (int j = 0; j < 4; ++j) { const int n = (lane >> 3) + 8 * j; const LAS float* s = scr + (8 * c) * 33 + n;
        v4u o; o.x = pk2(s[0 * 33], s[1 * 33]); o.y = pk2(s[2 * 33], s[3 * 33]); o.z = pk2(s[4 * 33], s[5 * 33]); o.w = pk2(s[6 * 33], s[7 * 33]);
        *(GAS v4u*)(WT + (size_t)(drow0 + n) * K + k0 + 8 * c) = o; }
    LDS_WAIT(); asm volatile("" ::: "memory");
}
__device__ __forceinline__ bool tr_job(int& r, const float* W, int K, int N, bf16* WT, int mode, int roff, const float* gain, int gofs, LAS float* scr, int lane) {
    const int nblk = (N + 31) / 32, items = (K / 64) * nblk;
    if (r >= items) { r -= items; return false; }
    const int kb = r / nblk, nb = r % nblk, n0 = nb * 32;
    const int drow0 = roff + (mode == 0 ? n0 : 256 * (n0 >> 7) + 128 * (mode - 1) + (n0 & 127));
    tr_item(W, N, N, kb * 64, n0, WT, K, drow0, gain, gofs, scr, lane);
    return true;
}
__device__ __forceinline__ void p0_prologue(Frame& F, const Args& A) {
    LAS float* scr = (LAS float*)(F.lds + RING_OFF + F.wave * 16384);
    const int gw = F.vcu * NWAVES + F.wave, NGW = F.G * NWAVES, lane = F.lane;
    constexpr int I_GU = 16 * 88, I_D = 44 * 32, I_IN = 16 * 129, I_OUT = 24 * 32, I_SQ = 16 * 32;
    constexpr int NITEMS = 4 * I_GU + 2 * I_D + I_IN + I_OUT + 4 * I_SQ;
    for (int it = gw; it < NITEMS; it += NGW) {
        int r = it;
        if (tr_job(r, A.in[11], 1024, 2816, WSP(bf16, WS_W1GU), 1, 0, A.in[10], 0, scr, lane)) continue;
        if (tr_job(r, A.in[12], 1024, 2816, WSP(bf16, WS_W1GU), 2, 0, A.in[10], 0, scr, lane)) continue;
        if (tr_job(r, A.in[13], 2816, 1024, WSP(bf16, WS_W1D), 0, 0, nullptr, 0, scr, lane)) continue;
        if (tr_job(r, A.in[15], 1024, 4112, WSP(bf16, WS_WIN), 0, 0, A.in[14], 0, scr, lane)) continue;
        if (tr_job(r, A.in[22], 1536, 1024, WSP(bf16, WS_WOUT), 0, 0, A.in[21], 512, scr, lane)) continue;
        if (tr_job(r, A.in[27], 1024, 1024, WSP(bf16, WS_WCQ), 0, 0, A.in[26], 0, scr, lane)) continue;
        if (tr_job(r, A.in[28], 1024, 1024, WSP(bf16, WS_WCO), 0, 0, nullptr, 0, scr, lane)) continue;
        if (tr_job(r, A.in[24], 1024, 1024, WSP(bf16, WS_WMEM), 0, 0, A.in[23], 0, scr, lane)) continue;
        if (tr_job(r, A.in[25], 1024, 1024, WSP(bf16, WS_WMEM), 0, 1024, A.in[23], 0, scr, lane)) continue;
        if (tr_job(r, A.in[30], 1024, 2816, WSP(bf16, WS_W2GU), 1, 0, A.in[29], 0, scr, lane)) continue;
        if (tr_job(r, A.in[31], 1024, 2816, WSP(bf16, WS_W2GU), 2, 0, A.in[29], 0, scr, lane)) continue;
        tr_job(r, A.in[32], 2816, 1024, WSP(bf16, WS_W2D), 0, 0, nullptr, 0, scr, lane);
    }
    { GAS v4u* z = (GAS v4u*)(WSP(bf16, WS_WIN) + (size_t)4128 * 1024); const int n16 = (4352 - 4128) * 1024 / 8;
      for (int i = gw * 64 + lane; i < n16; i += NGW * 64) z[i] = (v4u){0u, 0u, 0u, 0u}; }
    for (int m0 = gw; m0 < MT; m0 += 4 * NGW) {
        f32x4 v[4][4];
#pragma unroll
        for (int q = 0; q < 4; ++q) { const int m = m0 + q * NGW, mc = min(m, MROWS - 1);
            const float* src = mc < TP ? A.in[0] + (size_t)mc * 1024 : A.in[1] + (size_t)(mc - TP) * 1024; const GAS f32x4* xr = (const GAS f32x4*)src + lane;
#pragma unroll
            for (int j = 0; j < 4; ++j) v[q][j] = xr[64 * j]; }
#pragma unroll
        for (int q = 0; q < 4; ++q) { const int m = m0 + q * NGW; const float keep = m < MROWS ? 1.f : 0.f;
            if (m < MT) { float sq = 0.f;
#pragma unroll
            for (int j = 0; j < 4; ++j) { v[q][j] = v[q][j] * keep; sq += (v[q][j].x * v[q][j].x + v[q][j].y * v[q][j].y) + (v[q][j].z * v[q][j].z + v[q][j].w * v[q][j].w); }
            sq = wave_sum(sq);
            if (lane == 0) WSP(float, WS_RQ0)[m] = sq;
            GAS v2u* o8 = (GAS v2u*)(WSP(bf16, WS_XB) + (size_t)m * 1024) + lane;
#pragma unroll
            for (int j = 0; j < 4; ++j) o8[64 * j] = (v2u){pk2(v[q][j].x, v[q][j].y), pk2(v[q][j].z, v[q][j].w)}; } }
    }
    for (int m0 = gw; m0 < NB * NMEM; m0 += 4 * NGW) {
        f32x4 v[4][4];
#pragma unroll
        for (int q = 0; q < 4; ++q) { const int mc = min(m0 + q * NGW, NB * NMEM - 1); const GAS f32x4* xr = (const GAS f32x4*)(A.in[8] + (size_t)mc * 1024) + lane;
#pragma unroll
            for (int j = 0; j < 4; ++j) v[q][j] = xr[64 * j]; }
#pragma unroll
        for (int q = 0; q < 4; ++q) { const int m = m0 + q * NGW; if (m < NB * NMEM) { float sq = 0.f;
#pragma unroll
            for (int j = 0; j < 4; ++j) sq += (v[q][j].x * v[q][j].x + v[q][j].y * v[q][j].y) + (v[q][j].z * v[q][j].z + v[q][j].w * v[q][j].w);
            sq = wave_sum(sq);
            if (lane == 0) WSP(float, WS_RMEM)[m] = rsqrtf(sq * (1.f / 1024.f) + EPS);
            GAS v2u* o8 = (GAS v2u*)(WSP(bf16, WS_MEMB) + (size_t)m * 1024) + lane;
#pragma unroll
            for (int j = 0; j < 4; ++j) o8[64 * j] = (v2u){pk2(v[q][j].x, v[q][j].y), pk2(v[q][j].z, v[q][j].w)}; } }
    }
    for (int i = gw * 64 + lane; i < TS * 2 * DXBC; i += NGW * 64) { const int b = i / (2 * DXBC), r = i % (2 * DXBC); F.out[O_CVS + (size_t)b * 3 * DXBC + r] = A.in[4][(size_t)b * 3 * DXBC + DXBC + r]; }
}

__device__ __forceinline__ int t5_bucket(int d) {
    if (d < 16) return d;
    int b = 16;
    b += d >= 22; b += d >= 30; b += d >= 40; b += d >= 54; b += d >= 73; b += d >= 99; b += d >= 134; b += d >= 182; b += d >= 246; b += d >= 332; b += d >= 450; b += d >= 609; b += d >= 825; b += d >= 1117; b += d >= 1513;
    return b;
}

typedef float f32x16 __attribute__((ext_vector_type(16)));
typedef short s16x4 __attribute__((ext_vector_type(4)));
typedef short v4i16_t __attribute__((ext_vector_type(4)));
typedef float f32x2_t __attribute__((ext_vector_type(2)));
typedef __bf16 bf16x2_t __attribute__((ext_vector_type(2)));
using pg8::bf16x8; using pg8::f32x2;
#define MFMA32(a, b, c) __builtin_amdgcn_mfma_f32_32x32x16_bf16((a), (b), (c), 0, 0, 0)
__device__ __forceinline__ unsigned cvtpk(float lo, float hi) { f32x2_t v = {lo, hi}; bf16x2_t b = __builtin_convertvector(v, bf16x2_t); return __builtin_bit_cast(unsigned, b); }
__device__ __forceinline__ bf16x8 pack8(float a0, float a1, float a2, float a3, float a4, float a5, float a6, float a7) { v4u w; w.x = cvtpk(a0, a1); w.y = cvtpk(a2, a3); w.z = cvtpk(a4, a5); w.w = cvtpk(a6, a7); return __builtin_bit_cast(bf16x8, w); }
#define PACK_STEP(x, s) pack8((x)[8 * (s)], (x)[8 * (s) + 1], (x)[8 * (s) + 2], (x)[8 * (s) + 3], (x)[8 * (s) + 4], (x)[8 * (s) + 5], (x)[8 * (s) + 6], (x)[8 * (s) + 7])
__device__ __forceinline__ s16x4 tr_read(const LAS unsigned char* p) { return __builtin_bit_cast(s16x4, __builtin_amdgcn_ds_read_tr16_b64_v4i16((LAS v4i16_t*)p)); }
__device__ __forceinline__ f32x16 zero16() { f32x16 z;
#pragma unroll
    for (int i = 0; i < 16; ++i) z[i] = 0.f; return z; }

constexpr size_t WS_PX = WS_U + 16 * MiB;
__device__ __forceinline__ void cross_mfma_phase(Frame& F) {
    const bf16* qc = WSP(bf16, WS_QC); const bf16* mkb = WSP(bf16, WS_MKB); const bf16* mvb = WSP(bf16, WS_MVB); bf16* oc = WSP(bf16, WS_OC); v4u* px = WSP(v4u, WS_PX);
    LAS unsigned char* L = F.lds + RING_OFF;
    for (int su = F.vcu; su < NB * 4 * 2; su += F.G) {
        const int bh = su >> 1, b = bh >> 2, hx = bh & 3, half = su & 1;
        __syncthreads();
#pragma unroll 1
        for (int fb = 0; fb < 2; ++fb) { int ft = F.tid; asm volatile("" : "+v"(ft)); v4u fx[8];
#pragma unroll
          for (int i = 0; i < 8; ++i) { const int c = ft + 512 * (8 * fb + i), key = c >> 5, ch = c & 31; fx[i] = *(const GAS v4u*)(mkb + ((size_t)(b * 256 + key)) * 1024 + hx * 256 + ch * 8); }
#pragma unroll
          for (int i = 0; i < 8; ++i) { const int c = ft + 512 * (8 * fb + i), key = c >> 5, ch = c & 31; *(LAS v4u*)(L + key * 512 + ((ch ^ (key & 15)) << 4)) = fx[i]; } }
        __syncthreads();
        for (int qb = 0; qb < 4; ++qb) {
            int lane = F.lane; asm volatile("" : "+v"(lane));
            const int r = lane & 31, h = lane >> 5;
            const int m0 = b * SEQ + (half * 4 + qb) * 256 + F.wave * 32;
            bf16x8 qf[16];
            { const bf16* qrow = qc + (size_t)(m0 + r) * 1024 + hx * 256 + 8 * h;
#pragma unroll
              for (int ks = 0; ks < 16; ++ks) qf[ks] = *(const GAS bf16x8*)(qrow + 16 * ks); }
            asm volatile("" : "+v"(qf[0]), "+v"(qf[1]), "+v"(qf[2]), "+v"(qf[3]), "+v"(qf[4]), "+v"(qf[5]), "+v"(qf[6]), "+v"(qf[7]));
            asm volatile("" : "+v"(qf[8]), "+v"(qf[9]), "+v"(qf[10]), "+v"(qf[11]), "+v"(qf[12]), "+v"(qf[13]), "+v"(qf[14]), "+v"(qf[15]));
            f32x16 S[8];
#pragma unroll
            for (int kt = 0; kt < 8; ++kt) S[kt] = zero16();
            const LAS unsigned char* kb0 = L + r * 512;
            bf16x8 ka[4], kb_[4];
            { const int off = ((h ^ (r & 15)) << 4);
#pragma unroll
              for (int j = 0; j < 4; ++j) ka[j] = *(const LAS bf16x8*)(kb0 + j * 16384 + off); }
#pragma unroll
            for (int ks = 0; ks < 16; ++ks) { const int off = (((2 * ks + h) ^ (r & 15)) << 4), offn = (((2 * ks + 2 + h) ^ (r & 15)) << 4);
#pragma unroll
                for (int j = 0; j < 4; ++j) kb_[j] = *(const LAS bf16x8*)(kb0 + (4 + j) * 16384 + off);
                asm volatile("" : "+v"(ka[0]), "+v"(ka[1]), "+v"(ka[2]), "+v"(ka[3]));
#pragma unroll
                for (int j = 0; j < 4; ++j) S[j] = MFMA32(ka[j], qf[ks], S[j]);
                if (ks < 15) {
#pragma unroll
                    for (int j = 0; j < 4; ++j) ka[j] = *(const LAS bf16x8*)(kb0 + j * 16384 + offn); }
                asm volatile("" : "+v"(kb_[0]), "+v"(kb_[1]), "+v"(kb_[2]), "+v"(kb_[3]));
#pragma unroll
                for (int j = 0; j < 4; ++j) S[4 + j] = MFMA32(kb_[j], qf[ks], S[4 + j]);
            }
            float mx = -1e30f;
#pragma unroll
            for (int kt = 0; kt < 8; ++kt)
#pragma unroll
                for (int i = 0; i < 16; ++i) mx = fmaxf(mx, S[kt][i]);
            mx = fmaxf(mx, __shfl_xor(mx, 32));
            float sum = 0.f;
            { f32x2 s2v = {0.f, 0.f}; const float mxl = mx * 1.44269504f;
#pragma unroll
              for (int kt = 0; kt < 8; ++kt)
#pragma unroll
                for (int i2 = 0; i2 < 8; ++i2) { const f32x2 x = (f32x2){S[kt][2 * i2], S[kt][2 * i2 + 1]} * 1.44269504f - mxl; f32x2 e; e.x = __builtin_amdgcn_exp2f(x.x); e.y = __builtin_amdgcn_exp2f(x.y);
                    S[kt][2 * i2] = e.x; S[kt][2 * i2 + 1] = e.y; s2v = s2v + e; }
              sum = s2v.x + s2v.y; }
            sum += __shfl_xor(sum, 32);
            const float inv = 1.f / sum;
            v4u* pw = px + ((size_t)(m0 >> 5) * 4 + hx) * 1024 + lane;
#pragma unroll
            for (int kt = 0; kt < 8; ++kt)
#pragma unroll
                for (int s2 = 0; s2 < 2; ++s2) { v4u w; w.x = cvtpk(S[kt][8 * s2] * inv, S[kt][8 * s2 + 1] * inv); w.y = cvtpk(S[kt][8 * s2 + 2] * inv, S[kt][8 * s2 + 3] * inv);
                    w.z = cvtpk(S[kt][8 * s2 + 4] * inv, S[kt][8 * s2 + 5] * inv); w.w = cvtpk(S[kt][8 * s2 + 6] * inv, S[kt][8 * s2 + 7] * inv);
                    *(GAS v4u*)(pw + (kt * 2 + s2) * 64) = w; }
        }
        asm volatile("s_waitcnt vmcnt(0)" ::: "memory");
        __syncthreads();
#pragma unroll 1
        for (int fb = 0; fb < 2; ++fb) { int ft = F.tid; asm volatile("" : "+v"(ft)); v4u fx[8];
#pragma unroll
          for (int i = 0; i < 8; ++i) { const int c = ft + 512 * (8 * fb + i), key = c >> 5, c16 = c & 31; fx[i] = *(const GAS v4u*)(mvb + ((size_t)(b * 256 + key)) * 1024 + hx * 256 + c16 * 8); }
#pragma unroll
          for (int i = 0; i < 8; ++i) { const int c = ft + 512 * (8 * fb + i), key = c >> 5, c16 = c & 31; *(LAS v4u*)(L + key * 512 + ((c16 * 16) ^ ((key & 3) << 6))) = fx[i]; } }
        __syncthreads();
        for (int qb = 0; qb < 4; ++qb) {
            int lane = F.lane; asm volatile("" : "+v"(lane));
            const int r = lane & 31, h = lane >> 5, q4 = (lane & 15) >> 2, p4 = lane & 3, blk = (lane >> 4) & 1;
            const int m0 = b * SEQ + (half * 4 + qb) * 256 + F.wave * 32;
            const v4u* pw = px + ((size_t)(m0 >> 5) * 4 + hx) * 1024 + lane;
            bf16x8 P[8][2];
#pragma unroll
            for (int kt = 0; kt < 8; ++kt)
#pragma unroll
                for (int s2 = 0; s2 < 2; ++s2) P[kt][s2] = __builtin_bit_cast(bf16x8, *(const GAS v4u*)(pw + (kt * 2 + s2) * 64));
            asm volatile("" : "+v"(P[0][0]), "+v"(P[0][1]), "+v"(P[1][0]), "+v"(P[1][1]), "+v"(P[2][0]), "+v"(P[2][1]), "+v"(P[3][0]), "+v"(P[3][1]));
            asm volatile("" : "+v"(P[4][0]), "+v"(P[4][1]), "+v"(P[5][0]), "+v"(P[5][1]), "+v"(P[6][0]), "+v"(P[6][1]), "+v"(P[7][0]), "+v"(P[7][1]));
            f32x16 O[8];
#pragma unroll
            for (int dt = 0; dt < 8; ++dt) O[dt] = zero16();
            const LAS unsigned char* vb0 = L + (4 * h + q4) * 512 + 32 * blk + 8 * p4;
            bf16x8 va[4], vb_[4];
#define CX_VREAD(dst, step, d0) do { _Pragma("unroll") for (int j = 0; j < 4; ++j) { const LAS unsigned char* a0 = vb0 + (step) * 8192 + 64 * (((d0) + j) ^ q4); \
                const s16x4 lo = tr_read(a0), hi = tr_read(a0 + 8 * 512); dst[j] = __builtin_shufflevector(lo, hi, 0, 1, 2, 3, 4, 5, 6, 7); } } while (0)
            CX_VREAD(va, 0, 0);
#pragma unroll
            for (int st = 0; st < 16; ++st) {
                CX_VREAD(vb_, st, 4);
                asm volatile("" : "+v"(va[0]), "+v"(va[1]), "+v"(va[2]), "+v"(va[3]));
#pragma unroll
                for (int j = 0; j < 4; ++j) O[j] = MFMA32(P[st >> 1][st & 1], va[j], O[j]);
                if (st < 15) CX_VREAD(va, st + 1, 0);
                asm volatile("" : "+v"(vb_[0]), "+v"(vb_[1]), "+v"(vb_[2]), "+v"(vb_[3]));
#pragma unroll
                for (int j = 0; j < 4; ++j) O[4 + j] = MFMA32(P[st >> 1][st & 1], vb_[j], O[4 + j]);
            }
#undef CX_VREAD
            bf16* ocol = oc + (size_t)(m0 + 4 * h) * 1024 + hx * 256 + r;
#pragma unroll
            for (int dt = 0; dt < 8; ++dt)
#pragma unroll
                for (int i = 0; i < 16; ++i) ocol[(size_t)((i & 3) + 8 * (i >> 2)) * 1024 + 32 * dt] = (bf16)f2bf(O[dt][i]);
        }
    }
    __syncthreads();
}

constexpr size_t WS_PART = WS_QC, WS_LSE = WS_U, WS_SSQP = WS_U + 8 * MiB;
template <int MODE> __device__ __forceinline__ void attn_step(const bf16x8 (&kf)[4], const bf16x8 (&vf)[2][2], const bf16x8 (&qf)[4], const LAS float* tbk, int dl, float& m, float& l, f32x16 (&O)[2]) {
    f32x16 acc = zero16();
#pragma unroll
    for (int ks = 0; ks < 4; ++ks) acc = MFMA32(kf[ks], qf[ks], acc);
    float tmax = -1e30f;
#pragma unroll
    for (int hb = 0; hb < 4; ++hb) {
        const f32x2 b01 = {tbk[-(8 * hb)], tbk[-(8 * hb + 1)]}, b23 = {tbk[-(8 * hb + 2)], tbk[-(8 * hb + 3)]};
        const f32x2 a01 = (f32x2){acc[4 * hb], acc[4 * hb + 1]} + b01, a23 = (f32x2){acc[4 * hb + 2], acc[4 * hb + 3]} + b23;
        float v[4] = {a01.x, a01.y, a23.x, a23.y};
#pragma unroll
        for (int j = 0; j < 4; ++j) { const int ci = j + 8 * hb;
            if (MODE == 1) v[j] = (dl - ci <= 128) ? v[j] : -1e30f;
            else if (MODE == 2) v[j] = (dl - ci >= 0) ? v[j] : -1e30f;
            acc[4 * hb + j] = v[j]; tmax = fmaxf(tmax, v[j]); } }
    tmax = fmaxf(tmax, __shfl_xor(tmax, 32));
    const bool grow = tmax > m + 8.f;
    if (__builtin_amdgcn_ballot_w64(grow) != 0ull) {
        const float mn = grow ? tmax : m, scl = __builtin_amdgcn_exp2f(m - mn); m = mn; l *= scl;
#pragma unroll
        for (int i = 0; i < 16; ++i) { O[0][i] *= scl; O[1][i] *= scl; }
    }
    f32x2 ps = {0.f, 0.f}; const float mv = m;
#pragma unroll
    for (int i2 = 0; i2 < 8; ++i2) { const f32x2 x = (f32x2){acc[2 * i2], acc[2 * i2 + 1]} - mv; f32x2 e; e.x = __builtin_amdgcn_exp2f(x.x); e.y = __builtin_amdgcn_exp2f(x.y); acc[2 * i2] = e.x; acc[2 * i2 + 1] = e.y; ps = ps + e; }
    l += ps.x + ps.y;
#pragma unroll
    for (int s2 = 0; s2 < 2; ++s2) { const bf16x8 pf = PACK_STEP(acc, s2);
        O[0] = MFMA32(vf[s2][0], pf, O[0]); O[1] = MFMA32(vf[s2][1], pf, O[1]); }
}
__device__ __forceinline__ void attn_step_kt(const bf16x8 (&kf)[4], const bf16x8 (&vf)[2][2], const bf16x8 (&qf)[4], const LAS float* tb0, int d0, int kt, float& m, float& l, f32x16 (&O)[2]) {
    const LAS float* tbk = tb0 - 32 * kt; const int dl = d0 - 32 * kt;
    if (kt == 0) attn_step<1>(kf, vf, qf, tbk, dl, m, l, O); else if (kt == 4) attn_step<2>(kf, vf, qf, tbk, dl, m, l, O); else attn_step<0>(kf, vf, qf, tbk, dl, m, l, O);
}
__device__ __forceinline__ void attn_mfma_phase(Frame& F, const Args& A) {
    const int w = F.wave;
    LAS float* tab = (LAS float*)(F.lds + RING_OFF);
    LAS unsigned char* kl = F.lds + RING_OFF + 20480 + w * 8704;
    LAS unsigned char* vl = kl + 4608;
    const bf16* qb = WSP(bf16, WS_QB); const bf16* kb = WSP(bf16, WS_KB); const bf16* vb = WSP(bf16, WS_VB);
    bf16* part = WSP(bf16, WS_PART); float* lsep = WSP(float, WS_LSE); const float* relb = A.in[9];
    __syncthreads();
    { float tv[9];
#pragma unroll
      for (int i = 0; i < 9; ++i) { const int idx = F.tid + 512 * i, p = idx / (8 * 192), rem = idx % (8 * 192), hh = rem / 192, d = min(max(rem % 192 - 32, 0), 128); tv[i] = relb[t5_bucket(d << (2 * p)) * 8 + hh]; }
#pragma unroll
      for (int i = 0; i < 9; ++i) tab[F.tid + 512 * i] = tv[i] * 1.44269504f; }
    __syncthreads();
    for (int u = F.vcu; u < 1536; u += F.G) {
        const int p = u >> 9, v = u & 511, lg = 2 * p, b = v >> 4, w2 = v & 15, nbk = w2 >> lg, rcls = w2 & ((1 << lg) - 1);
        const size_t tokbase = (size_t)b * SEQ + rcls;
        const LAS float* tb = tab + (p * 8 + w) * 192 + 32;
        for (int pr = 0; pr < 2; ++pr) {
            int lane = F.lane; asm volatile("" : "+v"(lane));
            const int r = lane & 31, h = lane >> 5, q4 = (lane & 15) >> 2, p4 = lane & 3, blk = (lane >> 4) & 1, vxor = ((q4 >> 1) & 1) << 6;
            const int i0 = 128 * nbk + 64 * pr, jbase = i0 - 128, amin = jbase >= 0 ? 0 : ((-jbase) >> 5);
            const int d0 = 128 + r - 4 * h; const LAS float* tb0 = tb + d0;
            const int skey = lane >> 3, sc16 = lane & 7; const size_t hoff = (size_t)w * 64 + sc16 * 8;
            v4u ka[4], va[4];
            { const int j0 = jbase + 32 * amin;
#pragma unroll
              for (int i = 0; i < 4; ++i) { const size_t g = (tokbase + ((size_t)(j0 + skey + 8 * i) << lg)) * 512 + hoff; ka[i] = *(const GAS v4u*)(kb + g); va[i] = *(const GAS v4u*)(vb + g); } }
            bf16x8 qfa[4], qfb[4];
            { const bf16* qrow = qb + (tokbase + ((size_t)(i0 + r) << lg)) * 512 + w * 64 + 8 * h; const size_t qstep = ((size_t)32 << lg) * 512;
#pragma unroll
              for (int ks = 0; ks < 4; ++ks) { qfa[ks] = *(const GAS bf16x8*)(qrow + 16 * ks); qfb[ks] = *(const GAS bf16x8*)(qrow + qstep + 16 * ks); } }
            float ma = -1e30f, la = 0.f, mb = -1e30f, lb = 0.f; f32x16 Oa[2], Ob[2]; Oa[0] = zero16(); Oa[1] = zero16(); Ob[0] = zero16(); Ob[1] = zero16();
#pragma unroll 1
            for (int a = amin; a < 6; ++a) {
                {
                    asm volatile("" ::: "memory");
#pragma unroll
                    for (int i = 0; i < 4; ++i) { const int key = skey + 8 * i;
                        *(LAS v4u*)(kl + key * 144 + sc16 * 16) = ka[i];
                        *(LAS v4u*)(vl + key * 128 + ((sc16 * 16) ^ (((key >> 1) & 1) << 6))) = va[i]; }
                    if (a < 5) { const int j1 = jbase + 32 * (a + 1);
#pragma unroll
                        for (int i = 0; i < 4; ++i) { const size_t g = (tokbase + ((size_t)(j1 + skey + 8 * i) << lg)) * 512 + hoff; ka[i] = *(const GAS v4u*)(kb + g); va[i] = *(const GAS v4u*)(vb + g); } }
                    asm volatile("s_waitcnt lgkmcnt(0)" ::: "memory");
                    bf16x8 kf[4], vf[2][2];
#pragma unroll
                    for (int ks = 0; ks < 4; ++ks) kf[ks] = *(const LAS bf16x8*)(kl + r * 144 + (2 * ks + h) * 16);
#pragma unroll
                    for (int s2 = 0; s2 < 2; ++s2)
#pragma unroll
                        for (int dt = 0; dt < 2; ++dt) { const LAS unsigned char* a0 = vl + (16 * s2 + 4 * h + q4) * 128 + ((64 * dt + 32 * blk + 8 * p4) ^ vxor);
                            const s16x4 lo = tr_read(a0), hi = tr_read(a0 + 8 * 128); vf[s2][dt] = __builtin_shufflevector(lo, hi, 0, 1, 2, 3, 4, 5, 6, 7); }
                    if (a < 5) attn_step_kt(kf, vf, qfa, tb0, d0, a, ma, la, Oa);
                    if (a > 0) attn_step_kt(kf, vf, qfb, tb0, d0, a - 1, mb, lb, Ob);
                    asm volatile("s_waitcnt lgkmcnt(0)" ::: "memory");
                }
            }
#pragma unroll
            for (int sb = 0; sb < 2; ++sb) {
                float lsum = sb ? lb : la; const float mm = sb ? mb : ma; lsum += __shfl_xor(lsum, 32);
                const float inv = 1.f / lsum;
                const size_t tok = tokbase + ((size_t)(i0 + 32 * sb + r) << lg);
                bf16* orow = part + ((size_t)p * TP + tok) * 512 + w * 64 + 4 * h;
#pragma unroll
                for (int dt = 0; dt < 2; ++dt)
#pragma unroll
                    for (int g = 0; g < 4; ++g) { const f32x16& O = sb ? Ob[dt] : Oa[dt]; v2u x; x.x = cvtpk(O[4 * g] * inv, O[4 * g + 1] * inv); x.y = cvtpk(O[4 * g + 2] * inv, O[4 * g + 3] * inv);
                        *(GAS v2u*)(orow + 32 * dt + 8 * g) = x; }
                if (h == 0) lsep[((size_t)p * TP + tok) * 8 + w] = (mm + __builtin_amdgcn_logf(lsum)) * 0.69314718f;
            }
        }
    }
    __syncthreads();
}

constexpr int SSP = 272;
constexpr int SS_CN = 0, SS_BN = 34816, SS_BTD = 69632, SS_XT = 104448, SS_HB = 121856, SS_ACS = 139264;
static_assert(SS_ACS + 2 * 1536 <= LDSCTL_OFF, "SSD LDS map");

__device__ __forceinline__ void unpack8x2(const v4u w, f32x2 (&f)[4]) {
    f[0] = (f32x2){__uint_as_float(w.x << 16), __uint_as_float(w.x & 0xffff0000u)}; f[1] = (f32x2){__uint_as_float(w.y << 16), __uint_as_float(w.y & 0xffff0000u)};
    f[2] = (f32x2){__uint_as_float(w.z << 16), __uint_as_float(w.z & 0xffff0000u)}; f[3] = (f32x2){__uint_as_float(w.w << 16), __uint_as_float(w.w & 0xffff0000u)};
}
__device__ __forceinline__ f32x2 silu2(f32x2 v) { const f32x2 t = v * -1.44269504f; f32x2 e; e.x = __builtin_amdgcn_exp2f(t.x); e.y = __builtin_amdgcn_exp2f(t.y); const f32x2 d = e + 1.0f; f32x2 r; r.x = __builtin_amdgcn_rcpf(d.x); r.y = __builtin_amdgcn_rcpf(d.y); return v * r; }
constexpr size_t WS_BCC = 1455 * MiB;
__device__ __forceinline__ void bc_conv_prepass(Frame& F, const Args& A) {
    const bf16* xbc = WSP(bf16, WS_XBC); bf16* bcc = WSP(bf16, WS_BCC); const float* conv_w = A.in[16]; const float* conv_b = A.in[17];
    const int nthr = F.G * 512;
    for (int sidx = F.vcu * 512 + F.tid; sidx < (TP / 8) * 64; sidx += nthr) {
        const int cg = sidx & 63, rb = sidx >> 6, colg = 1024 + 8 * cg, row = rb * 8, t0 = row & 2047;
        v4u raw[11];
#pragma unroll
        for (int q = 0; q < 11; ++q) { const bool ok = t0 - 3 + q >= 0; const v4u x = *(const GAS v4u*)(xbc + (size_t)(ok ? row - 3 + q : row) * 1536 + colg);
            raw[q].x = ok ? x.x : 0u; raw[q].y = ok ? x.y : 0u; raw[q].z = ok ? x.z : 0u; raw[q].w = ok ? x.w : 0u; }
        f32x2 cw[4][4], cb[4];
#pragma unroll
        for (int w = 0; w < 4; ++w) { const f32x4 a = *(const GAS f32x4*)(conv_w + w * 1536 + colg), c = *(const GAS f32x4*)(conv_w + w * 1536 + colg + 4);
            cw[w][0] = (f32x2){a.x, a.y}; cw[w][1] = (f32x2){a.z, a.w}; cw[w][2] = (f32x2){c.x, c.y}; cw[w][3] = (f32x2){c.z, c.w}; }
        { const f32x4 a = *(const GAS f32x4*)(conv_b + colg), c = *(const GAS f32x4*)(conv_b + colg + 4); cb[0] = (f32x2){a.x, a.y}; cb[1] = (f32x2){a.z, a.w}; cb[2] = (f32x2){c.x, c.y}; cb[3] = (f32x2){c.z, c.w}; }
#pragma unroll
        for (int i = 0; i < 8; ++i) { f32x2 f0[4], f1[4], f2[4], f3[4], o[4]; unpack8x2(raw[i], f0); unpack8x2(raw[i + 1], f1); unpack8x2(raw[i + 2], f2); unpack8x2(raw[i + 3], f3);
#pragma unroll
            for (int e = 0; e < 4; ++e) o[e] = silu2(cb[e] + cw[0][e] * f0[e] + cw[1][e] * f1[e] + cw[2][e] * f2[e] + cw[3][e] * f3[e]);
            *(GAS v4u*)(bcc + (size_t)(row + i) * 512 + 8 * cg) = (v4u){cvtpk(o[0].x, o[0].y), cvtpk(o[1].x, o[1].y), cvtpk(o[2].x, o[2].y), cvtpk(o[3].x, o[3].y)}; }
    }
}
__device__ __forceinline__ void xstrip_load(v4u (&raw)[5], const bf16* xbc, size_t row0, int c, int k, int head) {
    const int cg = k & 7, rb = k >> 3, t0 = c * 128 + 2 * rb;
#pragma unroll
    for (int q = 0; q < 5; ++q) { const bool ok = t0 - 3 + q >= 0; const v4u x = *(const GAS v4u*)(xbc + (row0 + (ok ? t0 - 3 + q : 0)) * 1536 + head * 64 + 8 * cg);
        raw[q].x = ok ? x.x : 0u; raw[q].y = ok ? x.y : 0u; raw[q].z = ok ? x.z : 0u; raw[q].w = ok ? x.w : 0u; }
}
__device__ __forceinline__ void xstrip_compute(const v4u (&raw)[5], LAS unsigned char* L, const float* conv_w, const float* conv_b, int k, int head) {
    const int cg = k & 7, rb = k >> 3, colg = head * 64 + 8 * cg, s0 = 2 * rb;
    f32x2 cw[4][4], cb[4];
#pragma unroll
    for (int w = 0; w < 4; ++w) { const f32x4 a = *(const GAS f32x4*)(conv_w + w * 1536 + colg), c = *(const GAS f32x4*)(conv_w + w * 1536 + colg + 4);
        cw[w][0] = (f32x2){a.x, a.y}; cw[w][1] = (f32x2){a.z, a.w}; cw[w][2] = (f32x2){c.x, c.y}; cw[w][3] = (f32x2){c.z, c.w}; }
    { const f32x4 a = *(const GAS f32x4*)(conv_b + colg), c = *(const GAS f32x4*)(conv_b + colg + 4); cb[0] = (f32x2){a.x, a.y}; cb[1] = (f32x2){a.z, a.w}; cb[2] = (f32x2){c.x, c.y}; cb[3] = (f32x2){c.z, c.w}; }
    f32x2 o[2][4];
#pragma unroll
    for (int i = 0; i < 2; ++i) { f32x2 f0[4], f1[4], f2[4], f3[4]; unpack8x2(raw[i], f0); unpack8x2(raw[i + 1], f1); unpack8x2(raw[i + 2], f2); unpack8x2(raw[i + 3], f3);
#pragma unroll
        for (int e = 0; e < 4; ++e) o[i][e] = silu2(cb[e] + cw[0][e] * f0[e] + cw[1][e] * f1[e] + cw[2][e] * f2[e] + cw[3][e] * f3[e]); }
#pragma unroll
    for (int e = 0; e < 4; ++e) { *(LAS unsigned*)(L + SS_XT + (8 * cg + 2 * e) * SSP + s0 * 2) = cvtpk(o[0][e].x, o[1][e].x); *(LAS unsigned*)(L + SS_XT + (8 * cg + 2 * e + 1) * SSP + s0 * 2) = cvtpk(o[0][e].y, o[1][e].y); }
}
__device__ __forceinline__ void bcstrip_load(v4u (&raw)[8], const bf16* bcc, size_t row0, int c, int k, int g, int reg) {
    const int cg = k & 15, rb = k >> 4;
#pragma unroll
    for (int q = 0; q < 8; ++q) raw[q] = *(const GAS v4u*)(bcc + (row0 + c * 128 + 8 * rb + q) * 512 + (reg == 1 ? 0 : 256) + g * 128 + 8 * cg);
}
template <int REG> __device__ __forceinline__ void bcstrip_compute(const v4u (&raw)[8], LAS unsigned char* L, int k, const LAS float* acs, const LAS float* dtv) {
    const int cg = k & 15, rb = k >> 4, s0 = 8 * rb;
#pragma unroll
    for (int i = 0; i < 8; ++i) *(LAS v4u*)(L + (REG == 1 ? SS_BN : SS_CN) + (s0 + i) * SSP + cg * 16) = raw[i];
    if (REG == 1) { const float atot = acs[127]; float fd[8], f[8][8];
#pragma unroll
        for (int i = 0; i < 8; ++i) { fd[i] = dtv[s0 + i] * __expf(atot - acs[s0 + i]); unpack8(raw[i], f[i]); }
#pragma unroll
        for (int e = 0; e < 8; ++e) *(LAS v4u*)(L + SS_BTD + (8 * cg + e) * SSP + s0 * 2) =
            (v4u){cvtpk(f[0][e] * fd[0], f[1][e] * fd[1]), cvtpk(f[2][e] * fd[2], f[3][e] * fd[3]), cvtpk(f[4][e] * fd[4], f[5][e] * fd[5]), cvtpk(f[6][e] * fd[6], f[7][e] * fd[7])}; }
}
__device__ __forceinline__ void ssd_scan(LAS float* buf, float d0, float d1, float a, int lane) {
    float s0 = d0 * a, s1 = d1 * a;
#pragma unroll
    for (int o = 1; o < 64; o <<= 1) { const float t0 = __shfl_up(s0, o), t1 = __shfl_up(s1, o); if (lane >= o) { s0 += t0; s1 += t1; } }
    const float tot0 = __shfl(s0, 63); s1 += tot0;
    const float r0 = __shfl(s0, (lane & 32) + 31), r1 = __shfl(s1, (lane & 32) + 31);
    buf[lane] = s0; buf[64 + lane] = s1; buf[128 + lane] = d0; buf[192 + lane] = d1; buf[256 + lane] = d0 * __expf(r0 - s0); buf[320 + lane] = d1 * __expf(r1 - s1);
}
__device__ __forceinline__ void ssd_mfma_unit(Frame& F, const Args& A, int b, int head, float* hout) {
    const int w = F.wave, g = head >> 3;
    LAS unsigned char* L = F.lds + RING_OFF;
    const bf16* xbc = WSP(bf16, WS_XBC); const bf16* bcc = WSP(bf16, WS_BCC); const float* dtb = WSP(float, WS_DTB); const bf16* zg = WSP(bf16, WS_ZG); bf16* mix = WSP(bf16, WS_MIX); float* ssqp = WSP(float, WS_SSQP);
    const float* conv_w = A.in[16]; const float* conv_b = A.in[17];
    const float a = -__expf(A.in[19][head]), dsk = A.in[20][head];
    const size_t row0 = (size_t)b * SEQ;
    const int pt = w & 1, lt = (0x11002233 >> (4 * w)) & 3, pt2 = w >> 2, nt = w & 3, breg = w < 4 ? 1 : 2;
    f32x16 hacc = zero16();
    v4u rawx[5], rawb[8];
    float dn0 = 0.f, dn1 = 0.f;
    __syncthreads();
    { int lane0 = F.lane; asm volatile("" : "+v"(lane0)); const int tid0 = w * 64 + lane0;
      for (int i = tid0; i < 17408 / 16; i += 512) *(LAS v4u*)(L + SS_HB + i * 16) = (v4u){0u, 0u, 0u, 0u};
      xstrip_load(rawx, xbc, row0, 0, tid0, head); bcstrip_load(rawb, bcc, row0, 0, tid0 & 255, g, breg);
      if (w == 4) ssd_scan((LAS float*)(L + SS_ACS), dtb[(row0 + lane0) * 16 + head], dtb[(row0 + 64 + lane0) * 16 + head], a, lane0); }
    __syncthreads();
    for (int c = 0; c < 16; ++c) {
        int lane = F.lane; asm volatile("" : "+v"(lane));
        const int tid = w * 64 + lane, r = lane & 31, h = lane >> 5;
        const LAS float* acs = (const LAS float*)(L + SS_ACS + (c & 1) * 1536); const LAS float* dtv = acs + 128; const LAS float* vfac = acs + 256;
        if (w == 4 && c < 15) { dn0 = dtb[(row0 + (c + 1) * 128 + lane) * 16 + head]; dn1 = dtb[(row0 + (c + 1) * 128 + 64 + lane) * 16 + head]; }
        xstrip_compute(rawx, L, conv_w, conv_b, tid, head);
        if (w < 4) bcstrip_compute<1>(rawb, L, tid & 255, acs, dtv); else bcstrip_compute<2>(rawb, L, tid & 255, acs, dtv);
        LBAR();
        {
            if (c < 15) {
                int tc = tid; asm volatile("" : "+v"(tc));
                xstrip_load(rawx, xbc, row0, c + 1, tc, head); bcstrip_load(rawb, bcc, row0, c + 1, tc & 255, g, breg);
                if (w == 4) ssd_scan((LAS float*)(L + SS_ACS + ((c + 1) & 1) * 1536), dn0, dn1, a, lane); }
            const int l = 32 * lt + r; const size_t tok = row0 + c * 128 + l;
            v2u zw[4];
#pragma unroll
            for (int g4 = 0; g4 < 4; ++g4) zw[g4] = *(const GAS v2u*)(zg + tok * 1024 + head * 64 + 32 * pt + 8 * g4 + 4 * h);
            bf16x8 cf[8];
#pragma unroll
            for (int ks = 0; ks < 8; ++ks) cf[ks] = *(const LAS bf16x8*)(L + SS_CN + (32 * lt + r) * SSP + (16 * ks + 8 * h) * 2);
            const float al = acs[l];
            f32x16 y1 = zero16();
            for (int st = 0; st <= lt; ++st) {
                f32x16 ga = zero16(), gb = zero16();
#pragma unroll
                for (int ks = 0; ks < 8; ks += 2) { const bf16x8 af0 = *(const LAS bf16x8*)(L + SS_BN + (32 * st + r) * SSP + (16 * ks + 8 * h) * 2), af1 = *(const LAS bf16x8*)(L + SS_BN + (32 * st + r) * SSP + (16 * ks + 16 + 8 * h) * 2);
                    ga = MFMA32(af0, cf[ks], ga); gb = MFMA32(af1, cf[ks + 1], gb); }
                if (st < lt) {
                    const float ur = __expf(al - acs[32 * st + 31]);
#pragma unroll
                    for (int i = 0; i < 16; ++i) { const int sidx = 32 * st + (i & 3) + 8 * (i >> 2) + 4 * h; ga[i] = (ga[i] + gb[i]) * (ur * vfac[sidx]); }
                } else {
#pragma unroll
                    for (int i = 0; i < 16; ++i) { const int sidx = 32 * st + (i & 3) + 8 * (i >> 2) + 4 * h; const float msk = (sidx <= l) ? 1.f : 0.f;
                        const float e = __expf(fminf(al - acs[sidx], 0.f)) * (dtv[sidx] * msk); ga[i] = (ga[i] + gb[i]) * e; }
                }
#pragma unroll
                for (int s2 = 0; s2 < 2; ++s2) { const bf16x8 pf = PACK_STEP(ga, s2);
                    const LAS unsigned char* xp = L + SS_XT + (32 * pt + r) * SSP + (32 * st + 16 * s2 + 4 * h) * 2;
                    const v2u lo = *(const LAS v2u*)xp, hi = *(const LAS v2u*)(xp + 16);
                    const bf16x8 xa = __builtin_bit_cast(bf16x8, ((v4u){lo.x, lo.y, hi.x, hi.y}));
                    y1 = MFMA32(xa, pf, y1); }
            }
            f32x16 y2 = zero16(), y2b = zero16();
#pragma unroll
            for (int ks = 0; ks < 8; ks += 2) { const bf16x8 hf0 = *(const LAS bf16x8*)(L + SS_HB + (32 * pt + r) * SSP + (16 * ks + 8 * h) * 2), hf1 = *(const LAS bf16x8*)(L + SS_HB + (32 * pt + r) * SSP + (16 * ks + 16 + 8 * h) * 2);
                y2 = MFMA32(hf0, cf[ks], y2); y2b = MFMA32(hf1, cf[ks + 1], y2b); }
            const float el = __expf(al);
            float sq = 0.f;
#pragma unroll
            for (int g4 = 0; g4 < 4; ++g4) { const int p0 = 32 * pt + 8 * g4 + 4 * h;
                const float z0 = bf2f(zw[g4].x & 0xffffu), z1 = __uint_as_float(zw[g4].x & 0xffff0000u), z2 = bf2f(zw[g4].y & 0xffffu), z3 = __uint_as_float(zw[g4].y & 0xffff0000u);
                float yv[4];
#pragma unroll
                for (int j = 0; j < 4; ++j) { const float xv = bf2f(*(const LAS unsigned short*)(L + SS_XT + (p0 + j) * SSP + l * 2)); yv[j] = y1[4 * g4 + j] + el * (y2[4 * g4 + j] + y2b[4 * g4 + j]) + dsk * xv; }
                yv[0] *= z0; yv[1] *= z1; yv[2] *= z2; yv[3] *= z3;
                sq += yv[0] * yv[0] + yv[1] * yv[1] + yv[2] * yv[2] + yv[3] * yv[3];
                *(GAS v2u*)(mix + tok * 1536 + 512 + head * 64 + p0) = (v2u){cvtpk(yv[0], yv[1]), cvtpk(yv[2], yv[3])}; }
            sq += __shfl_xor(sq, 32);
            if (h == 0) ssqp[tok * 32 + head * 2 + pt] = sq;
            const float cd = __expf(acs[127]);
            f32x16 sa = zero16(), sb = zero16();
#pragma unroll
            for (int ks = 0; ks < 8; ks += 2) {
                const bf16x8 xa0 = *(const LAS bf16x8*)(L + SS_XT + (32 * pt2 + r) * SSP + (16 * ks + 8 * h) * 2), xa1 = *(const LAS bf16x8*)(L + SS_XT + (32 * pt2 + r) * SSP + (16 * ks + 16 + 8 * h) * 2);
                const bf16x8 bd0 = *(const LAS bf16x8*)(L + SS_BTD + (32 * nt + r) * SSP + (16 * ks + 8 * h) * 2), bd1 = *(const LAS bf16x8*)(L + SS_BTD + (32 * nt + r) * SSP + (16 * ks + 16 + 8 * h) * 2);
                sa = MFMA32(xa0, bd0, sa); sb = MFMA32(xa1, bd1, sb); }
#pragma unroll
            for (int i = 0; i < 16; ++i) hacc[i] = hacc[i] * cd + (sa[i] + sb[i]);
        }
        LBAR();
#pragma unroll
        for (int i = 0; i < 16; ++i) { const int p = 32 * pt2 + (i & 3) + 8 * (i >> 2) + 4 * h; *(LAS unsigned short*)(L + SS_HB + p * SSP + (32 * nt + r) * 2) = (unsigned short)f2bf(hacc[i]); }
    }
    { const int r = F.lane & 31, h = F.lane >> 5;
#pragma unroll
    for (int i = 0; i < 16; ++i) { const int p = 32 * pt2 + (i & 3) + 8 * (i >> 2) + 4 * h; hout[(size_t)p * 128 + 32 * nt + r] = hacc[i]; } }
    __syncthreads();
}

__device__ __forceinline__ void ssd_sample_wave(Frame& F, const Args& A, int v) {
    int lane = F.lane; asm volatile("" : "+v"(lane));
    const int b = v >> 4, head = v & 15, g = head >> 3; const size_t row = (size_t)TP + b;
    LAS float* wl = (LAS float*)(F.lds + RING_OFF + F.wave * 17152);
    const bf16* xbc = WSP(bf16, WS_XBC); const float* cc = A.in[4]; const float* conv_w = A.in[16]; const float* conv_b = A.in[17];
#pragma unroll
    for (int i = 0; i < 5; ++i) { const int c = lane + 64 * i; const int col = c < 64 ? head * 64 + c : (c < 192 ? 1024 + g * 128 + (c - 64) : 1280 + g * 128 + (c - 192));
        float x = conv_b[col] + conv_w[3 * 1536 + col] * bf2f(xbc[row * 1536 + col]);
#pragma unroll
        for (int w = 0; w < 3; ++w) x += conv_w[w * 1536 + col] * cc[((size_t)b * 3 + w) * 1536 + col];
        wl[c] = silu_f(x); }
    const float dt = WSP(float, WS_DTB)[row * 16 + head], dec = __expf(-dt * __expf(A.in[19][head])), dsk = A.in[20][head];
    LDS_WAIT(); asm volatile("" ::: "memory");
    const float x = wl[lane], dtx = dt * x;
    const GAS f32x4* hp = (const GAS f32x4*)(A.in[5] + (size_t)v * 8192 + lane * 128); GAS f32x4* op = (GAS f32x4*)(F.out + O_SSS + (size_t)v * 8192 + lane * 128);
    float y = 0.f;
#pragma unroll
    for (int jb = 0; jb < 4; ++jb) { f32x4 hv[8];
#pragma unroll
        for (int j = 0; j < 8; ++j) hv[j] = hp[8 * jb + j];
#pragma unroll
        for (int j = 0; j < 8; ++j) { const f32x4 B4 = *(const LAS f32x4*)(wl + 64 + 4 * (8 * jb + j)), C4 = *(const LAS f32x4*)(wl + 192 + 4 * (8 * jb + j));
            const f32x4 hn = hv[j] * dec + B4 * dtx; y += (C4.x * hn.x + C4.y * hn.y) + (C4.z * hn.z + C4.w * hn.w); op[8 * jb + j] = hn; } }
    y = (y + dsk * x) * bf2f(WSP(bf16, WS_ZG)[row * 1024 + head * 64 + lane]);
    WSP(bf16, WS_MIX)[row * 1536 + 512 + head * 64 + lane] = (bf16)f2bf(y);
    const float sq = wave_sum(y * y);
    if (lane < 2) WSP(float, WS_SSQP)[row * 32 + head * 2 + lane] = lane == 0 ? sq : 0.f;
    asm volatile("s_waitcnt lgkmcnt(0)" ::: "memory");
}
__device__ __forceinline__ void attn_sample_wave(Frame& F, const Args& A, int v) {
    int lane = F.lane; asm volatile("" : "+v"(lane));
    const int bs = v >> 3, hd = v & 7; const size_t row = (size_t)TP + bs;
    LAS float* ql = (LAS float*)(F.lds + RING_OFF + F.wave * 17152);
    LAS float* T = ql + 64;
    const float* ck = A.in[2]; const float* cv = A.in[3]; const float* relb = A.in[9];
    const float qv = bf2f(WSP(bf16, WS_QB)[row * 512 + hd * 64 + lane]), kn = bf2f(WSP(bf16, WS_KB)[row * 512 + hd * 64 + lane]), vn = bf2f(WSP(bf16, WS_VB)[row * 512 + hd * 64 + lane]);
    ql[lane] = qv;
    const float s0 = wave_sum(qv * kn) + relb[hd] * 1.44269504f;
    LDS_WAIT(); asm volatile("" ::: "memory");
    float m = lane == 0 ? s0 : -1e30f, l = lane == 0 ? 3.f : 0.f, o[64];
#pragma unroll
    for (int d = 0; d < 64; ++d) { const float vd = __shfl(vn, d); o[d] = lane == 0 ? 3.f * vd : 0.f; }
#pragma unroll 1
    for (int t = 0; t < 6; ++t) {
        const int e = lane + 64 * t, p = e >> 7, j = (e & 127) + 1, dist = j << (2 * p);
        const size_t off = (((size_t)bs * 2048 + (2048 - dist)) * 8 + hd) * 64;
        float s = relb[t5_bucket(dist) * 8 + hd] * 1.44269504f;
        { const GAS f32x4* kp = (const GAS f32x4*)(ck + off); f32x4 kr[16];
#pragma unroll
          for (int c = 0; c < 16; ++c) kr[c] = kp[c];
#pragma unroll
          for (int c = 0; c < 16; ++c) { const f32x4 q4 = *(const LAS f32x4*)(ql + 4 * c); s += (q4.x * kr[c].x + q4.y * kr[c].y) + (q4.z * kr[c].z + q4.w * kr[c].w); } }
        const float mn = fmaxf(m, s), sc = __builtin_amdgcn_exp2f(m - mn), pe = __builtin_amdgcn_exp2f(s - mn); l = l * sc + pe; m = mn;
        { const GAS f32x4* vp = (const GAS f32x4*)(cv + off); f32x4 vr[16];
#pragma unroll
          for (int c = 0; c < 16; ++c) vr[c] = vp[c];
#pragma unroll
          for (int c = 0; c < 16; ++c) { o[4 * c] = o[4 * c] * sc + pe * vr[c].x; o[4 * c + 1] = o[4 * c + 1] * sc + pe * vr[c].y; o[4 * c + 2] = o[4 * c + 2] * sc + pe * vr[c].z; o[4 * c + 3] = o[4 * c + 3] * sc + pe * vr[c].w; } }
    }
    const float M = wave_max(m), f = __builtin_amdgcn_exp2f(m - M); const float Ls = wave_sum(l * f);
#pragma unroll
    for (int d = 0; d < 64; ++d) T[lane * 65 + d] = o[d] * f;
    LDS_WAIT(); asm volatile("" ::: "memory");
    float acc = 0.f;
#pragma unroll 8
    for (int r = 0; r < 64; ++r) acc += T[r * 65 + lane];
    WSP(bf16, WS_MIX)[row * 1536 + hd * 64 + lane] = (bf16)f2bf(acc / Ls);
    LDS_WAIT(); asm volatile("" ::: "memory");
}
__device__ __forceinline__ void cross_sample_block(Frame& F, const Args& A, int pair) {
    int lane = F.lane; asm volatile("" : "+v"(lane));
    const int w = F.wave, task = pair * 2 + (w >> 2), kq = w & 3, bs = task >> 2, hx = task & 3; const size_t row = (size_t)TP + bs;
    const float* cmk = A.in[6]; const float* cmv = A.in[7];
    LAS float* X = (LAS float*)(F.lds + RING_OFF);
    float q[4]; { const v2u qw = *(const GAS v2u*)(WSP(bf16, WS_QC) + row * 1024 + hx * 256 + lane * 4); q[0] = bf2f(qw.x & 0xffffu); q[1] = __uint_as_float(qw.x & 0xffff0000u); q[2] = bf2f(qw.y & 0xffffu); q[3] = __uint_as_float(qw.y & 0xffff0000u); }
    const size_t kbase = (((size_t)bs * 256 + kq * 64) * 4 + hx) * 256 + lane * 4;
    float keep = 0.f;
#pragma unroll 1
    for (int kb = 0; kb < 4; ++kb) { f32x4 kr[16]; float d[16];
#pragma unroll
        for (int i = 0; i < 16; ++i) kr[i] = *(const GAS f32x4*)(cmk + kbase + (size_t)(kb * 16 + i) * 1024);
#pragma unroll
        for (int i = 0; i < 16; ++i) d[i] = (q[0] * kr[i].x + q[1] * kr[i].y) + (q[2] * kr[i].z + q[3] * kr[i].w);
#pragma unroll
        for (int o = 1; o < 64; o <<= 1) {
#pragma unroll
            for (int i = 0; i < 16; ++i) d[i] += __shfl_xor(d[i], o); }
#pragma unroll
        for (int i = 0; i < 16; ++i) keep = (lane == kb * 16 + i) ? d[i] : keep; }
    const float mw = wave_max(keep), pe = __expf(keep - mw), lw = wave_sum(pe);
    float o[4] = {0.f, 0.f, 0.f, 0.f};
#pragma unroll 1
    for (int kb = 0; kb < 4; ++kb) { f32x4 vr[16];
#pragma unroll
        for (int i = 0; i < 16; ++i) vr[i] = *(const GAS f32x4*)(cmv + kbase + (size_t)(kb * 16 + i) * 1024);
#pragma unroll
        for (int i = 0; i < 16; ++i) { const float wgt = rdlane(pe, kb * 16 + i); o[0] += wgt * vr[i].x; o[1] += wgt * vr[i].y; o[2] += wgt * vr[i].z; o[3] += wgt * vr[i].w; } }
    __syncthreads();
    *(LAS f32x4*)(X + w * 260 + lane * 4) = (f32x4){o[0], o[1], o[2], o[3]};
    if (lane == 0) { X[w * 260 + 256] = mw; X[w * 260 + 257] = lw; }
    __syncthreads();
    if (kq == 0) { const int w0 = w;
        float mm[4], ll[4];
#pragma unroll
        for (int i = 0; i < 4; ++i) { mm[i] = X[(w0 + i) * 260 + 256]; ll[i] = X[(w0 + i) * 260 + 257]; }
        const float M = fmaxf(fmaxf(mm[0], mm[1]), fmaxf(mm[2], mm[3])); float Ls = 0.f; f32x4 acc = (f32x4){0.f, 0.f, 0.f, 0.f};
#pragma unroll
        for (int i = 0; i < 4; ++i) { const float f = __expf(mm[i] - M); Ls += f * ll[i]; acc += *(const LAS f32x4*)(X + (w0 + i) * 260 + lane * 4) * f; }
        const float inv = 1.f / Ls;
        *(GAS v2u*)(WSP(bf16, WS_OC) + row * 1024 + hx * 256 + lane * 4) = (v2u){pk2(acc.x * inv, acc.y * inv), pk2(acc.z * inv, acc.w * inv)}; }
    __syncthreads();
}

#define SAMPLE_SPLIT(EPI, E, g, KS, IDX) do { pg8::Gemm g2{(g).A, (g).Bt, 256, (g).N, 256, (g).lda, (g).ldb}; pg8::SplitOrder S2; S2.init((g).N, (KS), 256, F.G, (int)blockIdx.x); \
        pg8::EpiSplit<EPI> E2{(E), WSP(float, WS_SLAB), (unsigned*)(F.ctl + CW_TICK + (IDX) * TICK_WORDS), (KS)}; \
        pg8::gemm_phase<pg8::EpiSplit<EPI>, pg8::SplitOrder, PG8_ALIGN, PG8_SP2>(F.lds + RING_OFF, g2, S2, E2, F.wave); } while (0)
__global__ void __launch_bounds__(NWAVES * 64, 2) hymba_fwd(Args args) {
    extern __shared__ __attribute__((aligned(16))) unsigned char lds[];
    Frame F;
    F.lds = (LAS unsigned char*)lds; F.MISC = (volatile LAS unsigned*)(F.lds + MISC_OFF);
    F.wave = __builtin_amdgcn_readfirstlane(threadIdx.x >> 6); refresh(F);
    F.G = gridDim.x; { const int bx = blockIdx.x; F.vcu = (F.G % 8 == 0) ? (bx % 8) * (F.G / 8) + bx / 8 : bx; }
    F.out = args.out; F.ws = args.ws; F.ctl = (gu32*)(args.ws + WS_CTL);
    for (int u = F.tid; u < (LDS_BYTES - LDSCTL_OFF) / 4; u += NWAVES * 64) ((LAS unsigned*)(F.lds + LDSCTL_OFF))[u] = 0u;
    __syncthreads();
    XcdBarrier bar; bar.bar = (unsigned*)(F.ctl + CW_BAR); bar.x = 0; bar.st = nullptr;
    if (!MK_SPLIT) bar = xcd_barrier_post((unsigned*)(F.ctl + CW_BAR), F.MISC + 8, F.tid == 0);
    const int lo = args.ph_lo, hi = args.ph_hi;
#define IN(k) (lo <= (k) && (k) < hi)
#define SEAM(k) do { if (IN(k) && IN((k) + 1)) { refresh(F); xcd_barrier(bar, F.tid == 0); } } while (0)
    const int gw = F.vcu * NWAVES + F.wave, NGW = F.G * NWAVES;
    float* out = args.out;

    if (IN(0)) { refresh(F); p0_prologue(F, args); } SEAM(0);
    if (IN(1)) { refresh(F); pg8::Gemm g{WSP(bf16, WS_XB), WSP(bf16, WS_W1GU), TP, 2 * DFF, 1024, 1024, 1024}; pg8::StaticOrder S; S.init(TP, 2 * DFF, F.G, (int)blockIdx.x);
        pg8::EpiGateUp E{WSP(bf16, WS_U), WSP(float, WS_RQ0)};
        pg8::gemm_phase<pg8::EpiGateUp, pg8::StaticOrder, PG8_ALIGN, PG8_SP2>(F.lds + RING_OFF, g, S, E, F.wave);
        SAMPLE_SPLIT(pg8::EpiGateUp, E, g, 4, 0); } SEAM(1);
    if (IN(2)) { refresh(F); pg8::Gemm g{WSP(bf16, WS_U), WSP(bf16, WS_W1D), TP, 1024, DFF, DFF, DFF}; pg8::StaticOrder S; S.init(TP, 1024, F.G, (int)blockIdx.x);
        pg8::EpiResid E{WSP(bf16, WS_XB), 0.5f, WSP(float, WS_RQ1), nullptr, nullptr};
        pg8::gemm_phase<pg8::EpiResid, pg8::StaticOrder, PG8_ALIGN, PG8_SP2>(F.lds + RING_OFF, g, S, E, F.wave);
        SAMPLE_SPLIT(pg8::EpiResid, E, g, 11, 1); } SEAM(2);
    if (IN(3)) { refresh(F); pg8::Gemm g{WSP(bf16, WS_XB), WSP(bf16, WS_WIN), TP, NINP, 1024, 1024, 1024}; pg8::StaticOrder S; S.init(TP, NINP, F.G, (int)blockIdx.x);
        pg8::EpiInProj E{WSP(float, WS_RQ1), WSP(bf16, WS_QB), WSP(bf16, WS_KB), WSP(bf16, WS_VB), WSP(bf16, WS_ZG), WSP(bf16, WS_XBC), WSP(float, WS_DTB), args.in[18],
                         out + O_WKP, out + O_WVP, out + O_CVP, out + O_WKS, out + O_WVS, out + O_CVS};
        pg8::gemm_phase<pg8::EpiInProj, pg8::StaticOrder, PG8_ALIGN, PG8_SP2>(F.lds + RING_OFF, g, S, E, F.wave);
        SAMPLE_SPLIT(pg8::EpiInProj, E, g, 4, 2); } SEAM(3);
    if (IN(4)) { refresh(F);
        for (int v = gw; v < TS * NHB; v += NGW) ssd_sample_wave(F, args, v);
        for (int v = gw; v < TS * NHA; v += NGW) attn_sample_wave(F, args, v);
        bc_conv_prepass(F, args);
        attn_mfma_phase(F, args);
        refresh(F); xcd_barrier(bar, F.tid == 0);
        refresh(F);
        for (int u = blockIdx.x; u < NB * NHB; u += F.G) { const int b = u >> 4, hd = u & 15; ssd_mfma_unit(F, args, b, hd, out + O_SSP + (size_t)u * 8192); }
    } SEAM(4);
    if (IN(5)) { refresh(F); bf16* mix = WSP(bf16, WS_MIX); const float* ssqp = WSP(float, WS_SSQP);
        { const bf16* part = WSP(bf16, WS_PART); const float* lsep = WSP(float, WS_LSE); const int hd = F.lane >> 3;
          for (int m0 = gw; m0 < TP; m0 += 8 * NGW) {
              v4u pa[8][3]; float ls[8][3];
#pragma unroll
              for (int q = 0; q < 8; ++q) { const int m = min(m0 + q * NGW, TP - 1);
#pragma unroll
                  for (int p = 0; p < 3; ++p) { ls[q][p] = lsep[((size_t)p * TP + m) * 8 + hd]; pa[q][p] = *(const GAS v4u*)(part + ((size_t)p * TP + m) * 512 + F.lane * 8); } }
#pragma unroll
              for (int q = 0; q < 8; ++q) { const int m = m0 + q * NGW; if (m >= TP) continue;
                  const float mx = fmaxf(ls[q][0], fmaxf(ls[q][1], ls[q][2])); float e0 = __expf(ls[q][0] - mx), e1 = __expf(ls[q][1] - mx), e2 = __expf(ls[q][2] - mx); const float inv = 1.f / (e0 + e1 + e2); e0 *= inv; e1 *= inv; e2 *= inv;
                  float a[8], bq[8], c[8]; unpack8(pa[q][0], a); unpack8(pa[q][1], bq); unpack8(pa[q][2], c);
                  v4u o; o.x = pk2(e0 * a[0] + e1 * bq[0] + e2 * c[0], e0 * a[1] + e1 * bq[1] + e2 * c[1]); o.y = pk2(e0 * a[2] + e1 * bq[2] + e2 * c[2], e0 * a[3] + e1 * bq[3] + e2 * c[3]);
                  o.z = pk2(e0 * a[4] + e1 * bq[4] + e2 * c[4], e0 * a[5] + e1 * bq[5] + e2 * c[5]); o.w = pk2(e0 * a[6] + e1 * bq[6] + e2 * c[6], e0 * a[7] + e1 * bq[7] + e2 * c[7]);
                  *(GAS v4u*)(mix + (size_t)m * 1536 + F.lane * 8) = o; } } }
        { float* rs2 = WSP(float, WS_RS2);
          for (int m0 = gw * 2; m0 < TP; m0 += 16 * NGW) {
              float pq[8];
#pragma unroll
              for (int q = 0; q < 8; ++q) { const int m = min(m0 + q * 2 * NGW + (F.lane >> 5), TP - 1); pq[q] = ssqp[(size_t)m * 32 + (F.lane & 31)]; }
#pragma unroll
              for (int q = 0; q < 8; ++q) { const int m = m0 + q * 2 * NGW + (F.lane >> 5); float pv = pq[q]; pv += __shfl_xor(pv, 1); pv += __shfl_xor(pv, 2); pv += __shfl_xor(pv, 4); pv += __shfl_xor(pv, 8);
                  if ((F.lane & 15) == 0 && m < TP) rs2[2 * (size_t)m + ((F.lane >> 4) & 1)] = rsqrtf(pv * (1.f / 512.f) + EPS); } } }
        for (int m = TP + gw; m < MROWS; m += NGW) {
            GAS v4u* p = (GAS v4u*)(mix + (size_t)m * 1536 + 512) + F.lane; v4u w0 = p[0], w1 = p[64];
            float pv = ssqp[(size_t)m * 32 + (F.lane & 31)]; pv += __shfl_xor(pv, 1); pv += __shfl_xor(pv, 2); pv += __shfl_xor(pv, 4); pv += __shfl_xor(pv, 8);
            const float s0 = rsqrtf(rdlane(pv, 0) * (1.f / 512.f) + EPS), s1 = rsqrtf(rdlane(pv, 16) * (1.f / 512.f) + EPS);
            float f[8]; unpack8(w0, f); v4u o; o.x = pk2(f[0] * s0, f[1] * s0); o.y = pk2(f[2] * s0, f[3] * s0); o.z = pk2(f[4] * s0, f[5] * s0); o.w = pk2(f[6] * s0, f[7] * s0); p[0] = o;
            unpack8(w1, f); o.x = pk2(f[0] * s1, f[1] * s1); o.y = pk2(f[2] * s1, f[3] * s1); o.z = pk2(f[4] * s1, f[5] * s1); o.w = pk2(f[6] * s1, f[7] * s1); p[64] = o;
        }
    } SEAM(5);
    if (IN(6)) { refresh(F); pg8::Gemm g{WSP(bf16, WS_MIX), WSP(bf16, WS_WOUT), TP, 1024, DMIX, DMIX, DMIX}; pg8::StaticOrder S; S.init(TP, 1024, F.G, (int)blockIdx.x);
        pg8::EpiResidKS EK{WSP(bf16, WS_XB), WSP(float, WS_RQ2), WSP(float, WS_RS2)};
        pg8::gemm_phase<pg8::EpiResidKS, pg8::StaticOrder, PG8_ALIGN, PG8_SP2>(F.lds + RING_OFF, g, S, EK, F.wave);
        pg8::EpiResid E{WSP(bf16, WS_XB), 1.0f, WSP(float, WS_RQ2), nullptr, nullptr};
        SAMPLE_SPLIT(pg8::EpiResid, E, g, 6, 3); } SEAM(6);
    if (IN(7)) { refresh(F);
        { pg8::Gemm g{WSP(bf16, WS_XB), WSP(bf16, WS_WCQ), TP, 1024, 1024, 1024, 1024}; pg8::StaticOrder S; S.init(TP, 1024, F.G, (int)blockIdx.x);
          pg8::EpiScale E{WSP(bf16, WS_QC), 1024, WSP(float, WS_RQ2), 0.0625f};
          pg8::gemm_phase<pg8::EpiScale, pg8::StaticOrder, PG8_ALIGN, PG8_SP2>(F.lds + RING_OFF, g, S, E, F.wave);
          SAMPLE_SPLIT(pg8::EpiScale, E, g, 4, 4); }
        { pg8::Gemm g{WSP(bf16, WS_MEMB), WSP(bf16, WS_WMEM), NB * NMEM, 2048, 1024, 1024, 1024}; pg8::StaticOrder S; S.init(NB * NMEM, 2048, F.G, (int)blockIdx.x);
          pg8::EpiMemKV E{WSP(float, WS_RMEM), out + O_MKP, out + O_MVP, WSP(bf16, WS_MKB), WSP(bf16, WS_MVB)};
          pg8::gemm_phase<pg8::EpiMemKV, pg8::StaticOrder, PG8_ALIGN, PG8_SP2>(F.lds + RING_OFF, g, S, E, F.wave); }
    } SEAM(7);
    if (IN(8)) { refresh(F); for (int pr = blockIdx.x; pr < TS * 4 / 2; pr += F.G) cross_sample_block(F, args, pr);
        cross_mfma_phase(F); } SEAM(8);
    if (IN(9)) { refresh(F); pg8::Gemm g{WSP(bf16, WS_OC), WSP(bf16, WS_WCO), TP, 1024, 1024, 1024, 1024}; pg8::StaticOrder S; S.init(TP, 1024, F.G, (int)blockIdx.x);
        pg8::EpiResid E{WSP(bf16, WS_XB), 1.0f, WSP(float, WS_RQ3), nullptr, nullptr};
        pg8::gemm_phase<pg8::EpiResid, pg8::StaticOrder, PG8_ALIGN, PG8_SP2>(F.lds + RING_OFF, g, S, E, F.wave);
        SAMPLE_SPLIT(pg8::EpiResid, E, g, 4, 5); } SEAM(9);
    if (IN(10)) { refresh(F); pg8::Gemm g{WSP(bf16, WS_XB), WSP(bf16, WS_W2GU), TP, 2 * DFF, 1024, 1024, 1024}; pg8::StaticOrder S; S.init(TP, 2 * DFF, F.G, (int)blockIdx.x);
        pg8::EpiGateUp E{WSP(bf16, WS_U), WSP(float, WS_RQ3)};
        pg8::gemm_phase<pg8::EpiGateUp, pg8::StaticOrder, PG8_ALIGN, PG8_SP2>(F.lds + RING_OFF, g, S, E, F.wave);
        SAMPLE_SPLIT(pg8::EpiGateUp, E, g, 4, 6); } SEAM(10);
    if (IN(11)) { refresh(F); pg8::Gemm g{WSP(bf16, WS_U), WSP(bf16, WS_W2D), TP, 1024, DFF, DFF, DFF}; pg8::StaticOrder S; S.init(TP, 1024, F.G, (int)blockIdx.x);
        pg8::EpiResid E{WSP(bf16, WS_XB), 0.5f, WSP(float, WS_RQ4), nullptr, nullptr};
        pg8::gemm_phase<pg8::EpiResid, pg8::StaticOrder, PG8_ALIGN, PG8_SP2>(F.lds + RING_OFF, g, S, E, F.wave);
        SAMPLE_SPLIT(pg8::EpiResid, E, g, 11, 7); } SEAM(11);
    if (IN(12)) { refresh(F); const float* rq = WSP(float, WS_RQ4); const GAS f32x4* gp = (const GAS f32x4*)args.in[33] + 2 * F.lane; const bf16* xb = WSP(bf16, WS_XB);
        f32x4 gg[2][2];
#pragma unroll
        for (int j = 0; j < 2; ++j) { gg[j][0] = gp[128 * j]; gg[j][1] = gp[128 * j + 1]; }
        for (int m0 = gw; m0 < MROWS; m0 += 4 * NGW) {
            v4u v[4][2]; float rs[4];
#pragma unroll
            for (int q = 0; q < 4; ++q) { const int m = min(m0 + q * NGW, MROWS - 1); { const GAS v4u* p = (const GAS v4u*)(xb + (size_t)m * 1024) + F.lane; v[q][0] = p[0]; v[q][1] = p[64]; rs[q] = rsqrtf(rq[m] * (1.f / 1024.f) + EPS); } }
#pragma unroll
            for (int q = 0; q < 4; ++q) { const int m = m0 + q * NGW; if (m < MROWS) { GAS f32x4* p = (GAS f32x4*)(m < TP ? out + O_YP + (size_t)m * 1024 : out + O_YS + (size_t)(m - TP) * 1024) + 2 * F.lane;
#pragma unroll
                for (int j = 0; j < 2; ++j) { float f[8]; unpack8(v[q][j], f);
                    p[128 * j] = (f32x4){f[0], f[1], f[2], f[3]} * rs[q] * gg[j][0]; p[128 * j + 1] = (f32x4){f[4], f[5], f[6], f[7]} * rs[q] * gg[j][1]; } } }
        }
    }
#undef IN
#undef SEAM
}

extern "C" void kernel_launch(void* const* d_in, const int* in_sizes, int n_in, void* d_out, int out_size, void* d_ws, size_t ws_size, hipStream_t stream) {
    static int grid = 0;
    if (grid == 0) {
        if (n_in != 34 || (size_t)out_size != O_END || ws_size < WS_END) { fprintf(stderr, "kernel_launch: unexpected sizes n_in %d out %d ws %zu\n", n_in, out_size, ws_size); grid = -1; return; }
        int dev = 0, cus = 0, per_cu = 0;
        if (hipGetDevice(&dev) != hipSuccess || hipDeviceGetAttribute(&cus, hipDeviceAttributeMultiprocessorCount, dev) != hipSuccess) { grid = -1; return; }
        if (hipFuncSetAttribute((const void*)hymba_fwd, hipFuncAttributeMaxDynamicSharedMemorySize, LDS_BYTES) != hipSuccess) { fprintf(stderr, "kernel_launch: hipFuncSetAttribute failed\n"); grid = -1; return; }
        if (hipOccupancyMaxActiveBlocksPerMultiprocessor(&per_cu, (const void*)hymba_fwd, NWAVES * 64, LDS_BYTES) != hipSuccess || per_cu < 1) fprintf(stderr, "kernel_launch: occupancy query reports %d\n", per_cu);
        (void)hipGetLastError();
        grid = cus;
    }
    if (grid < 0) return;
    if (hipMemsetAsync((char*)d_ws + WS_CTL, 0, CTL_ZERO_BYTES, stream) != hipSuccess) return;
    Args a{};
    for (int i = 0; i < 34; ++i) a.in[i] = (const float*)d_in[i];
    a.out = (float*)d_out; a.ws = (unsigned char*)d_ws; a.li = 0; a.pad = 0;
#if MK_SPLIT
    for (int ph = 0; ph < NPHASE; ++ph) { a.ph_lo = ph; a.ph_hi = ph + 1; hipLaunchKernelGGL(hymba_fwd, dim3(grid), dim3(NWAVES * 64), LDS_BYTES, stream, a); }
#else
    a.ph_lo = 0; a.ph_hi = NPHASE;
    hipLaunchKernelGGL(hymba_fwd, dim3(grid), dim3(NWAVES * 64), LDS_BYTES, stream, a);
#endif
}
```

```cpp
#include <hip/hip_runtime.h>
#include <cstdio>
#include <cstdint>
namespace pg8 {
#define PG8_LAS __attribute__((address_space(3)))
typedef unsigned short bf16_t;
typedef short bf16x8 __attribute__((ext_vector_type(8)));
typedef float f32x4 __attribute__((ext_vector_type(4)));
typedef unsigned u32x4 __attribute__((ext_vector_type(4)));
constexpr int BM = 256, BK = 64, HALF = 128, HTB = HALF * BK * 2  , STAGE_BYTES = 8 * HTB, NXCD = 8, WGM = 8;

__host__ __device__ __forceinline__ int lds_byte(int r, int c) { const int st = (r >> 4) * 2 + (c >> 5), rr = r & 15, cc = c & 31, ob = rr * 64 + cc * 2; return st * 1024 + (ob ^ (((ob >> 9) & 1) << 5)); }
__host__ __device__ __forceinline__ void stage_rc(int b, int& R, int& C) { const int st = b / 1024, sb = b % 1024, swz = sb ^ (((sb >> 9) & 1) << 5); R = (st >> 1) * 16 + swz / 64; C = (st & 1) * 32 + (swz % 64) / 2; }
__host__ __device__ __forceinline__ int perm32(int rho) { const int n = rho >> 4, i = rho & 15; return 8 * (i >> 2) + 4 * n + (i & 3); }

struct Unit { int pm, pn, koff, ks; };
struct Gemm { const bf16_t* A; const bf16_t* Bt; int M, N, K, lda, ldb; };

struct StaticOrder {
    int nM, nN, nwg, G, c;
    __host__ __device__ void init(int M, int N, int G_, int c_) { nM = M / BM; nN = N / BM; nwg = nM * nN; G = G_; c = c_; }
    __host__ __device__ bool next(int i, Unit& u) const {
        const long L = (long)i * G + c; if (L >= nwg) return false;
        int wgid = (int)L; { const int q = nwg / NXCD, r = nwg % NXCD, xcd = wgid % NXCD, off = wgid / NXCD; wgid = (xcd < r ? xcd * (q + 1) : r * (q + 1) + (xcd - r) * q) + off; }
        const int nig = WGM * nN, gid = wgid / nig, fm = gid * WGM, gsz = (nM - fm) < WGM ? (nM - fm) : WGM;
        u.pm = fm + ((wgid % nig) % gsz); u.pn = (wgid % nig) / gsz; u.koff = 0; u.ks = 0; return true;
    }
    __device__ __forceinline__ void a_ready(const Unit&) const {}
    __device__ __forceinline__ void done(const Unit&) const {}
};
__device__ __forceinline__ unsigned cvt_pk_bf16(float lo, float hi) { unsigned r; asm volatile("v_cvt_pk_bf16_f32 %0, %1, %2" : "=v"(r) : "v"(lo), "v"(hi)); return r; }
typedef float f32x2 __attribute__((ext_vector_type(2)));
template <class Epi, class Sched, bool ALIGN_EPI = false, bool SP2 = false>
__device__ __forceinline__ void gemm_phase(PG8_LAS unsigned char* lds, const Gemm g, const Sched& S, const Epi& E, const int wid) {
    int lane; asm volatile("v_mbcnt_lo_u32_b32 %0, -1, 0\n\tv_mbcnt_hi_u32_b32 %0, -1, %0" : "=v"(lane));
    const int tid = wid * 64 + lane, wr = wid >> 2, wc = wid & 3, fr = lane & 15, fq = lane >> 4;
    const int K = g.K, nt = K / BK;
    unsigned voffA[2], voffB[2];
#pragma unroll
    for (int i = 0; i < 2; ++i) { int R, C; stage_rc(tid * 16 + i * 8192, R, C); const int Rb = Epi::PERM ? ((R & ~31) + perm32(R & 31)) : R;
        voffA[i] = (unsigned)(R * g.lda + C) * 2u; voffB[i] = (unsigned)(Rb * g.ldb + C) * 2u; }
    const size_t kstep = (size_t)(BK * 2);
    const size_t hstepA = (size_t)HALF * g.lda * 2, hstepB = (size_t)HALF * g.ldb * 2;
    const size_t tstepA = 2 * hstepA, tstepB = 2 * hstepB;
    const unsigned ldsw = (unsigned)wid * 1024u;
    const int aoff = lds_byte(wr * 64 + fr, fq * 8), boff = lds_byte(wc * 32 + fr, fq * 8);
#define PG8_SA(b, h) (((b) * 2 + (h)) * HTB)
#define PG8_SB(b, h) ((4 + (b) * 2 + (h)) * HTB)
#define PG8_STAGE(bufoff, gbase, voff) do { _Pragma("unroll") for (int _i = 0; _i < 2; ++_i) \
        __builtin_amdgcn_global_load_lds((const unsigned*)((const char*)(gbase) + (voff)[_i]), (PG8_LAS unsigned*)(lds + (bufoff) + ldsw + _i * 8192), 16, 0, 0); } while (0)
#define PG8_LDA(dst, b, h) do { _Pragma("unroll") for (int m = 0; m < 4; ++m) _Pragma("unroll") for (int k = 0; k < 2; ++k) dst[m][k] = *(const PG8_LAS bf16x8*)(lds + PG8_SA(b, h) + aoff + m * 2048 + k * 1024); } while (0)
#define PG8_LDB(dst, b, h) do { _Pragma("unroll") for (int n = 0; n < 2; ++n) _Pragma("unroll") for (int k = 0; k < 2; ++k) dst[n][k] = *(const PG8_LAS bf16x8*)(lds + PG8_SB(b, h) + boff + n * 2048 + k * 1024); } while (0)
#define PG8_MMA(ai, bj, At, Bt) do { __builtin_amdgcn_s_setprio(1); _Pragma("unroll") for (int m = 0; m < 4; ++m) _Pragma("unroll") for (int n = 0; n < 2; ++n) _Pragma("unroll") for (int k = 0; k < 2; ++k) \
        acc[ai][bj][m][n] = __builtin_amdgcn_mfma_f32_16x16x32_bf16(Bt[n][k], At[m][k], acc[ai][bj][m][n], 0, 0, 0); __builtin_amdgcn_s_setprio(0); } while (0)
#define PG8_WAIT_V(n) asm volatile("s_waitcnt vmcnt(" #n ")" ::: "memory")
#define PG8_WAIT_L(n) asm volatile("s_waitcnt lgkmcnt(" #n ")" ::: "memory")
#define PG8_BAR __builtin_amdgcn_s_barrier()
#define PG8_SCHED __builtin_amdgcn_sched_barrier(0)
    Unit cur, nxt; int ui = 0;
    if (!S.next(0, cur)) return;
    float pre[8] = {0.f, 0.f, 0.f, 0.f, 0.f, 0.f, 0.f, 0.f};
    f32x4 acc[2][2][4][2];
#pragma unroll
    for (int a = 0; a < 2; ++a)
#pragma unroll
        for (int b = 0; b < 2; ++b)
#pragma unroll
            for (int m = 0; m < 4; ++m)
#pragma unroll
                for (int n = 0; n < 2; ++n) acc[a][b][m][n] = (f32x4){0.f, 0.f, 0.f, 0.f};
    bf16x8 At[4][2], B0[2][2], B1[2][2];
    const char* cA = (const char*)g.A + (size_t)cur.pm * tstepA + cur.koff; const char* cB = (const char*)g.Bt + (size_t)cur.pn * tstepB + cur.koff;
    S.a_ready(cur);
    if constexpr (SP2) {
        PG8_STAGE(PG8_SB(0, 0), cB, voffB); PG8_STAGE(PG8_SB(0, 1), cB + hstepB, voffB); PG8_STAGE(PG8_SA(0, 0), cA, voffA); PG8_STAGE(PG8_SA(0, 1), cA + hstepA, voffA);
        if (wr == 1) PG8_BAR;
        PG8_WAIT_V(2); PG8_BAR;
        PG8_STAGE(PG8_SB(1, 0), cB + kstep, voffB); PG8_STAGE(PG8_SA(1, 0), cA + kstep, voffA); PG8_STAGE(PG8_SB(1, 1), cB + hstepB + kstep, voffB);
        PG8_WAIT_V(6); PG8_BAR;
    } else {
        PG8_STAGE(PG8_SB(0, 0), cB, voffB); PG8_STAGE(PG8_SA(0, 0), cA, voffA); PG8_STAGE(PG8_SB(0, 1), cB + hstepB, voffB); PG8_STAGE(PG8_SA(0, 1), cA + hstepA, voffA);
        if (wr == 1) PG8_BAR;
        PG8_WAIT_V(4); PG8_BAR;
        PG8_STAGE(PG8_SB(1, 0), cB + kstep, voffB); PG8_STAGE(PG8_SA(1, 0), cA + kstep, voffA); PG8_STAGE(PG8_SB(1, 1), cB + hstepB + kstep, voffB);
        PG8_WAIT_V(6); PG8_BAR;
    }
    for (;;) {
        const bool has_next = S.next(ui + 1, nxt);
        const char* nA = has_next ? (const char*)g.A + (size_t)nxt.pm * tstepA + nxt.koff : cA; const char* nB = has_next ? (const char*)g.Bt + (size_t)nxt.pn * tstepB + nxt.koff : cB;
        for (int t = 0; t < nt; t += 2) {
            if constexpr (Epi::KSEG > 0) { if (t == Epi::KSEG || t == 2 * Epi::KSEG) E.kseg(acc, cur, t, wr, fr); }
            if constexpr (Epi::PRE) { if (t == nt - 2) E.preload(cur, wr, fr, pre); }
            const bool last = (t == nt - 2);
            const char* a1 = cA + (size_t)(t + 1) * kstep;
            const char* a2 = last ? nA : cA + (size_t)(t + 2) * kstep; const char* b2 = last ? nB : cB + (size_t)(t + 2) * kstep;
            const char* a3 = a2 + kstep; const char* b3 = b2 + kstep;
            if (last && has_next) S.a_ready(nxt);
            if constexpr (SP2) {
            PG8_LDB(B0, 0, 0); PG8_LDB(B1, 0, 1); PG8_SCHED; PG8_LDA(At, 0, 0); PG8_STAGE(PG8_SA(1, 1), a1 + hstepA, voffA);
            PG8_WAIT_V(8); PG8_WAIT_L(0); PG8_BAR; PG8_MMA(0, 0, At, B0); PG8_MMA(0, 1, At, B1); PG8_BAR; PG8_SCHED;
            PG8_LDA(At, 0, 1); PG8_STAGE(PG8_SB(0, 0), b2, voffB); PG8_STAGE(PG8_SB(0, 1), b2 + hstepB, voffB); PG8_STAGE(PG8_SA(0, 0), a2, voffA);
            PG8_WAIT_V(8); PG8_WAIT_L(0); PG8_BAR; PG8_MMA(1, 0, At, B0); PG8_MMA(1, 1, At, B1); PG8_BAR; PG8_SCHED;
            PG8_LDB(B0, 1, 0); PG8_LDB(B1, 1, 1); PG8_SCHED; PG8_LDA(At, 1, 0); PG8_STAGE(PG8_SA(0, 1), a2 + hstepA, voffA);
            PG8_WAIT_V(8); PG8_WAIT_L(0); PG8_BAR; PG8_MMA(0, 0, At, B0); PG8_MMA(0, 1, At, B1); PG8_BAR; PG8_SCHED;
            PG8_LDA(At, 1, 1); PG8_STAGE(PG8_SB(1, 0), b3, voffB); PG8_STAGE(PG8_SB(1, 1), b3 + hstepB, voffB); PG8_STAGE(PG8_SA(1, 0), a3, voffA);
            PG8_WAIT_V(8); PG8_WAIT_L(0); PG8_BAR; PG8_MMA(1, 0, At, B0); PG8_MMA(1, 1, At, B1); PG8_BAR; PG8_SCHED;
            } else {
            PG8_LDB(B0, 0, 0); PG8_SCHED; PG8_LDA(At, 0, 0); PG8_STAGE(PG8_SA(1, 1), a1 + hstepA, voffA);
            PG8_WAIT_L(8); PG8_BAR; PG8_WAIT_L(0); PG8_MMA(0, 0, At, B0); PG8_BAR; PG8_SCHED;
            PG8_LDB(B1, 0, 1); PG8_STAGE(PG8_SB(0, 0), b2, voffB);
            PG8_BAR; PG8_WAIT_L(0); PG8_MMA(0, 1, At, B1); PG8_BAR;
            PG8_LDA(At, 0, 1); PG8_STAGE(PG8_SA(0, 0), a2, voffA);
            PG8_BAR; PG8_WAIT_L(0); PG8_MMA(1, 0, At, B0); PG8_BAR; PG8_SCHED;
            PG8_STAGE(PG8_SB(0, 1), b2 + hstepB, voffB);
            PG8_WAIT_V(6); PG8_BAR; PG8_MMA(1, 1, At, B1); PG8_BAR;
            PG8_LDB(B0, 1, 0); PG8_SCHED; PG8_LDA(At, 1, 0); PG8_STAGE(PG8_SA(0, 1), a2 + hstepA, voffA);
            PG8_WAIT_L(8); PG8_BAR; PG8_WAIT_L(0); PG8_MMA(0, 0, At, B0); PG8_BAR; PG8_SCHED;
            PG8_LDB(B1, 1, 1); PG8_STAGE(PG8_SB(1, 0), b3, voffB);
            PG8_BAR; PG8_WAIT_L(0); PG8_MMA(0, 1, At, B1); PG8_BAR;
            PG8_LDA(At, 1, 1); PG8_STAGE(PG8_SA(1, 0), a3, voffA);
            PG8_BAR; PG8_WAIT_L(0); PG8_MMA(1, 0, At, B0); PG8_BAR; PG8_SCHED;
            PG8_STAGE(PG8_SB(1, 1), b3 + hstepB, voffB);
            PG8_WAIT_V(6); PG8_BAR; PG8_MMA(1, 1, At, B1); PG8_BAR;
            }
        }
        if constexpr (ALIGN_EPI) { if (wr == 0) PG8_BAR; }
        if constexpr (!Epi::AFTER_DRAIN) { if constexpr (Epi::PRE) E(acc, cur, wr, wc, fr, fq, pre); else E(acc, cur, wr, wc, fr, fq); S.done(cur); }
        if (!has_next) break;
#pragma unroll
        for (int a = 0; a < 2; ++a)
#pragma unroll
            for (int b = 0; b < 2; ++b)
#pragma unroll
                for (int m = 0; m < 4; ++m)
#pragma unroll
                    for (int n = 0; n < 2; ++n) acc[a][b][m][n] = (f32x4){0.f, 0.f, 0.f, 0.f};
        cur = nxt; cA = nA; cB = nB; ++ui;
        if constexpr (ALIGN_EPI) { if (wr == 1) PG8_BAR; }
    }
    PG8_WAIT_V(0);
    if constexpr (!ALIGN_EPI) { if (wr == 0) PG8_BAR; }
    PG8_BAR;
    if constexpr (Epi::AFTER_DRAIN) { E.fused(acc, cur, wr, wc, fr, fq, lds, wid, lane); S.done(cur); }
#undef PG8_SA
#undef PG8_SB
#undef PG8_STAGE
#undef PG8_LDA
#undef PG8_LDB
#undef PG8_MMA
#undef PG8_WAIT_V
#undef PG8_WAIT_L
#undef PG8_BAR
#undef PG8_SCHED
}
}

#define GAS __attribute__((address_space(1)))
#define LAS __attribute__((address_space(3)))
typedef unsigned short bf16;
typedef unsigned v4u __attribute__((ext_vector_type(4)));
typedef unsigned v2u __attribute__((ext_vector_type(2)));
typedef float f32x4 __attribute__((ext_vector_type(4)));
typedef GAS unsigned gu32;
#define RLX_AGENT __ATOMIC_RELAXED, __HIP_MEMORY_SCOPE_AGENT
#define LDS_WAIT() asm volatile("s_waitcnt lgkmcnt(0)" ::: "memory")
#define VM_WAIT() asm volatile("s_waitcnt vmcnt(0)" ::: "memory")
#define LBAR() do { asm volatile("s_waitcnt lgkmcnt(0)" ::: "memory"); __builtin_amdgcn_s_barrier(); asm volatile("" ::: "memory"); } while (0)

constexpr int DM = 1024, NB = 32, SEQ = 2048, TP = NB * SEQ, TS = 128, MROWS = TP + TS, MT = 65792;
constexpr int DATT = 512, DINNER = 1024, DXBC = 1536, DMIX = 1536, DFF = 2816, NIN = 4112, NINP = 4352, NHA = 8, NHB = 16, NMEM = 256;
constexpr float EPS = 1e-6f;
constexpr size_t O_YP = 0, O_YS = 67108864, O_WKP = 67239936, O_WVP = 100794368, O_CVP = 134348800, O_SSP = 134496256, O_MKP = 138690560, O_MVP = 147079168,
                 O_WKS = 155467776, O_WVS = 155533312, O_CVS = 155598848, O_SSS = 156188672, O_END = 172965888;
constexpr size_t MiB = 1u << 20;
constexpr size_t WS_CTL = 0, CTL_ZERO_BYTES = 4 * MiB;
constexpr size_t WS_RQ1 = 1 * MiB, WS_RQ2 = WS_RQ1 + 512 * 1024, WS_RQ3 = 2 * MiB, WS_RQ4 = WS_RQ3 + 512 * 1024, WS_SSQ = 3 * MiB;
constexpr size_t WS_RQ0 = 4 * MiB, WS_RMEM = WS_RQ0 + 512 * 1024, WS_RS2 = 5 * MiB;
constexpr size_t WS_W1GU = 8 * MiB, WS_W1D = 19 * MiB, WS_WIN = 25 * MiB, WS_WOUT = 34 * MiB, WS_WCQ = 37 * MiB, WS_WCO = 39 * MiB, WS_WMEM = 41 * MiB, WS_W2GU = 45 * MiB, WS_W2D = 56 * MiB;
constexpr size_t WS_XB = 64 * MiB, WS_U = 193 * MiB, WS_QB = 547 * MiB, WS_KB = 612 * MiB, WS_VB = 677 * MiB, WS_ZG = 742 * MiB, WS_XBC = 871 * MiB, WS_DTB = 1064 * MiB,
                 WS_MIX = 1069 * MiB, WS_QC = 1262 * MiB, WS_OC = 1391 * MiB, WS_MEMB = 1520 * MiB, WS_MKB = 1536 * MiB, WS_MVB = 1552 * MiB, WS_SLAB = 1568 * MiB, WS_END = 1584 * MiB;
constexpr int CW_BAR = 4096, CW_TICK = 16384, TICK_WORDS = 22 * 8 * 16;
constexpr int RING_OFF = 0, RING_BYTES = 131072, LDS_BYTES = 147456, LDSCTL_OFF = LDS_BYTES - 512, MISC_OFF = LDSCTL_OFF + 320;
constexpr int NWAVES = 8;
#ifndef MK_SPLIT
#define MK_SPLIT 0
#endif
constexpr int NPHASE = 13;

__device__ __forceinline__ float bf2f(unsigned b) { return __uint_as_float(b << 16); }
__device__ __forceinline__ unsigned f2bf(float f) { unsigned u = __float_as_uint(f); return (u + 0x7fffu + ((u >> 16) & 1u)) >> 16; }
__device__ __forceinline__ unsigned pk2(float lo, float hi) { return f2bf(lo) | (f2bf(hi) << 16); }
__device__ __forceinline__ float silu_f(float x) { return x * __builtin_amdgcn_rcpf(1.f + __expf(-x)); }
__device__ __forceinline__ float wave_sum(float v) {
#pragma unroll
    for (int o = 1; o < 64; o <<= 1) v += __shfl_xor(v, o);
    return v;
}
__device__ __forceinline__ float wave_max(float v) {
#pragma unroll
    for (int o = 1; o < 64; o <<= 1) v = fmaxf(v, __shfl_xor(v, o));
    return v;
}
__device__ __forceinline__ float rdlane(float v, int l) { return __int_as_float(__builtin_amdgcn_readlane(__float_as_int(v), l)); }
__device__ __forceinline__ void unpack8(const v4u w, float* f) {
    f[0] = __uint_as_float(w.x << 16); f[1] = __uint_as_float(w.x & 0xffff0000u); f[2] = __uint_as_float(w.y << 16); f[3] = __uint_as_float(w.y & 0xffff0000u);
    f[4] = __uint_as_float(w.z << 16); f[5] = __uint_as_float(w.z & 0xffff0000u); f[6] = __uint_as_float(w.w << 16); f[7] = __uint_as_float(w.w & 0xffff0000u);
}

namespace pg8 {
struct EpiGateUp {
    static constexpr bool PERM = true, AFTER_DRAIN = false; static constexpr int KSEG = 0; static constexpr bool PRE = true;
    bf16_t* U; const float* rq;
    __device__ __forceinline__ void preload(const Unit& u, int wr, int fr, float (&pre)[8]) const {
        const int row0 = u.pm * BM + wr * 64 + fr;
#pragma unroll
        for (int ai = 0; ai < 2; ++ai)
#pragma unroll
            for (int m = 0; m < 4; ++m) pre[ai * 4 + m] = rq[row0 + ai * HALF + m * 16];
    }
    __device__ __forceinline__ void operator()(const f32x4 (&acc)[2][2][4][2], const Unit& u, int wr, int wc, int fr, int fq, const float (&pre)[8]) const {
        const int row0 = u.pm * BM + wr * 64 + fr, col0 = u.pn * 128 + wc * 32 + 8 * fq;
#pragma unroll
        for (int ai = 0; ai < 2; ++ai)
#pragma unroll
            for (int m = 0; m < 4; ++m) {
                const int row = row0 + ai * HALF + m * 16; const float rs = rsqrtf(pre[ai * 4 + m] * (1.f / 1024.f) + 1e-6f);
                f32x2 o[4];
#pragma unroll
                for (int n = 0; n < 2; ++n)
#pragma unroll
                    for (int jp = 0; jp < 2; ++jp) { const f32x2 ga = {acc[ai][0][m][n][2 * jp], acc[ai][0][m][n][2 * jp + 1]}, ua = {acc[ai][1][m][n][2 * jp], acc[ai][1][m][n][2 * jp + 1]};
                        const f32x2 g = ga * rs, t = ga * (rs * -1.44269504f), uu = ua * rs;
                        f32x2 e; e.x = __builtin_amdgcn_exp2f(t.x); e.y = __builtin_amdgcn_exp2f(t.y);
                        const f32x2 d = e + 1.0f; f32x2 r; r.x = __builtin_amdgcn_rcpf(d.x); r.y = __builtin_amdgcn_rcpf(d.y);
                        o[2 * n + jp] = (g * r) * uu; }
                u32x4 w; w.x = cvt_pk_bf16(o[0].x, o[0].y); w.y = cvt_pk_bf16(o[1].x, o[1].y); w.z = cvt_pk_bf16(o[2].x, o[2].y); w.w = cvt_pk_bf16(o[3].x, o[3].y);
                *(u32x4*)(U + (size_t)row * 2816 + col0) = w; }
    }
};
struct EpiResid {
    static constexpr bool PERM = true, AFTER_DRAIN = false; static constexpr int KSEG = 0; static constexpr bool PRE = false;
    bf16_t* X; float alpha; float* rq; float* yp; float* ys;
    __device__ __forceinline__ void operator()(const f32x4 (&acc)[2][2][4][2], const Unit& u, int wr, int wc, int fr, int fq) const {
        const int row0 = u.pm * BM + wr * 64 + fr, col0 = u.pn * BM + wc * 32 + 8 * fq;
#pragma unroll
        for (int ai = 0; ai < 2; ++ai)
#pragma unroll
            for (int m = 0; m < 4; ++m) {
                const int row = row0 + ai * HALF + m * 16; float ss = 0.f;
#pragma unroll
                for (int bj = 0; bj < 2; ++bj) {
                    const int col = col0 + bj * HALF; bf16_t* xp = X + (size_t)row * 1024 + col;
                    const u32x4 ow = *(const u32x4*)xp; float v[8];
                    { f32x2 p0 = {__uint_as_float(ow.x << 16), __uint_as_float(ow.x & 0xffff0000u)}, p1 = {__uint_as_float(ow.y << 16), __uint_as_float(ow.y & 0xffff0000u)},
                            p2 = {__uint_as_float(ow.z << 16), __uint_as_float(ow.z & 0xffff0000u)}, p3 = {__uint_as_float(ow.w << 16), __uint_as_float(ow.w & 0xffff0000u)};
                      const f32x4 a0 = acc[ai][bj][m][0], a1 = acc[ai][bj][m][1];
                      p0 = p0 + (f32x2){a0[0], a0[1]} * alpha; p1 = p1 + (f32x2){a0[2], a0[3]} * alpha; p2 = p2 + (f32x2){a1[0], a1[1]} * alpha; p3 = p3 + (f32x2){a1[2], a1[3]} * alpha;
                      const f32x2 q = (p0 * p0 + p1 * p1) + (p2 * p2 + p3 * p3); ss += q.x + q.y;
                      v[0] = p0.x; v[1] = p0.y; v[2] = p1.x; v[3] = p1.y; v[4] = p2.x; v[5] = p2.y; v[6] = p3.x; v[7] = p3.y; }
                    if (yp) {
                        float* dst = row < 65536 ? yp + (size_t)row * 1024 + col : (row < 65664 ? ys + (size_t)(row - 65536) * 1024 + col : nullptr);
                        if (dst) { *(f32x4*)dst = (f32x4){v[0], v[1], v[2], v[3]}; *(f32x4*)(dst + 4) = (f32x4){v[4], v[5], v[6], v[7]}; }
                    } else {
                        u32x4 w; w.x = cvt_pk_bf16(v[0], v[1]); w.y = cvt_pk_bf16(v[2], v[3]); w.z = cvt_pk_bf16(v[4], v[5]); w.w = cvt_pk_bf16(v[6], v[7]);
                        *(u32x4*)xp = w; }
                }
                ss += __shfl_xor(ss, 16); ss += __shfl_xor(ss, 32);
                if (fq == 0) unsafeAtomicAdd(rq + row, ss);
            }
    }
};

struct EpiResidKS {
    static constexpr bool PERM = true, AFTER_DRAIN = false; static constexpr int KSEG = 8; static constexpr bool PRE = false;
    bf16_t* X; float* rq; const float* rs2;
    __device__ __forceinline__ void kseg(f32x4 (&acc)[2][2][4][2], const Unit& u, int t, int wr, int fr) const {
        const int row0 = u.pm * BM + wr * 64 + fr;
#pragma unroll
        for (int ai = 0; ai < 2; ++ai)
#pragma unroll
            for (int m = 0; m < 4; ++m) { const int row = row0 + ai * HALF + m * 16; const f32x2 sv = *(const f32x2*)(rs2 + 2 * row);
                const float f = (t == KSEG) ? __builtin_amdgcn_rcpf(sv.x) : sv.x * __builtin_amdgcn_rcpf(sv.y);
#pragma unroll
                for (int bj = 0; bj < 2; ++bj)
#pragma unroll
                    for (int n = 0; n < 2; ++n) acc[ai][bj][m][n] = acc[ai][bj][m][n] * f; }
    }
    __device__ __forceinline__ void operator()(const f32x4 (&acc)[2][2][4][2], const Unit& u, int wr, int wc, int fr, int fq) const {
        const int row0 = u.pm * BM + wr * 64 + fr, col0 = u.pn * BM + wc * 32 + 8 * fq;
#pragma unroll
        for (int ai = 0; ai < 2; ++ai)
#pragma unroll
            for (int m = 0; m < 4; ++m) {
                const int row = row0 + ai * HALF + m * 16; float ss = 0.f; const float alpha = rs2[2 * (size_t)row + 1];
#pragma unroll
                for (int bj = 0; bj < 2; ++bj) {
                    const int col = col0 + bj * HALF; bf16_t* xp = X + (size_t)row * 1024 + col;
                    const u32x4 ow = *(const u32x4*)xp; float v[8];
                    { f32x2 p0 = {__uint_as_float(ow.x << 16), __uint_as_float(ow.x & 0xffff0000u)}, p1 = {__uint_as_float(ow.y << 16), __uint_as_float(ow.y & 0xffff0000u)},
                            p2 = {__uint_as_float(ow.z << 16), __uint_as_float(ow.z & 0xffff0000u)}, p3 = {__uint_as_float(ow.w << 16), __uint_as_float(ow.w & 0xffff0000u)};
                      const f32x4 a0 = acc[ai][bj][m][0], a1 = acc[ai][bj][m][1];
                      p0 = p0 + (f32x2){a0[0], a0[1]} * alpha; p1 = p1 + (f32x2){a0[2], a0[3]} * alpha; p2 = p2 + (f32x2){a1[0], a1[1]} * alpha; p3 = p3 + (f32x2){a1[2], a1[3]} * alpha;
                      const f32x2 q = (p0 * p0 + p1 * p1) + (p2 * p2 + p3 * p3); ss += q.x + q.y;
                      v[0] = p0.x; v[1] = p0.y; v[2] = p1.x; v[3] = p1.y; v[4] = p2.x; v[5] = p2.y; v[6] = p3.x; v[7] = p3.y; }
                    u32x4 w; w.x = cvt_pk_bf16(v[0], v[1]); w.y = cvt_pk_bf16(v[2], v[3]); w.z = cvt_pk_bf16(v[4], v[5]); w.w = cvt_pk_bf16(v[6], v[7]);
                    *(u32x4*)xp = w;
                }
                ss += __shfl_xor(ss, 16); ss += __shfl_xor(ss, 32);
                if (fq == 0) unsafeAtomicAdd(rq + row, ss);
            }
    }
};
struct EpiScale {
    static constexpr bool PERM = true, AFTER_DRAIN = false; static constexpr int KSEG = 0; static constexpr bool PRE = false;
    bf16_t* O; int ldc; const float* rq; float scale;
    __device__ __forceinline__ void operator()(const f32x4 (&acc)[2][2][4][2], const Unit& u, int wr, int wc, int fr, int fq) const {
        const int row0 = u.pm * BM + wr * 64 + fr, col0 = u.pn * BM + wc * 32 + 8 * fq;
#pragma unroll
        for (int ai = 0; ai < 2; ++ai)
#pragma unroll
            for (int m = 0; m < 4; ++m) {
                const int row = row0 + ai * HALF + m * 16; const float rs = rsqrtf(rq[row] * (1.f / 1024.f) + 1e-6f) * scale;
#pragma unroll
                for (int bj = 0; bj < 2; ++bj) { const f32x4 v0 = acc[ai][bj][m][0] * rs, v1 = acc[ai][bj][m][1] * rs;
                    u32x4 w; w.x = cvt_pk_bf16(v0[0], v0[1]); w.y = cvt_pk_bf16(v0[2], v0[3]); w.z = cvt_pk_bf16(v1[0], v1[1]); w.w = cvt_pk_bf16(v1[2], v1[3]);
                    *(u32x4*)(O + (size_t)row * ldc + col0 + bj * HALF) = w; } }
    }
};
struct EpiMemKV {
    static constexpr bool PERM = true, AFTER_DRAIN = false; static constexpr int KSEG = 0; static constexpr bool PRE = false;
    const float* rmem; float* mkp; float* mvp; bf16_t* mkb; bf16_t* mvb;
    __device__ __forceinline__ void operator()(const f32x4 (&acc)[2][2][4][2], const Unit& u, int wr, int wc, int fr, int fq) const {
        const int row0 = u.pm * BM + wr * 64 + fr; const bool isv = u.pn >= 4; const int col0 = (u.pn & 3) * BM + wc * 32 + 8 * fq;
        float* of = isv ? mvp : mkp; bf16_t* ob = isv ? mvb : mkb;
#pragma unroll
        for (int ai = 0; ai < 2; ++ai)
#pragma unroll
            for (int m = 0; m < 4; ++m) {
                const int row = row0 + ai * HALF + m * 16; const float rs = rmem[row];
#pragma unroll
                for (int bj = 0; bj < 2; ++bj) { const f32x4 v0 = acc[ai][bj][m][0] * rs, v1 = acc[ai][bj][m][1] * rs; const size_t o = (size_t)row * 1024 + col0 + bj * HALF;
                    *(f32x4*)(of + o) = v0; *(f32x4*)(of + o + 4) = v1;
                    u32x4 w; w.x = cvt_pk_bf16(v0[0], v0[1]); w.y = cvt_pk_bf16(v0[2], v0[3]); w.z = cvt_pk_bf16(v1[0], v1[1]); w.w = cvt_pk_bf16(v1[2], v1[3]);
                    *(u32x4*)(ob + o) = w; } }
    }
};
struct EpiInProj {
    static constexpr bool PERM = true, AFTER_DRAIN = false; static constexpr int KSEG = 0; static constexpr bool PRE = false;
    const float* rq; bf16_t* qb; bf16_t* kb; bf16_t* vb; bf16_t* zg; bf16_t* xbc; float* dtb; const float* dt_bias;
    float* wkp; float* wvp; float* cvp; float* wks; float* wvs; float* cvs;
    __device__ __forceinline__ void operator()(const f32x4 (&acc)[2][2][4][2], const Unit& u, int wr, int wc, int fr, int fq) const {
        const int row0 = u.pm * BM + wr * 64 + fr, c0 = wc * 32 + 8 * fq, pn = u.pn;
#pragma unroll
        for (int ai = 0; ai < 2; ++ai)
#pragma unroll
            for (int m = 0; m < 4; ++m) {
                const int row = row0 + ai * HALF + m * 16; const float rs = rsqrtf(rq[row] * (1.f / 1024.f) + 1e-6f);
#pragma unroll
                for (int bj = 0; bj < 2; ++bj) {
                    const int c8 = c0 + bj * HALF; f32x4 v0 = acc[ai][bj][m][0] * rs, v1 = acc[ai][bj][m][1] * rs;
                    if (pn < 2) {
                        v0 = v0 * 0.180336880f; v1 = v1 * 0.180336880f;
                        u32x4 w; w.x = cvt_pk_bf16(v0[0], v0[1]); w.y = cvt_pk_bf16(v0[2], v0[3]); w.z = cvt_pk_bf16(v1[0], v1[1]); w.w = cvt_pk_bf16(v1[2], v1[3]);
                        *(u32x4*)(qb + (size_t)row * 512 + pn * 256 + c8) = w;
                    } else if (pn < 6) {
                        const bool isv = pn >= 4; const int col = (pn & 1) * 256 + c8;
                        u32x4 w; w.x = cvt_pk_bf16(v0[0], v0[1]); w.y = cvt_pk_bf16(v0[2], v0[3]); w.z = cvt_pk_bf16(v1[0], v1[1]); w.w = cvt_pk_bf16(v1[2], v1[3]);
                        *(u32x4*)((isv ? vb : kb) + (size_t)row * 512 + col) = w;
                        float* dst = row < 65536 ? (isv ? wvp : wkp) + (size_t)row * 512 + col : (row < 65664 ? (isv ? wvs : wks) + (size_t)(row - 65536) * 512 + col : nullptr);
                        if (dst) { *(f32x4*)dst = v0; *(f32x4*)(dst + 4) = v1; }
                    } else if (pn < 10) {
                        float o[8];
#pragma unroll
                        for (int j = 0; j < 4; ++j) { o[j] = v0[j] * __builtin_amdgcn_rcpf(1.f + __expf(-v0[j])); o[4 + j] = v1[j] * __builtin_amdgcn_rcpf(1.f + __expf(-v1[j])); }
                        u32x4 w; w.x = cvt_pk_bf16(o[0], o[1]); w.y = cvt_pk_bf16(o[2], o[3]); w.z = cvt_pk_bf16(o[4], o[5]); w.w = cvt_pk_bf16(o[6], o[7]);
                        *(u32x4*)(zg + (size_t)row * 1024 + (pn - 6) * 256 + c8) = w;
                    } else if (pn < 16) {
                        const int col = (pn - 10) * 256 + c8;
                        u32x4 w; w.x = cvt_pk_bf16(v0[0], v0[1]); w.y = cvt_pk_bf16(v0[2], v0[3]); w.z = cvt_pk_bf16(v1[0], v1[1]); w.w = cvt_pk_bf16(v1[2], v1[3]);
                        *(u32x4*)(xbc + (size_t)row * 1536 + col) = w;
                        float* dst = nullptr;
                        if (row < 65536) { const int t = row & 2047; if (t >= 2045) dst = cvp + ((size_t)(row >> 11) * 3 + (t - 2045)) * 1536 + col; }
                        else if (row < 65664) dst = cvs + ((size_t)(row - 65536) * 3 + 2) * 1536 + col;
                        if (dst) { *(f32x4*)dst = v0; *(f32x4*)(dst + 4) = v1; }
                    } else {
                        if (c8 < 16) {
                            float o[8];
#pragma unroll
                            for (int j = 0; j < 8; ++j) { const float x = (j < 4 ? v0[j & 3] : v1[j & 3]) + dt_bias[c8 + j]; o[j] = fmaxf(x, 0.f) + log1pf(__expf(-fabsf(x))); }
                            float* dst = dtb + (size_t)row * 16 + c8; *(f32x4*)dst = (f32x4){o[0], o[1], o[2], o[3]}; *(f32x4*)(dst + 4) = (f32x4){o[4], o[5], o[6], o[7]};
                        }
                    }
                }
            }
    }
};

struct SplitOrder {
    int nN, KS, G, c, kbytes;
    __host__ __device__ void init(int N, int KS_, int kper, int G_, int c_) { nN = N / BM; KS = KS_; G = G_; c = c_; kbytes = kper * 2; }
    __host__ __device__ bool next(int i, Unit& u) const { const int L = i * G + c; if (L >= nN * KS) return false; u.pm = 256; u.pn = L % nN; u.ks = L / nN; u.koff = u.ks * kbytes; return true; }
    __device__ __forceinline__ void a_ready(const Unit&) const {}
    __device__ __forceinline__ void done(const Unit&) const {}
};
template <class Inner> struct EpiSplit {
    static constexpr bool PERM = Inner::PERM, AFTER_DRAIN = false; static constexpr int KSEG = 0; static constexpr bool PRE = false;
    Inner in; float* slab; unsigned* tick; int KS;
    __device__ __forceinline__ void operator()(f32x4 (&acc)[2][2][4][2], const Unit& u, int wr, int wc, int fr, int fq) const {
        const int wave = wr * 4 + wc, lane = fr + 16 * fq;
        const __amdgpu_buffer_rsrc_t rs = __builtin_amdgcn_make_buffer_rsrc((void*)slab, 0, 0x7fffffff, 0x00020000);
        const int base = (((u.pn * KS + u.ks) * 8 + wave) * 16) * 1024 + lane * 16;
#pragma unroll
        for (int bj = 0; bj < 2; ++bj)
#pragma unroll
            for (int m = 0; m < 4; ++m)
#pragma unroll
                for (int n = 0; n < 2; ++n) __builtin_amdgcn_raw_buffer_store_b128(__builtin_bit_cast(u32x4, acc[0][bj][m][n]), rs, base + ((bj * 4 + m) * 2 + n) * 1024, 0, 16);
        asm volatile("s_waitcnt vmcnt(0)" ::: "memory");
        unsigned old = 0u;
        if (lane == 0) old = __hip_atomic_fetch_add(tick + (u.pn * 8 + wave) * 16, 1u, __ATOMIC_RELAXED, __HIP_MEMORY_SCOPE_AGENT);
        old = (unsigned)__builtin_amdgcn_readfirstlane((int)old);
        if (old == (unsigned)(KS - 1)) {
            __builtin_amdgcn_fence(__ATOMIC_ACQUIRE, "agent");
            asm volatile("s_waitcnt vmcnt(0)" ::: "memory");
#pragma unroll 1
            for (int s2 = 0; s2 < KS; ++s2) { if (s2 == u.ks) continue;
                const int ob = (((u.pn * KS + s2) * 8 + wave) * 16) * 1024 + lane * 16;
#pragma unroll
                for (int bj = 0; bj < 2; ++bj)
#pragma unroll
                    for (int m = 0; m < 4; ++m)
#pragma unroll
                        for (int n = 0; n < 2; ++n) acc[0][bj][m][n] += __builtin_bit_cast(f32x4, __builtin_amdgcn_raw_buffer_load_b128(rs, ob + ((bj * 4 + m) * 2 + n) * 1024, 0, 16)); }
#pragma unroll
            for (int bj = 0; bj < 2; ++bj)
#pragma unroll
                for (int m = 0; m < 4; ++m)
#pragma unroll
                    for (int n = 0; n < 2; ++n) acc[1][bj][m][n] = (f32x4){0.f, 0.f, 0.f, 0.f};
            int fr2 = fr, fq2 = fq; asm volatile("" : "+v"(fr2), "+v"(fq2));
            if constexpr (Inner::PRE) { float pre[8]; in.preload(u, wr, fr2, pre); in(acc, u, wr, wc, fr2, fq2, pre); } else in(acc, u, wr, wc, fr2, fq2);
        }
    }
};
}
#define PG8_SP2 true
#define PG8_ALIGN true

#define XB_TMO      128
#define XB_XCNT(j)  (256  + 64 * (j))
#define XB_XSUB(j)  (1280 + 64 * (j))
#define XB_XGEN(j)  (2304 + 64 * (j))
#define XB_TOP      3328
#define XB_TOPGEN   3392
#define XCD_BAR_WORDS 3456
#define XB_SPIN_CAP (1u << 18)

__device__ __forceinline__ unsigned xb_ld(unsigned* p)              { return __hip_atomic_load(p, __ATOMIC_RELAXED, __HIP_MEMORY_SCOPE_AGENT); }
__device__ __forceinline__ unsigned xb_add(unsigned* p, unsigned v) { return __hip_atomic_fetch_add(p, v, __ATOMIC_RELAXED, __HIP_MEMORY_SCOPE_AGENT); }
__device__ __forceinline__ unsigned xb_xcc_id() { return (unsigned)__builtin_amdgcn_s_getreg((3 << 11) | 20) & 0xFu; }
#define XB_SPIN(cond, bar) do { unsigned _sp = 0; while (cond) { __builtin_amdgcn_s_sleep(1); \
    if ((++_sp & 255u) == 0u) { if (xb_ld(&(bar)[XB_TMO])) break; if (_sp > XB_SPIN_CAP) { atomicAdd(&(bar)[XB_TMO], 1u); break; } } } } while (0)

struct XcdBarrier {
    unsigned* bar; unsigned x;
    volatile LAS unsigned* st;
};

__device__ __forceinline__ XcdBarrier xcd_barrier_post(unsigned* bar, volatile LAS unsigned* st, const bool leader) {
    XcdBarrier b; b.bar = bar; b.x = xb_xcc_id(); b.st = st;
    if (leader) (void)xb_add(&bar[XB_XCNT(b.x)], 1u);
    return b;
}
__device__ __forceinline__ void xcd_barrier_complete(unsigned* bar, unsigned x, unsigned& nloc, unsigned& nx) {
    const unsigned G = gridDim.x * gridDim.y * gridDim.z;
    unsigned sum, cnt, mine, sp = 0u;
    for (;;) {
        sum = 0u; cnt = 0u; mine = 0u;
#pragma unroll
        for (unsigned j = 0; j < 16; ++j) { const unsigned c = xb_ld(&bar[XB_XCNT(j)]); sum += c; cnt += (c > 0u) ? 1u : 0u; mine = (j == x) ? c : mine; }
        if (sum == G) break;
        __builtin_amdgcn_s_sleep(1);
        if ((++sp & 255u) == 0u) { if (xb_ld(&bar[XB_TMO])) break; if (sp > XB_SPIN_CAP) { atomicAdd(&bar[XB_TMO], 1u); break; } }
    }
    nloc = mine > 0u ? mine : 1u; nx = cnt > 0u ? cnt : 1u;
}

__device__ __forceinline__ void xcd_barrier(const XcdBarrier& b, const bool leader) {
    asm volatile("s_waitcnt vmcnt(0)" ::: "memory");
    __syncthreads();
    if (leader) {
        unsigned* bar = b.bar;
        __builtin_amdgcn_s_waitcnt(0);
        unsigned nloc = b.st[0], nx = b.st[1];
        if (nloc == 0u) { xcd_barrier_complete(bar, b.x, nloc, nx); b.st[0] = nloc; b.st[1] = nx; }
        const unsigned old = xb_add(&bar[XB_XSUB(b.x)], 1u);
        const unsigned gen = old / nloc;
        if (old + 1u == (gen + 1u) * nloc) {
            __builtin_amdgcn_fence(__ATOMIC_RELEASE, "agent");
            asm volatile("s_waitcnt vmcnt(0)" ::: "memory");
            const unsigned og = xb_add(&bar[XB_TOP], 1u);
            const unsigned tg = og / nx;
            if (og + 1u == (tg + 1u) * nx) xb_add(&bar[XB_TOPGEN], 1u);
            else XB_SPIN(xb_ld(&bar[XB_TOPGEN]) == tg, bar);
            __builtin_amdgcn_fence(__ATOMIC_ACQUIRE, "agent");
            xb_add(&bar[XB_XGEN(b.x)], 1u);
            asm volatile("s_waitcnt vmcnt(0)" ::: "memory");
        } else {
            XB_SPIN(xb_ld(&bar[XB_XGEN(b.x)]) == gen, bar);
            __builtin_amdgcn_fence(__ATOMIC_ACQUIRE, "agent");
            asm volatile("s_waitcnt vmcnt(0)" ::: "memory");
        }
    }
    __syncthreads();
}

struct Args { const float* in[34]; float* out; unsigned char* ws; int ph_lo, ph_hi, li, pad; };
struct Frame {
    LAS unsigned char* lds; volatile LAS unsigned* MISC; gu32* ctl;
    int tid, lane, wave, vcu, G;
    float* out; unsigned char* ws;
};
#define WSP(T, off) ((T*)(F.ws + (off)))
__device__ __forceinline__ void refresh(Frame& F) { int l; asm volatile("v_mbcnt_lo_u32_b32 %0, -1, 0\n\tv_mbcnt_hi_u32_b32 %0, -1, %0" : "=v"(l)); F.lane = l; F.tid = F.wave * 64 + l; }

__device__ __forceinline__ void tr_item(const float* W, int ldsrc, int ncols, int k0, int n0, bf16* WT, int K, int drow0, const float* gain, int gofs, LAS float* scr, int lane) {
    const int nn = n0 + (lane & 31); const bool okc = nn < ncols; const int nc = okc ? nn : ncols - 1;
    const float* gp = gain ? gain : W;
#pragma unroll
    for (int ib = 0; ib < 4; ++ib) { float v[8], gv[8];
#pragma unroll
        for (int j = 0; j < 8; ++j) { const int kk = 2 * (8 * ib + j) + (lane >> 5), k = k0 + kk; v[j] = __builtin_nontemporal_load(W + (size_t)k * ldsrc + nc); gv[j] = gp[max(k - gofs, 0)]; }
#pragma unroll
        for (int j = 0; j < 8; ++j) { const int kk = 2 * (8 * ib + j) + (lane >> 5), k = k0 + kk; float x = okc ? v[j] : 0.f; if (gain && k >= gofs) x *= gv[j]; scr[kk * 33 + (lane & 31)] = x; } }
    LDS_WAIT(); asm volatile("" ::: "memory");
    const int c = lane & 7;
#pragma unroll
    for (int j = 0; j < 4; ++j) { const int n = (lane >> 3) + 8 * j; const LAS float* s = scr + (8 * c) * 33 + n;
        v4u o; o.x = pk2(s[0 * 33], s[1 * 33]); o.y = pk2(s[2 * 33], s[3 * 33]); o.z = pk2(s[4 * 33], s[5 * 33]); o.w = pk2(s[6 * 33], s[7 * 33]);
        *(GAS v4u*)(WT + (size_t)(drow0 + n) * K + k0 + 8 * c) = o; }
    LDS_WAIT(); asm volatile("" ::: "memory");
}
__device__ __forceinline__ bool tr_job(int& r, const float* W, int K, int N, bf16* WT, int mode, int roff, const float* gain, int gofs, LAS float* scr, int lane) {
    const int nblk = (N + 31) / 32, items = (K / 64) * nblk;
    if (r >= items) { r -= items; return false; }
    const int kb = r / nblk, nb = r % nblk, n0 = nb * 32;
    const int drow0 = roff + (mode == 0 ? n0 : 256 * (n0 >> 7) + 128 * (mode - 1) + (n0 & 127));
    tr_item(W, N, N, kb * 64, n0, WT, K, drow0, gain, gofs, scr, lane);
    return true;
}
__device__ __forceinline__ void p0_prologue(Frame& F, const Args& A) {
    LAS float* scr = (LAS float*)(F.lds + RING_OFF + F.wave * 16384);
    const int gw = F.vcu * NWAVES + F.wave, NGW = F.G * NWAVES, lane = F.lane;
    constexpr int I_GU = 16 * 88, I_D = 44 * 32, I_IN = 16 * 129, I_OUT = 24 * 32, I_SQ = 16 * 32;
    constexpr int NITEMS = 4 * I_GU + 2 * I_D + I_IN + I_OUT + 4 * I_SQ;
    for (int it = gw; it < NITEMS; it += NGW) {
        int r = it;
        if (tr_job(r, A.in[11], 1024, 2816, WSP(bf16, WS_W1GU), 1, 0, A.in[10], 0, scr, lane)) continue;
        if (tr_job(r, A.in[12], 1024, 2816, WSP(bf16, WS_W1GU), 2, 0, A.in[10], 0, scr, lane)) continue;
        if (tr_job(r, A.in[13], 2816, 1024, WSP(bf16, WS_W1D), 0, 0, nullptr, 0, scr, lane)) continue;
        if (tr_job(r, A.in[15], 1024, 4112, WSP(bf16, WS_WIN), 0, 0, A.in[14], 0, scr, lane)) continue;
        if (tr_job(r, A.in[22], 1536, 1024, WSP(bf16, WS_WOUT), 0, 0, A.in[21], 512, scr, lane)) continue;
        if (tr_job(r, A.in[27], 1024, 1024, WSP(bf16, WS_WCQ), 0, 0, A.in[26], 0, scr, lane)) continue;
        if (tr_job(r, A.in[28], 1024, 1024, WSP(bf16, WS_WCO), 0, 0, nullptr, 0, scr, lane)) continue;
        if (tr_job(r, A.in[24], 1024, 1024, WSP(bf16, WS_WMEM), 0, 0, A.in[23], 0, scr, lane)) continue;
        if (tr_job(r, A.in[25], 1024, 1024, WSP(bf16, WS_WMEM), 0, 1024, A.in[23], 0, scr, lane)) continue;
        if (tr_job(r, A.in[30], 1024, 2816, WSP(bf16, WS_W2GU), 1, 0, A.in[29], 0, scr, lane)) continue;
        if (tr_job(r, A.in[31], 1024, 2816, WSP(bf16, WS_W2GU), 2, 0, A.in[29], 0, scr, lane)) continue;
        tr_job(r, A.in[32], 2816, 1024, WSP(bf16, WS_W2D), 0, 0, nullptr, 0, scr, lane);
    }
    { GAS v4u* z = (GAS v4u*)(WSP(bf16, WS_WIN) + (size_t)4128 * 1024); const int n16 = (4352 - 4128) * 1024 / 8;
      for (int i = gw * 64 + lane; i < n16; i += NGW * 64) z[i] = (v4u){0u, 0u, 0u, 0u}; }
    for (int m0 = gw; m0 < MT; m0 += 4 * NGW) {
        f32x4 v[4][4];
#pragma unroll
        for (int q = 0; q < 4; ++q) { const int m = m0 + q * NGW, mc = min(m, MROWS - 1);
            const float* src = mc < TP ? A.in[0] + (size_t)mc * 1024 : A.in[1] + (size_t)(mc - TP) * 1024; const GAS f32x4* xr = (const GAS f32x4*)src + lane;
#pragma unroll
            for (int j = 0; j < 4; ++j) v[q][j] = __builtin_nontemporal_load(xr + 64 * j); }
#pragma unroll
        for (int q = 0; q < 4; ++q) { const int m = m0 + q * NGW; const float keep = m < MROWS ? 1.f : 0.f;
            if (m < MT) { float sq = 0.f;
#pragma unroll
            for (int j = 0; j < 4; ++j) { v[q][j] = v[q][j] * keep; sq += (v[q][j].x * v[q][j].x + v[q][j].y * v[q][j].y) + (v[q][j].z * v[q][j].z + v[q][j].w * v[q][j].w); }
            sq = wave_sum(sq);
            if (lane == 0) WSP(float, WS_RQ0)[m] = sq;
            GAS v2u* o8 = (GAS v2u*)(WSP(bf16, WS_XB) + (size_t)m * 1024) + lane;
#pragma unroll
            for (int j = 0; j < 4; ++j) o8[64 * j] = (v2u){pk2(v[q][j].x, v[q][j].y), pk2(v[q][j].z, v[q][j].w)}; } }
    }
    for (int m0 = gw; m0 < NB * NMEM; m0 += 4 * NGW) {
        f32x4 v[4][4];
#pragma unroll
        for (int q = 0; q < 4; ++q) { const int mc = min(m0 + q * NGW, NB * NMEM - 1); const GAS f32x4* xr = (const GAS f32x4*)(A.in[8] + (size_t)mc * 1024) + lane;
#pragma unroll
            for (int j = 0; j < 4; ++j) v[q][j] = __builtin_nontemporal_load(xr + 64 * j); }
#pragma unroll
        for (int q = 0; q < 4; ++q) { const int m = m0 + q * NGW; if (m < NB * NMEM) { float sq = 0.f;
#pragma unroll
            for (int j = 0; j < 4; ++j) sq += (v[q][j].x * v[q][j].x + v[q][j].y * v[q][j].y) + (v[q][j].z * v[q][j].z + v[q][j].w * v[q][j].w);
            sq = wave_sum(sq);
            if (lane == 0) WSP(float, WS_RMEM)[m] = rsqrtf(sq * (1.f / 1024.f) + EPS);
            GAS v2u* o8 = (GAS v2u*)(WSP(bf16, WS_MEMB) + (size_t)m * 1024) + lane;
#pragma unroll
            for (int j = 0; j < 4; ++j) o8[64 * j] = (v2u){pk2(v[q][j].x, v[q][j].y), pk2(v[q][j].z, v[q][j].w)}; } }
    }
    for (int i = gw * 64 + lane; i < TS * 2 * DXBC; i += NGW * 64) { const int b = i / (2 * DXBC), r = i % (2 * DXBC); F.out[O_CVS + (size_t)b * 3 * DXBC + r] = A.in[4][(size_t)b * 3 * DXBC + DXBC + r]; }
}

__device__ __forceinline__ int t5_bucket(int d) {
    if (d < 16) return d;
    int b = 16;
    b += d >= 22; b += d >= 30; b += d >= 40; b += d >= 54; b += d >= 73; b += d >= 99; b += d >= 134; b += d >= 182; b += d >= 246; b += d >= 332; b += d >= 450; b += d >= 609; b += d >= 825; b += d >= 1117; b += d >= 1513;
    return b;
}

typedef float f32x16 __attribute__((ext_vector_type(16)));
typedef short s16x4 __attribute__((ext_vector_type(4)));
typedef short v4i16_t __attribute__((ext_vector_type(4)));
typedef float f32x2_t __attribute__((ext_vector_type(2)));
typedef __bf16 bf16x2_t __attribute__((ext_vector_type(2)));
using pg8::bf16x8; using pg8::f32x2;
#define MFMA32(a, b, c) __builtin_amdgcn_mfma_f32_32x32x16_bf16((a), (b), (c), 0, 0, 0)
__device__ __forceinline__ unsigned cvtpk(float lo, float hi) { f32x2_t v = {lo, hi}; bf16x2_t b = __builtin_convertvector(v, bf16x2_t); return __builtin_bit_cast(unsigned, b); }
__device__ __forceinline__ bf16x8 pack8(float a0, float a1, float a2, float a3, float a4, float a5, float a6, float a7) { v4u w; w.x = cvtpk(a0, a1); w.y = cvtpk(a2, a3); w.z = cvtpk(a4, a5); w.w = cvtpk(a6, a7); return __builtin_bit_cast(bf16x8, w); }
#define PACK_STEP(x, s) pack8((x)[8 * (s)], (x)[8 * (s) + 1], (x)[8 * (s) + 2], (x)[8 * (s) + 3], (x)[8 * (s) + 4], (x)[8 * (s) + 5], (x)[8 * (s) + 6], (x)[8 * (s) + 7])
__device__ __forceinline__ s16x4 tr_read(const LAS unsigned char* p) { return __builtin_bit_cast(s16x4, __builtin_amdgcn_ds_read_tr16_b64_v4i16((LAS v4i16_t*)p)); }
__device__ __forceinline__ f32x16 zero16() { f32x16 z;
#pragma unroll
    for (int i = 0; i < 16; ++i) z[i] = 0.f; return z; }

constexpr size_t WS_PX = WS_U + 16 * MiB;
__device__ __forceinline__ void cross_mfma_phase(Frame& F) {
    const bf16* qc = WSP(bf16, WS_QC); const bf16* mkb = WSP(bf16, WS_MKB); const bf16* mvb = WSP(bf16, WS_MVB); bf16* oc = WSP(bf16, WS_OC); v4u* px = WSP(v4u, WS_PX);
    LAS unsigned char* L = F.lds + RING_OFF;
    for (int su = F.vcu; su < NB * 4 * 2; su += F.G) {
        const int bh = su >> 1, b = bh >> 2, hx = bh & 3, half = su & 1;
        __syncthreads();
#pragma unroll 1
        for (int fb = 0; fb < 2; ++fb) { int ft = F.tid; asm volatile("" : "+v"(ft)); v4u fx[8];
#pragma unroll
          for (int i = 0; i < 8; ++i) { const int c = ft + 512 * (8 * fb + i), key = c >> 5, ch = c & 31; fx[i] = *(const GAS v4u*)(mkb + ((size_t)(b * 256 + key)) * 1024 + hx * 256 + ch * 8); }
#pragma unroll
          for (int i = 0; i < 8; ++i) { const int c = ft + 512 * (8 * fb + i), key = c >> 5, ch = c & 31; *(LAS v4u*)(L + key * 512 + ((ch ^ (key & 15)) << 4)) = fx[i]; } }
        __syncthreads();
        for (int qb = 0; qb < 4; ++qb) {
            int lane = F.lane; asm volatile("" : "+v"(lane));
            const int r = lane & 31, h = lane >> 5;
            const int m0 = b * SEQ + (half * 4 + qb) * 256 + F.wave * 32;
            bf16x8 qf[16];
            { const bf16* qrow = qc + (size_t)(m0 + r) * 1024 + hx * 256 + 8 * h;
#pragma unroll
              for (int ks = 0; ks < 16; ++ks) qf[ks] = *(const GAS bf16x8*)(qrow + 16 * ks); }
            asm volatile("" : "+v"(qf[0]), "+v"(qf[1]), "+v"(qf[2]), "+v"(qf[3]), "+v"(qf[4]), "+v"(qf[5]), "+v"(qf[6]), "+v"(qf[7]));
            asm volatile("" : "+v"(qf[8]), "+v"(qf[9]), "+v"(qf[10]), "+v"(qf[11]), "+v"(qf[12]), "+v"(qf[13]), "+v"(qf[14]), "+v"(qf[15]));
            f32x16 S[8];
#pragma unroll
            for (int kt = 0; kt < 8; ++kt) S[kt] = zero16();
            const LAS unsigned char* kb0 = L + r * 512;
            bf16x8 ka[4], kb_[4];
            { const int off = ((h ^ (r & 15)) << 4);
#pragma unroll
              for (int j = 0; j < 4; ++j) ka[j] = *(const LAS bf16x8*)(kb0 + j * 16384 + off); }
#pragma unroll
            for (int ks = 0; ks < 16; ++ks) { const int off = (((2 * ks + h) ^ (r & 15)) << 4), offn = (((2 * ks + 2 + h) ^ (r & 15)) << 4);
#pragma unroll
                for (int j = 0; j < 4; ++j) kb_[j] = *(const LAS bf16x8*)(kb0 + (4 + j) * 16384 + off);
                asm volatile("" : "+v"(ka[0]), "+v"(ka[1]), "+v"(ka[2]), "+v"(ka[3]));
#pragma unroll
                for (int j = 0; j < 4; ++j) S[j] = MFMA32(ka[j], qf[ks], S[j]);
                if (ks < 15) {
#pragma unroll
                    for (int j = 0; j < 4; ++j) ka[j] = *(const LAS bf16x8*)(kb0 + j * 16384 + offn); }
                asm volatile("" : "+v"(kb_[0]), "+v"(kb_[1]), "+v"(kb_[2]), "+v"(kb_[3]));
#pragma unroll
                for (int j = 0; j < 4; ++j) S[4 + j] = MFMA32(kb_[j], qf[ks], S[4 + j]);
            }
            float mx = -1e30f;
#pragma unroll
            for (int kt = 0; kt < 8; ++kt)
#pragma unroll
                for (int i = 0; i < 16; ++i) mx = fmaxf(mx, S[kt][i]);
            mx = fmaxf(mx, __shfl_xor(mx, 32));
            float sum = 0.f;
            { f32x2 s2v = {0.f, 0.f}; const float mxl = mx * 1.44269504f;
#pragma unroll
              for (int kt = 0; kt < 8; ++kt)
#pragma unroll
                for (int i2 = 0; i2 < 8; ++i2) { const f32x2 x = (f32x2){S[kt][2 * i2], S[kt][2 * i2 + 1]} * 1.44269504f - mxl; f32x2 e; e.x = __builtin_amdgcn_exp2f(x.x); e.y = __builtin_amdgcn_exp2f(x.y);
                    S[kt][2 * i2] = e.x; S[kt][2 * i2 + 1] = e.y; s2v = s2v + e; }
              sum = s2v.x + s2v.y; }
            sum += __shfl_xor(sum, 32);
            const float inv = 1.f / sum;
            v4u* pw = px + ((size_t)(m0 >> 5) * 4 + hx) * 1024 + lane;
#pragma unroll
            for (int kt = 0; kt < 8; ++kt)
#pragma unroll
                for (int s2 = 0; s2 < 2; ++s2) { v4u w; w.x = cvtpk(S[kt][8 * s2] * inv, S[kt][8 * s2 + 1] * inv); w.y = cvtpk(S[kt][8 * s2 + 2] * inv, S[kt][8 * s2 + 3] * inv);
                    w.z = cvtpk(S[kt][8 * s2 + 4] * inv, S[kt][8 * s2 + 5] * inv); w.w = cvtpk(S[kt][8 * s2 + 6] * inv, S[kt][8 * s2 + 7] * inv);
                    *(GAS v4u*)(pw + (kt * 2 + s2) * 64) = w; }
        }
        asm volatile("s_waitcnt vmcnt(0)" ::: "memory");
        __syncthreads();
#pragma unroll 1
        for (int fb = 0; fb < 2; ++fb) { int ft = F.tid; asm volatile("" : "+v"(ft)); v4u fx[8];
#pragma unroll
          for (int i = 0; i < 8; ++i) { const int c = ft + 512 * (8 * fb + i), key = c >> 5, c16 = c & 31; fx[i] = *(const GAS v4u*)(mvb + ((size_t)(b * 256 + key)) * 1024 + hx * 256 + c16 * 8); }
#pragma unroll
          for (int i = 0; i < 8; ++i) { const int c = ft + 512 * (8 * fb + i), key = c >> 5, c16 = c & 31; *(LAS v4u*)(L + key * 512 + ((c16 * 16) ^ ((key & 3) << 6))) = fx[i]; } }
        __syncthreads();
        for (int qb = 0; qb < 4; ++qb) {
            int lane = F.lane; asm volatile("" : "+v"(lane));
            const int r = lane & 31, h = lane >> 5, q4 = (lane & 15) >> 2, p4 = lane & 3, blk = (lane >> 4) & 1;
            const int m0 = b * SEQ + (half * 4 + qb) * 256 + F.wave * 32;
            const v4u* pw = px + ((size_t)(m0 >> 5) * 4 + hx) * 1024 + lane;
            bf16x8 P[8][2];
#pragma unroll
            for (int kt = 0; kt < 8; ++kt)
#pragma unroll
                for (int s2 = 0; s2 < 2; ++s2) P[kt][s2] = __builtin_bit_cast(bf16x8, *(const GAS v4u*)(pw + (kt * 2 + s2) * 64));
            asm volatile("" : "+v"(P[0][0]), "+v"(P[0][1]), "+v"(P[1][0]), "+v"(P[1][1]), "+v"(P[2][0]), "+v"(P[2][1]), "+v"(P[3][0]), "+v"(P[3][1]));
            asm volatile("" : "+v"(P[4][0]), "+v"(P[4][1]), "+v"(P[5][0]), "+v"(P[5][1]), "+v"(P[6][0]), "+v"(P[6][1]), "+v"(P[7][0]), "+v"(P[7][1]));
            f32x16 O[8];
#pragma unroll
            for (int dt = 0; dt < 8; ++dt) O[dt] = zero16();
            const LAS unsigned char* vb0 = L + (4 * h + q4) * 512 + 32 * blk + 8 * p4;
            bf16x8 va[4], vb_[4];
#define CX_VREAD(dst, step, d0) do { _Pragma("unroll") for (int j = 0; j < 4; ++j) { const LAS unsigned char* a0 = vb0 + (step) * 8192 + 64 * (((d0) + j) ^ q4); \
                const s16x4 lo = tr_read(a0), hi = tr_read(a0 + 8 * 512); dst[j] = __builtin_shufflevector(lo, hi, 0, 1, 2, 3, 4, 5, 6, 7); } } while (0)
            CX_VREAD(va, 0, 0);
#pragma unroll
            for (int st = 0; st < 16; ++st) {
                CX_VREAD(vb_, st, 4);
                asm volatile("" : "+v"(va[0]), "+v"(va[1]), "+v"(va[2]), "+v"(va[3]));
#pragma unroll
                for (int j = 0; j < 4; ++j) O[j] = MFMA32(P[st >> 1][st & 1], va[j], O[j]);
                if (st < 15) CX_VREAD(va, st + 1, 0);
                asm volatile("" : "+v"(vb_[0]), "+v"(vb_[1]), "+v"(vb_[2]), "+v"(vb_[3]));
#pragma unroll
                for (int j = 0; j < 4; ++j) O[4 + j] = MFMA32(P[st >> 1][st & 1], vb_[j], O[4 + j]);
            }
#undef CX_VREAD
            bf16* ocol = oc + (size_t)(m0 + 4 * h) * 1024 + hx * 256 + r;
#pragma unroll
            for (int dt = 0; dt < 8; ++dt)
#pragma unroll
                for (int i = 0; i < 16; ++i) ocol[(size_t)((i & 3) + 8 * (i >> 2)) * 1024 + 32 * dt] = (bf16)f2bf(O[dt][i]);
        }
    }
    __syncthreads();
}

constexpr size_t WS_PART = WS_QC, WS_LSE = WS_U, WS_SSQP = WS_U + 8 * MiB;
template <int MODE> __device__ __forceinline__ void attn_step(const bf16x8 (&kf)[4], const bf16x8 (&vf)[2][2], const bf16x8 (&qf)[4], const LAS float* tbk, int dl, float& m, float& l, f32x16 (&O)[2]) {
    f32x16 acc = zero16();
#pragma unroll
    for (int ks = 0; ks < 4; ++ks) acc = MFMA32(kf[ks], qf[ks], acc);
    float tmax = -1e30f;
#pragma unroll
    for (int hb = 0; hb < 4; ++hb) {
        const f32x2 b01 = {tbk[-(8 * hb)], tbk[-(8 * hb + 1)]}, b23 = {tbk[-(8 * hb + 2)], tbk[-(8 * hb + 3)]};
        const f32x2 a01 = (f32x2){acc[4 * hb], acc[4 * hb + 1]} + b01, a23 = (f32x2){acc[4 * hb + 2], acc[4 * hb + 3]} + b23;
        float v[4] = {a01.x, a01.y, a23.x, a23.y};
#pragma unroll
        for (int j = 0; j < 4; ++j) { const int ci = j + 8 * hb;
            if (MODE == 1) v[j] = (dl - ci <= 128) ? v[j] : -1e30f;
            else if (MODE == 2) v[j] = (dl - ci >= 0) ? v[j] : -1e30f;
            acc[4 * hb + j] = v[j]; tmax = fmaxf(tmax, v[j]); } }
    tmax = fmaxf(tmax, __shfl_xor(tmax, 32));
    const bool grow = tmax > m + 8.f;
    if (__builtin_amdgcn_ballot_w64(grow) != 0ull) {
        const float mn = grow ? tmax : m, scl = __builtin_amdgcn_exp2f(m - mn); m = mn; l *= scl;
#pragma unroll
        for (int i = 0; i < 16; ++i) { O[0][i] *= scl; O[1][i] *= scl; }
    }
    f32x2 ps = {0.f, 0.f}; const float mv = m;
#pragma unroll
    for (int i2 = 0; i2 < 8; ++i2) { const f32x2 x = (f32x2){acc[2 * i2], acc[2 * i2 + 1]} - mv; f32x2 e; e.x = __builtin_amdgcn_exp2f(x.x); e.y = __builtin_amdgcn_exp2f(x.y); acc[2 * i2] = e.x; acc[2 * i2 + 1] = e.y; ps = ps + e; }
    l += ps.x + ps.y;
#pragma unroll
    for (int s2 = 0; s2 < 2; ++s2) { const bf16x8 pf = PACK_STEP(acc, s2);
        O[0] = MFMA32(vf[s2][0], pf, O[0]); O[1] = MFMA32(vf[s2][1], pf, O[1]); }
}
__device__ __forceinline__ void attn_step_kt(const bf16x8 (&kf)[4], const bf16x8 (&vf)[2][2], const bf16x8 (&qf)[4], const LAS float* tb0, int d0, int kt, float& m, float& l, f32x16 (&O)[2]) {
    const LAS float* tbk = tb0 - 32 * kt; const int dl = d0 - 32 * kt;
    if (kt == 0) attn_step<1>(kf, vf, qf, tbk, dl, m, l, O); else if (kt == 4) attn_step<2>(kf, vf, qf, tbk, dl, m, l, O); else attn_step<0>(kf, vf, qf, tbk, dl, m, l, O);
}
__device__ __forceinline__ void attn_mfma_phase(Frame& F, const Args& A) {
    const int w = F.wave;
    LAS float* tab = (LAS float*)(F.lds + RING_OFF);
    LAS unsigned char* kl = F.lds + RING_OFF + 20480 + w * 8704;
    LAS unsigned char* vl = kl + 4608;
    const bf16* qb = WSP(bf16, WS_QB); const bf16* kb = WSP(bf16, WS_KB); const bf16* vb = WSP(bf16, WS_VB);
    bf16* part = WSP(bf16, WS_PART); float* lsep = WSP(float, WS_LSE); const float* relb = A.in[9];
    __syncthreads();
    { float tv[9];
#pragma unroll
      for (int i = 0; i < 9; ++i) { const int idx = F.tid + 512 * i, p = idx / (8 * 192), rem = idx % (8 * 192), hh = rem / 192, d = min(max(rem % 192 - 32, 0), 128); tv[i] = relb[t5_bucket(d << (2 * p)) * 8 + hh]; }
#pragma unroll
      for (int i = 0; i < 9; ++i) tab[F.tid + 512 * i] = tv[i] * 1.44269504f; }
    __syncthreads();
    for (int u = F.vcu; u < 1536; u += F.G) {
        const int p = u >> 9, v = u & 511, lg = 2 * p, b = v >> 4, w2 = v & 15, nbk = w2 >> lg, rcls = w2 & ((1 << lg) - 1);
        const size_t tokbase = (size_t)b * SEQ + rcls;
        const LAS float* tb = tab + (p * 8 + w) * 192 + 32;
        for (int pr = 0; pr < 2; ++pr) {
            int lane = F.lane; asm volatile("" : "+v"(lane));
            const int r = lane & 31, h = lane >> 5, q4 = (lane & 15) >> 2, p4 = lane & 3, blk = (lane >> 4) & 1, vxor = ((q4 >> 1) & 1) << 6;
            const int i0 = 128 * nbk + 64 * pr, jbase = i0 - 128, amin = jbase >= 0 ? 0 : ((-jbase) >> 5);
            const int d0 = 128 + r - 4 * h; const LAS float* tb0 = tb + d0;
            const int skey = lane >> 3, sc16 = lane & 7; const size_t hoff = (size_t)w * 64 + sc16 * 8;
            v4u ka[4], va[4];
            { const int j0 = jbase + 32 * amin;
#pragma unroll
              for (int i = 0; i < 4; ++i) { const size_t g = (tokbase + ((size_t)(j0 + skey + 8 * i) << lg)) * 512 + hoff; ka[i] = *(const GAS v4u*)(kb + g); va[i] = *(const GAS v4u*)(vb + g); } }
            bf16x8 qfa[4], qfb[4];
            { const bf16* qrow = qb + (tokbase + ((size_t)(i0 + r) << lg)) * 512 + w * 64 + 8 * h; const size_t qstep = ((size_t)32 << lg) * 512;
#pragma unroll
              for (int ks = 0; ks < 4; ++ks) { qfa[ks] = *(const GAS bf16x8*)(qrow + 16 * ks); qfb[ks] = *(const GAS bf16x8*)(qrow + qstep + 16 * ks); } }
            float ma = -1e30f, la = 0.f, mb = -1e30f, lb = 0.f; f32x16 Oa[2], Ob[2]; Oa[0] = zero16(); Oa[1] = zero16(); Ob[0] = zero16(); Ob[1] = zero16();
#pragma unroll 1
            for (int a = amin; a < 6; ++a) {
                {
                    asm volatile("" ::: "memory");
#pragma unroll
                    for (int i = 0; i < 4; ++i) { const int key = skey + 8 * i;
                        *(LAS v4u*)(kl + key * 144 + sc16 * 16) = ka[i];
                        *(LAS v4u*)(vl + key * 128 + ((sc16 * 16) ^ (((key >> 1) & 1) << 6))) = va[i]; }
                    if (a < 5) { const int j1 = jbase + 32 * (a + 1);
#pragma unroll
                        for (int i = 0; i < 4; ++i) { const size_t g = (tokbase + ((size_t)(j1 + skey + 8 * i) << lg)) * 512 + hoff; ka[i] = *(const GAS v4u*)(kb + g); va[i] = *(const GAS v4u*)(vb + g); } }
                    asm volatile("s_waitcnt lgkmcnt(0)" ::: "memory");
                    bf16x8 kf[4], vf[2][2];
#pragma unroll
                    for (int ks = 0; ks < 4; ++ks) kf[ks] = *(const LAS bf16x8*)(kl + r * 144 + (2 * ks + h) * 16);
#pragma unroll
                    for (int s2 = 0; s2 < 2; ++s2)
#pragma unroll
                        for (int dt = 0; dt < 2; ++dt) { const LAS unsigned char* a0 = vl + (16 * s2 + 4 * h + q4) * 128 + ((64 * dt + 32 * blk + 8 * p4) ^ vxor);
                            const s16x4 lo = tr_read(a0), hi = tr_read(a0 + 8 * 128); vf[s2][dt] = __builtin_shufflevector(lo, hi, 0, 1, 2, 3, 4, 5, 6, 7); }
                    if (a < 5) attn_step_kt(kf, vf, qfa, tb0, d0, a, ma, la, Oa);
                    if (a > 0) attn_step_kt(kf, vf, qfb, tb0, d0, a - 1, mb, lb, Ob);
                    asm volatile("s_waitcnt lgkmcnt(0)" ::: "memory");
                }
            }
#pragma unroll
            for (int sb = 0; sb < 2; ++sb) {
                float lsum = sb ? lb : la; const float mm = sb ? mb : ma; lsum += __shfl_xor(lsum, 32);
                const float inv = 1.f / lsum;
                const size_t tok = tokbase + ((size_t)(i0 + 32 * sb + r) << lg);
                bf16* orow = part + ((size_t)p * TP + tok) * 512 + w * 64 + 4 * h;
#pragma unroll
                for (int dt = 0; dt < 2; ++dt)
#pragma unroll
                    for (int g = 0; g < 4; ++g) { const f32x16& O = sb ? Ob[dt] : Oa[dt]; v2u x; x.x = cvtpk(O[4 * g] * inv, O[4 * g + 1] * inv); x.y = cvtpk(O[4 * g + 2] * inv, O[4 * g + 3] * inv);
                        *(GAS v2u*)(orow + 32 * dt + 8 * g) = x; }
                if (h == 0) lsep[((size_t)p * TP + tok) * 8 + w] = (mm + __builtin_amdgcn_logf(lsum)) * 0.69314718f;
            }
        }
    }
    __syncthreads();
}

constexpr int SSP = 272;
constexpr int SS_CN = 0, SS_BN = 34816, SS_BTD = 69632, SS_XT = 104448, SS_HB = 121856, SS_ACS = 139264;
static_assert(SS_ACS + 2 * 1536 <= LDSCTL_OFF, "SSD LDS map");

__device__ __forceinline__ void unpack8x2(const v4u w, f32x2 (&f)[4]) {
    f[0] = (f32x2){__uint_as_float(w.x << 16), __uint_as_float(w.x & 0xffff0000u)}; f[1] = (f32x2){__uint_as_float(w.y << 16), __uint_as_float(w.y & 0xffff0000u)};
    f[2] = (f32x2){__uint_as_float(w.z << 16), __uint_as_float(w.z & 0xffff0000u)}; f[3] = (f32x2){__uint_as_float(w.w << 16), __uint_as_float(w.w & 0xffff0000u)};
}
__device__ __forceinline__ f32x2 silu2(f32x2 v) { const f32x2 t = v * -1.44269504f; f32x2 e; e.x = __builtin_amdgcn_exp2f(t.x); e.y = __builtin_amdgcn_exp2f(t.y); const f32x2 d = e + 1.0f; f32x2 r; r.x = __builtin_amdgcn_rcpf(d.x); r.y = __builtin_amdgcn_rcpf(d.y); return v * r; }
constexpr size_t WS_BCC = 1455 * MiB;
__device__ __forceinline__ void bc_conv_prepass(Frame& F, const Args& A) {
    const bf16* xbc = WSP(bf16, WS_XBC); bf16* bcc = WSP(bf16, WS_BCC); const float* conv_w = A.in[16]; const float* conv_b = A.in[17];
    const int nthr = F.G * 512;
    for (int sidx = F.vcu * 512 + F.tid; sidx < (TP / 8) * 64; sidx += nthr) {
        const int cg = sidx & 63, rb = sidx >> 6, colg = 1024 + 8 * cg, row = rb * 8, t0 = row & 2047;
        v4u raw[11];
#pragma unroll
        for (int q = 0; q < 11; ++q) { const bool ok = t0 - 3 + q >= 0; const v4u x = *(const GAS v4u*)(xbc + (size_t)(ok ? row - 3 + q : row) * 1536 + colg);
            raw[q].x = ok ? x.x : 0u; raw[q].y = ok ? x.y : 0u; raw[q].z = ok ? x.z : 0u; raw[q].w = ok ? x.w : 0u; }
        f32x2 cw[4][4], cb[4];
#pragma unroll
        for (int w = 0; w < 4; ++w) { const f32x4 a = *(const GAS f32x4*)(conv_w + w * 1536 + colg), c = *(const GAS f32x4*)(conv_w + w * 1536 + colg + 4);
            cw[w][0] = (f32x2){a.x, a.y}; cw[w][1] = (f32x2){a.z, a.w}; cw[w][2] = (f32x2){c.x, c.y}; cw[w][3] = (f32x2){c.z, c.w}; }
        { const f32x4 a = *(const GAS f32x4*)(conv_b + colg), c = *(const GAS f32x4*)(conv_b + colg + 4); cb[0] = (f32x2){a.x, a.y}; cb[1] = (f32x2){a.z, a.w}; cb[2] = (f32x2){c.x, c.y}; cb[3] = (f32x2){c.z, c.w}; }
#pragma unroll
        for (int i = 0; i < 8; ++i) { f32x2 f0[4], f1[4], f2[4], f3[4], o[4]; unpack8x2(raw[i], f0); unpack8x2(raw[i + 1], f1); unpack8x2(raw[i + 2], f2); unpack8x2(raw[i + 3], f3);
#pragma unroll
            for (int e = 0; e < 4; ++e) o[e] = silu2(cb[e] + cw[0][e] * f0[e] + cw[1][e] * f1[e] + cw[2][e] * f2[e] + cw[3][e] * f3[e]);
            *(GAS v4u*)(bcc + (size_t)(row + i) * 512 + 8 * cg) = (v4u){cvtpk(o[0].x, o[0].y), cvtpk(o[1].x, o[1].y), cvtpk(o[2].x, o[2].y), cvtpk(o[3].x, o[3].y)}; }
    }
}
__device__ __forceinline__ void xstrip_load(v4u (&raw)[5], const bf16* xbc, size_t row0, int c, int k, int head) {
    const int cg = k & 7, rb = k >> 3, t0 = c * 128 + 2 * rb;
#pragma unroll
    for (int q = 0; q < 5; ++q) { const bool ok = t0 - 3 + q >= 0; const v4u x = *(const GAS v4u*)(xbc + (row0 + (ok ? t0 - 3 + q : 0)) * 1536 + head * 64 + 8 * cg);
        raw[q].x = ok ? x.x : 0u; raw[q].y = ok ? x.y : 0u; raw[q].z = ok ? x.z : 0u; raw[q].w = ok ? x.w : 0u; }
}
__device__ __forceinline__ void xstrip_compute(const v4u (&raw)[5], LAS unsigned char* L, const float* conv_w, const float* conv_b, int k, int head) {
    const int cg = k & 7, rb = k >> 3, colg = head * 64 + 8 * cg, s0 = 2 * rb;
    f32x2 cw[4][4], cb[4];
#pragma unroll
    for (int w = 0; w < 4; ++w) { const f32x4 a = *(const GAS f32x4*)(conv_w + w * 1536 + colg), c = *(const GAS f32x4*)(conv_w + w * 1536 + colg + 4);
        cw[w][0] = (f32x2){a.x, a.y}; cw[w][1] = (f32x2){a.z, a.w}; cw[w][2] = (f32x2){c.x, c.y}; cw[w][3] = (f32x2){c.z, c.w}; }
    { const f32x4 a = *(const GAS f32x4*)(conv_b + colg), c = *(const GAS f32x4*)(conv_b + colg + 4); cb[0] = (f32x2){a.x, a.y}; cb[1] = (f32x2){a.z, a.w}; cb[2] = (f32x2){c.x, c.y}; cb[3] = (f32x2){c.z, c.w}; }
    f32x2 o[2][4];
#pragma unroll
    for (int i = 0; i < 2; ++i) { f32x2 f0[4], f1[4], f2[4], f3[4]; unpack8x2(raw[i], f0); unpack8x2(raw[i + 1], f1); unpack8x2(raw[i + 2], f2); unpack8x2(raw[i + 3], f3);
#pragma unroll
        for (int e = 0; e < 4; ++e) o[i][e] = silu2(cb[e] + cw[0][e] * f0[e] + cw[1][e] * f1[e] + cw[2][e] * f2[e] + cw[3][e] * f3[e]); }
#pragma unroll
    for (int e = 0; e < 4; ++e) { *(LAS unsigned*)(L + SS_XT + (8 * cg + 2 * e) * SSP + s0 * 2) = cvtpk(o[0][e].x, o[1][e].x); *(LAS unsigned*)(L + SS_XT + (8 * cg + 2 * e + 1) * SSP + s0 * 2) = cvtpk(o[0][e].y, o[1][e].y); }
}
__device__ __forceinline__ void bcstrip_load(v4u (&raw)[8], const bf16* bcc, size_t row0, int c, int k, int g, int reg) {
    const int cg = k & 15, rb = k >> 4;
#pragma unroll
    for (int q = 0; q < 8; ++q) raw[q] = *(const GAS v4u*)(bcc + (row0 + c * 128 + 8 * rb + q) * 512 + (reg == 1 ? 0 : 256) + g * 128 + 8 * cg);
}
template <int REG> __device__ __forceinline__ void bcstrip_compute(const v4u (&raw)[8], LAS unsigned char* L, int k, const LAS float* acs, const LAS float* dtv) {
    const int cg = k & 15, rb = k >> 4, s0 = 8 * rb;
#pragma unroll
    for (int i = 0; i < 8; ++i) *(LAS v4u*)(L + (REG == 1 ? SS_BN : SS_CN) + (s0 + i) * SSP + cg * 16) = raw[i];
    if (REG == 1) { const float atot = acs[127]; float fd[8], f[8][8];
#pragma unroll
        for (int i = 0; i < 8; ++i) { fd[i] = dtv[s0 + i] * __expf(atot - acs[s0 + i]); unpack8(raw[i], f[i]); }
#pragma unroll
        for (int e = 0; e < 8; ++e) *(LAS v4u*)(L + SS_BTD + (8 * cg + e) * SSP + s0 * 2) =
            (v4u){cvtpk(f[0][e] * fd[0], f[1][e] * fd[1]), cvtpk(f[2][e] * fd[2], f[3][e] * fd[3]), cvtpk(f[4][e] * fd[4], f[5][e] * fd[5]), cvtpk(f[6][e] * fd[6], f[7][e] * fd[7])}; }
}
__device__ __forceinline__ void ssd_scan(LAS float* buf, float d0, float d1, float a, int lane) {
    float s0 = d0 * a, s1 = d1 * a;
#pragma unroll
    for (int o = 1; o < 64; o <<= 1) { const float t0 = __shfl_up(s0, o), t1 = __shfl_up(s1, o); if (lane >= o) { s0 += t0; s1 += t1; } }
    const float tot0 = __shfl(s0, 63); s1 += tot0;
    const float r0 = __shfl(s0, (lane & 32) + 31), r1 = __shfl(s1, (lane & 32) + 31);
    buf[lane] = s0; buf[64 + lane] = s1; buf[128 + lane] = d0; buf[192 + lane] = d1; buf[256 + lane] = d0 * __expf(r0 - s0); buf[320 + lane] = d1 * __expf(r1 - s1);
}
__device__ __forceinline__ void ssd_mfma_unit(Frame& F, const Args& A, int b, int head, float* hout) {
    const int w = F.wave, g = head >> 3;
    LAS unsigned char* L = F.lds + RING_OFF;
    const bf16* xbc = WSP(bf16, WS_XBC); const bf16* bcc = WSP(bf16, WS_BCC); const float* dtb = WSP(float, WS_DTB); const bf16* zg = WSP(bf16, WS_ZG); bf16* mix = WSP(bf16, WS_MIX); float* ssqp = WSP(float, WS_SSQP);
    const float* conv_w = A.in[16]; const float* conv_b = A.in[17];
    const float a = -__expf(A.in[19][head]), dsk = A.in[20][head];
    const size_t row0 = (size_t)b * SEQ;
    const int pt = w & 1, lt = (0x11002233 >> (4 * w)) & 3, pt2 = w >> 2, nt = w & 3, breg = w < 4 ? 1 : 2;
    f32x16 hacc = zero16();
    v4u rawx[5], rawb[8];
    float dn0 = 0.f, dn1 = 0.f;
    __syncthreads();
    { int lane0 = F.lane; asm volatile("" : "+v"(lane0)); const int tid0 = w * 64 + lane0;
      for (int i = tid0; i < 17408 / 16; i += 512) *(LAS v4u*)(L + SS_HB + i * 16) = (v4u){0u, 0u, 0u, 0u};
      xstrip_load(rawx, xbc, row0, 0, tid0, head); bcstrip_load(rawb, bcc, row0, 0, tid0 & 255, g, breg);
      if (w == 4) ssd_scan((LAS float*)(L + SS_ACS), dtb[(row0 + lane0) * 16 + head], dtb[(row0 + 64 + lane0) * 16 + head], a, lane0); }
    __syncthreads();
    for (int c = 0; c < 16; ++c) {
        int lane = F.lane; asm volatile("" : "+v"(lane));
        const int tid = w * 64 + lane, r = lane & 31, h = lane >> 5;
        const LAS float* acs = (const LAS float*)(L + SS_ACS + (c & 1) * 1536); const LAS float* dtv = acs + 128; const LAS float* vfac = acs + 256;
        if (w == 4 && c < 15) { dn0 = dtb[(row0 + (c + 1) * 128 + lane) * 16 + head]; dn1 = dtb[(row0 + (c + 1) * 128 + 64 + lane) * 16 + head]; }
        xstrip_compute(rawx, L, conv_w, conv_b, tid, head);
        if (w < 4) bcstrip_compute<1>(rawb, L, tid & 255, acs, dtv); else bcstrip_compute<2>(rawb, L, tid & 255, acs, dtv);
        LBAR();
        {
            if (c < 15) {
                int tc = tid; asm volatile("" : "+v"(tc));
                xstrip_load(rawx, xbc, row0, c + 1, tc, head); bcstrip_load(rawb, bcc, row0, c + 1, tc & 255, g, breg);
                if (w == 4) ssd_scan((LAS float*)(L + SS_ACS + ((c + 1) & 1) * 1536), dn0, dn1, a, lane); }
            const int l = 32 * lt + r; const size_t tok = row0 + c * 128 + l;
            v2u zw[4];
#pragma unroll
            for (int g4 = 0; g4 < 4; ++g4) zw[g4] = *(const GAS v2u*)(zg + tok * 1024 + head * 64 + 32 * pt + 8 * g4 + 4 * h);
            bf16x8 cf[8];
#pragma unroll
            for (int ks = 0; ks < 8; ++ks) cf[ks] = *(const LAS bf16x8*)(L + SS_CN + (32 * lt + r) * SSP + (16 * ks + 8 * h) * 2);
            const float al = acs[l];
            f32x16 y1 = zero16();
            for (int st = 0; st <= lt; ++st) {
                f32x16 ga = zero16(), gb = zero16();
#pragma unroll
                for (int ks = 0; ks < 8; ks += 2) { const bf16x8 af0 = *(const LAS bf16x8*)(L + SS_BN + (32 * st + r) * SSP + (16 * ks + 8 * h) * 2), af1 = *(const LAS bf16x8*)(L + SS_BN + (32 * st + r) * SSP + (16 * ks + 16 + 8 * h) * 2);
                    ga = MFMA32(af0, cf[ks], ga); gb = MFMA32(af1, cf[ks + 1], gb); }
                if (st < lt) {
                    const float ur = __expf(al - acs[32 * st + 31]);
#pragma unroll
                    for (int i = 0; i < 16; ++i) { const int sidx = 32 * st + (i & 3) + 8 * (i >> 2) + 4 * h; ga[i] = (ga[i] + gb[i]) * (ur * vfac[sidx]); }
                } else {
#pragma unroll
                    for (int i = 0; i < 16; ++i) { const int sidx = 32 * st + (i & 3) + 8 * (i >> 2) + 4 * h; const float msk = (sidx <= l) ? 1.f : 0.f;
                        const float e = __expf(fminf(al - acs[sidx], 0.f)) * (dtv[sidx] * msk); ga[i] = (ga[i] + gb[i]) * e; }
                }
#pragma unroll
                for (int s2 = 0; s2 < 2; ++s2) { const bf16x8 pf = PACK_STEP(ga, s2);
                    const LAS unsigned char* xp = L + SS_XT + (32 * pt + r) * SSP + (32 * st + 16 * s2 + 4 * h) * 2;
                    const v2u lo = *(const LAS v2u*)xp, hi = *(const LAS v2u*)(xp + 16);
                    const bf16x8 xa = __builtin_bit_cast(bf16x8, ((v4u){lo.x, lo.y, hi.x, hi.y}));
                    y1 = MFMA32(xa, pf, y1); }
            }
            f32x16 y2 = zero16(), y2b = zero16();
#pragma unroll
            for (int ks = 0; ks < 8; ks += 2) { const bf16x8 hf0 = *(const LAS bf16x8*)(L + SS_HB + (32 * pt + r) * SSP + (16 * ks + 8 * h) * 2), hf1 = *(const LAS bf16x8*)(L + SS_HB + (32 * pt + r) * SSP + (16 * ks + 16 + 8 * h) * 2);
                y2 = MFMA32(hf0, cf[ks], y2); y2b = MFMA32(hf1, cf[ks + 1], y2b); }
            const float el = __expf(al);
            float sq = 0.f;
#pragma unroll
            for (int g4 = 0; g4 < 4; ++g4) { const int p0 = 32 * pt + 8 * g4 + 4 * h;
                const float z0 = bf2f(zw[g4].x & 0xffffu), z1 = __uint_as_float(zw[g4].x & 0xffff0000u), z2 = bf2f(zw[g4].y & 0xffffu), z3 = __uint_as_float(zw[g4].y & 0xffff0000u);
                float yv[4];
#pragma unroll
                for (int j = 0; j < 4; ++j) { const float xv = bf2f(*(const LAS unsigned short*)(L + SS_XT + (p0 + j) * SSP + l * 2)); yv[j] = y1[4 * g4 + j] + el * (y2[4 * g4 + j] + y2b[4 * g4 + j]) + dsk * xv; }
                yv[0] *= z0; yv[1] *= z1; yv[2] *= z2; yv[3] *= z3;
                sq += yv[0] * yv[0] + yv[1] * yv[1] + yv[2] * yv[2] + yv[3] * yv[3];
                *(GAS v2u*)(mix + tok * 1536 + 512 + head * 64 + p0) = (v2u){cvtpk(yv[0], yv[1]), cvtpk(yv[2], yv[3])}; }
            sq += __shfl_xor(sq, 32);
            if (h == 0) ssqp[tok * 32 + head * 2 + pt] = sq;
            const float cd = __expf(acs[127]);
            f32x16 sa = zero16(), sb = zero16();
#pragma unroll
            for (int ks = 0; ks < 8; ks += 2) {
                const bf16x8 xa0 = *(const LAS bf16x8*)(L + SS_XT + (32 * pt2 + r) * SSP + (16 * ks + 8 * h) * 2), xa1 = *(const LAS bf16x8*)(L + SS_XT + (32 * pt2 + r) * SSP + (16 * ks + 16 + 8 * h) * 2);
                const bf16x8 bd0 = *(const LAS bf16x8*)(L + SS_BTD + (32 * nt + r) * SSP + (16 * ks + 8 * h) * 2), bd1 = *(const LAS bf16x8*)(L + SS_BTD + (32 * nt + r) * SSP + (16 * ks + 16 + 8 * h) * 2);
                sa = MFMA32(xa0, bd0, sa); sb = MFMA32(xa1, bd1, sb); }
#pragma unroll
            for (int i = 0; i < 16; ++i) hacc[i] = hacc[i] * cd + (sa[i] + sb[i]);
        }
        LBAR();
#pragma unroll
        for (int i = 0; i < 16; ++i) { const int p = 32 * pt2 + (i & 3) + 8 * (i >> 2) + 4 * h; *(LAS unsigned short*)(L + SS_HB + p * SSP + (32 * nt + r) * 2) = (unsigned short)f2bf(hacc[i]); }
    }
    { const int r = F.lane & 31, h = F.lane >> 5;
#pragma unroll
    for (int i = 0; i < 16; ++i) { const int p = 32 * pt2 + (i & 3) + 8 * (i >> 2) + 4 * h; hout[(size_t)p * 128 + 32 * nt + r] = hacc[i]; } }
    __syncthreads();
}

__device__ __forceinline__ void ssd_sample_wave(Frame& F, const Args& A, int v) {
    int lane = F.lane; asm volatile("" : "+v"(lane));
    const int b = v >> 4, head = v & 15, g = head >> 3; const size_t row = (size_t)TP + b;
    LAS float* wl = (LAS float*)(F.lds + RING_OFF + F.wave * 17152);
    const bf16* xbc = WSP(bf16, WS_XBC); const float* cc = A.in[4]; const float* conv_w = A.in[16]; const float* conv_b = A.in[17];
#pragma unroll
    for (int i = 0; i < 5; ++i) { const int c = lane + 64 * i; const int col = c < 64 ? head * 64 + c : (c < 192 ? 1024 + g * 128 + (c - 64) : 1280 + g * 128 + (c - 192));
        float x = conv_b[col] + conv_w[3 * 1536 + col] * bf2f(xbc[row * 1536 + col]);
#pragma unroll
        for (int w = 0; w < 3; ++w) x += conv_w[w * 1536 + col] * cc[((size_t)b * 3 + w) * 1536 + col];
        wl[c] = silu_f(x); }
    const float dt = WSP(float, WS_DTB)[row * 16 + head], dec = __expf(-dt * __expf(A.in[19][head])), dsk = A.in[20][head];
    LDS_WAIT(); asm volatile("" ::: "memory");
    const float x = wl[lane], dtx = dt * x;
    const GAS f32x4* hp = (const GAS f32x4*)(A.in[5] + (size_t)v * 8192 + lane * 128); GAS f32x4* op = (GAS f32x4*)(F.out + O_SSS + (size_t)v * 8192 + lane * 128);
    float y = 0.f;
#pragma unroll
    for (int jb = 0; jb < 4; ++jb) { f32x4 hv[8];
#pragma unroll
        for (int j = 0; j < 8; ++j) hv[j] = hp[8 * jb + j];
#pragma unroll
        for (int j = 0; j < 8; ++j) { const f32x4 B4 = *(const LAS f32x4*)(wl + 64 + 4 * (8 * jb + j)), C4 = *(const LAS f32x4*)(wl + 192 + 4 * (8 * jb + j));
            const f32x4 hn = hv[j] * dec + B4 * dtx; y += (C4.x * hn.x + C4.y * hn.y) + (C4.z * hn.z + C4.w * hn.w); op[8 * jb + j] = hn; } }
    y = (y + dsk * x) * bf2f(WSP(bf16, WS_ZG)[row * 1024 + head * 64 + lane]);
    WSP(bf16, WS_MIX)[row * 1536 + 512 + head * 64 + lane] = (bf16)f2bf(y);
    const float sq = wave_sum(y * y);
    if (lane < 2) WSP(float, WS_SSQP)[row * 32 + head * 2 + lane] = lane == 0 ? sq : 0.f;
    asm volatile("s_waitcnt lgkmcnt(0)" ::: "memory");
}
__device__ __forceinline__ void attn_sample_wave(Frame& F, const Args& A, int v) {
    int lane = F.lane; asm volatile("" : "+v"(lane));
    const int bs = v >> 3, hd = v & 7; const size_t row = (size_t)TP + bs;
    LAS float* ql = (LAS float*)(F.lds + RING_OFF + F.wave * 17152);
    LAS float* T = ql + 64;
    const float* ck = A.in[2]; const float* cv = A.in[3]; const float* relb = A.in[9];
    const float qv = bf2f(WSP(bf16, WS_QB)[row * 512 + hd * 64 + lane]), kn = bf2f(WSP(bf16, WS_KB)[row * 512 + hd * 64 + lane]), vn = bf2f(WSP(bf16, WS_VB)[row * 512 + hd * 64 + lane]);
    ql[lane] = qv;
    const float s0 = wave_sum(qv * kn) + relb[hd] * 1.44269504f;
    LDS_WAIT(); asm volatile("" ::: "memory");
    float m = lane == 0 ? s0 : -1e30f, l = lane == 0 ? 3.f : 0.f, o[64];
#pragma unroll
    for (int d = 0; d < 64; ++d) { const float vd = __shfl(vn, d); o[d] = lane == 0 ? 3.f * vd : 0.f; }
#pragma unroll 1
    for (int t = 0; t < 6; ++t) {
        const int e = lane + 64 * t, p = e >> 7, j = (e & 127) + 1, dist = j << (2 * p);
        const size_t off = (((size_t)bs * 2048 + (2048 - dist)) * 8 + hd) * 64;
        float s = relb[t5_bucket(dist) * 8 + hd] * 1.44269504f;
        { const GAS f32x4* kp = (const GAS f32x4*)(ck + off); f32x4 kr[16];
#pragma unroll
          for (int c = 0; c < 16; ++c) kr[c] = kp[c];
#pragma unroll
          for (int c = 0; c < 16; ++c) { const f32x4 q4 = *(const LAS f32x4*)(ql + 4 * c); s += (q4.x * kr[c].x + q4.y * kr[c].y) + (q4.z * kr[c].z + q4.w * kr[c].w); } }
        const float mn = fmaxf(m, s), sc = __builtin_amdgcn_exp2f(m - mn), pe = __builtin_amdgcn_exp2f(s - mn); l = l * sc + pe; m = mn;
        { const GAS f32x4* vp = (const GAS f32x4*)(cv + off); f32x4 vr[16];
#pragma unroll
          for (int c = 0; c < 16; ++c) vr[c] = vp[c];
#pragma unroll
          for (int c = 0; c < 16; ++c) { o[4 * c] = o[4 * c] * sc + pe * vr[c].x; o[4 * c + 1] = o[4 * c + 1] * sc + pe * vr[c].y; o[4 * c + 2] = o[4 * c + 2] * sc + pe * vr[c].z; o[4 * c + 3] = o[4 * c + 3] * sc + pe * vr[c].w; } }
    }
    const float M = wave_max(m), f = __builtin_amdgcn_exp2f(m - M); const float Ls = wave_sum(l * f);
#pragma unroll
    for (int d = 0; d < 64; ++d) T[lane * 65 + d] = o[d] * f;
    LDS_WAIT(); asm volatile("" ::: "memory");
    float acc = 0.f;
#pragma unroll 8
    for (int r = 0; r < 64; ++r) acc += T[r * 65 + lane];
    WSP(bf16, WS_MIX)[row * 1536 + hd * 64 + lane] = (bf16)f2bf(acc / Ls);
    LDS_WAIT(); asm volatile("" ::: "memory");
}
__device__ __forceinline__ void cross_sample_block(Frame& F, const Args& A, int pair) {
    int lane = F.lane; asm volatile("" : "+v"(lane));
    const int w = F.wave, task = pair * 2 + (w >> 2), kq = w & 3, bs = task >> 2, hx = task & 3; const size_t row = (size_t)TP + bs;
    const float* cmk = A.in[6]; const float* cmv = A.in[7];
    LAS float* X = (LAS float*)(F.lds + RING_OFF);
    float q[4]; { const v2u qw = *(const GAS v2u*)(WSP(bf16, WS_QC) + row * 1024 + hx * 256 + lane * 4); q[0] = bf2f(qw.x & 0xffffu); q[1] = __uint_as_float(qw.x & 0xffff0000u); q[2] = bf2f(qw.y & 0xffffu); q[3] = __uint_as_float(qw.y & 0xffff0000u); }
    const size_t kbase = (((size_t)bs * 256 + kq * 64) * 4 + hx) * 256 + lane * 4;
    float keep = 0.f;
#pragma unroll 1
    for (int kb = 0; kb < 4; ++kb) { f32x4 kr[16]; float d[16];
#pragma unroll
        for (int i = 0; i < 16; ++i) kr[i] = __builtin_nontemporal_load((const GAS f32x4*)(cmk + kbase + (size_t)(kb * 16 + i) * 1024));
#pragma unroll
        for (int i = 0; i < 16; ++i) d[i] = (q[0] * kr[i].x + q[1] * kr[i].y) + (q[2] * kr[i].z + q[3] * kr[i].w);
#pragma unroll
        for (int o = 1; o < 64; o <<= 1) {
#pragma unroll
            for (int i = 0; i < 16; ++i) d[i] += __shfl_xor(d[i], o); }
#pragma unroll
        for (int i = 0; i < 16; ++i) keep = (lane == kb * 16 + i) ? d[i] : keep; }
    const float mw = wave_max(keep), pe = __expf(keep - mw), lw = wave_sum(pe);
    float o[4] = {0.f, 0.f, 0.f, 0.f};
#pragma unroll 1
    for (int kb = 0; kb < 4; ++kb) { f32x4 vr[16];
#pragma unroll
        for (int i = 0; i < 16; ++i) vr[i] = __builtin_nontemporal_load((const GAS f32x4*)(cmv + kbase + (size_t)(kb * 16 + i) * 1024));
#pragma unroll
        for (int i = 0; i < 16; ++i) { const float wgt = rdlane(pe, kb * 16 + i); o[0] += wgt * vr[i].x; o[1] += wgt * vr[i].y; o[2] += wgt * vr[i].z; o[3] += wgt * vr[i].w; } }
    __syncthreads();
    *(LAS f32x4*)(X + w * 260 + lane * 4) = (f32x4){o[0], o[1], o[2], o[3]};
    if (lane == 0) { X[w * 260 + 256] = mw; X[w * 260 + 257] = lw; }
    __syncthreads();
    if (kq == 0) { const int w0 = w;
        float mm[4], ll[4];
#pragma unroll
        for (int i = 0; i < 4; ++i) { mm[i] = X[(w0 + i) * 260 + 256]; ll[i] = X[(w0 + i) * 260 + 257]; }
        const float M = fmaxf(fmaxf(mm[0], mm[1]), fmaxf(mm[2], mm[3])); float Ls = 0.f; f32x4 acc = (f32x4){0.f, 0.f, 0.f, 0.f};
#pragma unroll
        for (int i = 0; i < 4; ++i) { const float f = __expf(mm[i] - M); Ls += f * ll[i]; acc += *(const LAS f32x4*)(X + (w0 + i) * 260 + lane * 4) * f; }
        const float inv = 1.f / Ls;
        *(GAS v2u*)(WSP(bf16, WS_OC) + row * 1024 + hx * 256 + lane * 4) = (v2u){pk2(acc.x * inv, acc.y * inv), pk2(acc.z * inv, acc.w * inv)}; }
    __syncthreads();
}

#define SAMPLE_SPLIT(EPI, E, g, KS, IDX) do { pg8::Gemm g2{(g).A, (g).Bt, 256, (g).N, 256, (g).lda, (g).ldb}; pg8::SplitOrder S2; S2.init((g).N, (KS), 256, F.G, (int)blockIdx.x); \
        pg8::EpiSplit<EPI> E2{(E), WSP(float, WS_SLAB), (unsigned*)(F.ctl + CW_TICK + (IDX) * TICK_WORDS), (KS)}; \
        pg8::gemm_phase<pg8::EpiSplit<EPI>, pg8::SplitOrder, PG8_ALIGN, PG8_SP2>(F.lds + RING_OFF, g2, S2, E2, F.wave); } while (0)
__global__ void __launch_bounds__(NWAVES * 64, 2) hymba_fwd(Args args) {
    extern __shared__ __attribute__((aligned(16))) unsigned char lds[];
    Frame F;
    F.lds = (LAS unsigned char*)lds; F.MISC = (volatile LAS unsigned*)(F.lds + MISC_OFF);
    F.wave = __builtin_amdgcn_readfirstlane(threadIdx.x >> 6); refresh(F);
    F.G = gridDim.x; { const int bx = blockIdx.x; F.vcu = (F.G % 8 == 0) ? (bx % 8) * (F.G / 8) + bx / 8 : bx; }
    F.out = args.out; F.ws = args.ws; F.ctl = (gu32*)(args.ws + WS_CTL);
    for (int u = F.tid; u < (LDS_BYTES - LDSCTL_OFF) / 4; u += NWAVES * 64) ((LAS unsigned*)(F.lds + LDSCTL_OFF))[u] = 0u;
    __syncthreads();
    XcdBarrier bar; bar.bar = (unsigned*)(F.ctl + CW_BAR); bar.x = 0; bar.st = nullptr;
    if (!MK_SPLIT) bar = xcd_barrier_post((unsigned*)(F.ctl + CW_BAR), F.MISC + 8, F.tid == 0);
    const int lo = args.ph_lo, hi = args.ph_hi;
#define IN(k) (lo <= (k) && (k) < hi)
#define SEAM(k) do { if (IN(k) && IN((k) + 1)) { refresh(F); xcd_barrier(bar, F.tid == 0); } } while (0)
    const int gw = F.vcu * NWAVES + F.wave, NGW = F.G * NWAVES;
    float* out = args.out;

    if (IN(0)) { refresh(F); p0_prologue(F, args); } SEAM(0);
    if (IN(1)) { refresh(F); pg8::Gemm g{WSP(bf16, WS_XB), WSP(bf16, WS_W1GU), TP, 2 * DFF, 1024, 1024, 1024}; pg8::StaticOrder S; S.init(TP, 2 * DFF, F.G, (int)blockIdx.x);
        pg8::EpiGateUp E{WSP(bf16, WS_U), WSP(float, WS_RQ0)};
        pg8::gemm_phase<pg8::EpiGateUp, pg8::StaticOrder, PG8_ALIGN, PG8_SP2>(F.lds + RING_OFF, g, S, E, F.wave);
        SAMPLE_SPLIT(pg8::EpiGateUp, E, g, 4, 0); } SEAM(1);
    if (IN(2)) { refresh(F); pg8::Gemm g{WSP(bf16, WS_U), WSP(bf16, WS_W1D), TP, 1024, DFF, DFF, DFF}; pg8::StaticOrder S; S.init(TP, 1024, F.G, (int)blockIdx.x);
        pg8::EpiResid E{WSP(bf16, WS_XB), 0.5f, WSP(float, WS_RQ1), nullptr, nullptr};
        pg8::gemm_phase<pg8::EpiResid, pg8::StaticOrder, PG8_ALIGN, PG8_SP2>(F.lds + RING_OFF, g, S, E, F.wave);
        SAMPLE_SPLIT(pg8::EpiResid, E, g, 11, 1); } SEAM(2);
    if (IN(3)) { refresh(F); pg8::Gemm g{WSP(bf16, WS_XB), WSP(bf16, WS_WIN), TP, NINP, 1024, 1024, 1024}; pg8::StaticOrder S; S.init(TP, NINP, F.G, (int)blockIdx.x);
        pg8::EpiInProj E{WSP(float, WS_RQ1), WSP(bf16, WS_QB), WSP(bf16, WS_KB), WSP(bf16, WS_VB), WSP(bf16, WS_ZG), WSP(bf16, WS_XBC), WSP(float, WS_DTB), args.in[18],
                         out + O_WKP, out + O_WVP, out + O_CVP, out + O_WKS, out + O_WVS, out + O_CVS};
        pg8::gemm_phase<pg8::EpiInProj, pg8::StaticOrder, PG8_ALIGN, PG8_SP2>(F.lds + RING_OFF, g, S, E, F.wave);
        SAMPLE_SPLIT(pg8::EpiInProj, E, g, 4, 2); } SEAM(3);
    if (IN(4)) { refresh(F);
        for (int v = gw; v < TS * NHB; v += NGW) ssd_sample_wave(F, args, v);
        for (int v = gw; v < TS * NHA; v += NGW) attn_sample_wave(F, args, v);
        bc_conv_prepass(F, args);
        attn_mfma_phase(F, args);
        refresh(F); xcd_barrier(bar, F.tid == 0);
        refresh(F);
        for (int u = blockIdx.x; u < NB * NHB; u += F.G) { const int b = u >> 4, hd = u & 15; ssd_mfma_unit(F, args, b, hd, out + O_SSP + (size_t)u * 8192); }
    } SEAM(4);
    if (IN(5)) { refresh(F); bf16* mix = WSP(bf16, WS_MIX); const float* ssqp = WSP(float, WS_SSQP);
        { const bf16* part = WSP(bf16, WS_PART); const float* lsep = WSP(float, WS_LSE); const int hd = F.lane >> 3;
          for (int m0 = gw; m0 < TP; m0 += 8 * NGW) {
              v4u pa[8][3]; float ls[8][3];
#pragma unroll
              for (int q = 0; q < 8; ++q) { const int m = min(m0 + q * NGW, TP - 1);
#pragma unroll
                  for (int p = 0; p < 3; ++p) { ls[q][p] = lsep[((size_t)p * TP + m) * 8 + hd]; pa[q][p] = *(const GAS v4u*)(part + ((size_t)p * TP + m) * 512 + F.lane * 8); } }
#pragma unroll
              for (int q = 0; q < 8; ++q) { const int m = m0 + q * NGW; if (m >= TP) continue;
                  const float mx = fmaxf(ls[q][0], fmaxf(ls[q][1], ls[q][2])); float e0 = __expf(ls[q][0] - mx), e1 = __expf(ls[q][1] - mx), e2 = __expf(ls[q][2] - mx); const float inv = 1.f / (e0 + e1 + e2); e0 *= inv; e1 *= inv; e2 *= inv;
                  float a[8], bq[8], c[8]; unpack8(pa[q][0], a); unpack8(pa[q][1], bq); unpack8(pa[q][2], c);
                  v4u o; o.x = pk2(e0 * a[0] + e1 * bq[0] + e2 * c[0], e0 * a[1] + e1 * bq[1] + e2 * c[1]); o.y = pk2(e0 * a[2] + e1 * bq[2] + e2 * c[2], e0 * a[3] + e1 * bq[3] + e2 * c[3]);
                  o.z = pk2(e0 * a[4] + e1 * bq[4] + e2 * c[4], e0 * a[5] + e1 * bq[5] + e2 * c[5]); o.w = pk2(e0 * a[6] + e1 * bq[6] + e2 * c[6], e0 * a[7] + e1 * bq[7] + e2 * c[7]);
                  *(GAS v4u*)(mix + (size_t)m * 1536 + F.lane * 8) = o; } } }
        { float* rs2 = WSP(float, WS_RS2);
          for (int m0 = gw * 2; m0 < TP; m0 += 16 * NGW) {
              float pq[8];
#pragma unroll
              for (int q = 0; q < 8; ++q) { const int m = min(m0 + q * 2 * NGW + (F.lane >> 5), TP - 1); pq[q] = ssqp[(size_t)m * 32 + (F.lane & 31)]; }
#pragma unroll
              for (int q = 0; q < 8; ++q) { const int m = m0 + q * 2 * NGW + (F.lane >> 5); float pv = pq[q]; pv += __shfl_xor(pv, 1); pv += __shfl_xor(pv, 2); pv += __shfl_xor(pv, 4); pv += __shfl_xor(pv, 8);
                  if ((F.lane & 15) == 0 && m < TP) rs2[2 * (size_t)m + ((F.lane >> 4) & 1)] = rsqrtf(pv * (1.f / 512.f) + EPS); } } }
        for (int m = TP + gw; m < MROWS; m += NGW) {
            GAS v4u* p = (GAS v4u*)(mix + (size_t)m * 1536 + 512) + F.lane; v4u w0 = p[0], w1 = p[64];
            float pv = ssqp[(size_t)m * 32 + (F.lane & 31)]; pv += __shfl_xor(pv, 1); pv += __shfl_xor(pv, 2); pv += __shfl_xor(pv, 4); pv += __shfl_xor(pv, 8);
            const float s0 = rsqrtf(rdlane(pv, 0) * (1.f / 512.f) + EPS), s1 = rsqrtf(rdlane(pv, 16) * (1.f / 512.f) + EPS);
            float f[8]; unpack8(w0, f); v4u o; o.x = pk2(f[0] * s0, f[1] * s0); o.y = pk2(f[2] * s0, f[3] * s0); o.z = pk2(f[4] * s0, f[5] * s0); o.w = pk2(f[6] * s0, f[7] * s0); p[0] = o;
            unpack8(w1, f); o.x = pk2(f[0] * s1, f[1] * s1); o.y = pk2(f[2] * s1, f[3] * s1); o.z = pk2(f[4] * s1, f[5] * s1); o.w = pk2(f[6] * s1, f[7] * s1); p[64] = o;
        }
    } SEAM(5);
    if (IN(6)) { refresh(F); pg8::Gemm g{WSP(bf16, WS_MIX), WSP(bf16, WS_WOUT), TP, 1024, DMIX, DMIX, DMIX}; pg8::StaticOrder S; S.init(TP, 1024, F.G, (int)blockIdx.x);
        pg8::EpiResidKS EK{WSP(bf16, WS_XB), WSP(float, WS_RQ2), WSP(float, WS_RS2)};
        pg8::gemm_phase<pg8::EpiResidKS, pg8::StaticOrder, PG8_ALIGN, PG8_SP2>(F.lds + RING_OFF, g, S, EK, F.wave);
        pg8::EpiResid E{WSP(bf16, WS_XB), 1.0f, WSP(float, WS_RQ2), nullptr, nullptr};
        SAMPLE_SPLIT(pg8::EpiResid, E, g, 6, 3); } SEAM(6);
    if (IN(7)) { refresh(F);
        { pg8::Gemm g{WSP(bf16, WS_XB), WSP(bf16, WS_WCQ), TP, 1024, 1024, 1024, 1024}; pg8::StaticOrder S; S.init(TP, 1024, F.G, (int)blockIdx.x);
          pg8::EpiScale E{WSP(bf16, WS_QC), 1024, WSP(float, WS_RQ2), 0.0625f};
          pg8::gemm_phase<pg8::EpiScale, pg8::StaticOrder, PG8_ALIGN, PG8_SP2>(F.lds + RING_OFF, g, S, E, F.wave);
          SAMPLE_SPLIT(pg8::EpiScale, E, g, 4, 4); }
        { pg8::Gemm g{WSP(bf16, WS_MEMB), WSP(bf16, WS_WMEM), NB * NMEM, 2048, 1024, 1024, 1024}; pg8::StaticOrder S; S.init(NB * NMEM, 2048, F.G, (int)blockIdx.x);
          pg8::EpiMemKV E{WSP(float, WS_RMEM), out + O_MKP, out + O_MVP, WSP(bf16, WS_MKB), WSP(bf16, WS_MVB)};
          pg8::gemm_phase<pg8::EpiMemKV, pg8::StaticOrder, PG8_ALIGN, PG8_SP2>(F.lds + RING_OFF, g, S, E, F.wave); }
    } SEAM(7);
    if (IN(8)) { refresh(F); for (int pr = blockIdx.x; pr < TS * 4 / 2; pr += F.G) cross_sample_block(F, args, pr);
        cross_mfma_phase(F); } SEAM(8);
    if (IN(9)) { refresh(F); pg8::Gemm g{WSP(bf16, WS_OC), WSP(bf16, WS_WCO), TP, 1024, 1024, 1024, 1024}; pg8::StaticOrder S; S.init(TP, 1024, F.G, (int)blockIdx.x);
        pg8::EpiResid E{WSP(bf16, WS_XB), 1.0f, WSP(float, WS_RQ3), nullptr, nullptr};
        pg8::gemm_phase<pg8::EpiResid, pg8::StaticOrder, PG8_ALIGN, PG8_SP2>(F.lds + RING_OFF, g, S, E, F.wave);
        SAMPLE_SPLIT(pg8::EpiResid, E, g, 4, 5); } SEAM(9);
    if (IN(10)) { refresh(F); pg8::Gemm g{WSP(bf16, WS_XB), WSP(bf16, WS_W2GU), TP, 2 * DFF, 1024, 1024, 1024}; pg8::StaticOrder S; S.init(TP, 2 * DFF, F.G, (int)blockIdx.x);
        pg8::EpiGateUp E{WSP(bf16, WS_U), WSP(float, WS_RQ3)};
        pg8::gemm_phase<pg8::EpiGateUp, pg8::StaticOrder, PG8_ALIGN, PG8_SP2>(F.lds + RING_OFF, g, S, E, F.wave);
        SAMPLE_SPLIT(pg8::EpiGateUp, E, g, 4, 6); } SEAM(10);
    if (IN(11)) { refresh(F); pg8::Gemm g{WSP(bf16, WS_U), WSP(bf16, WS_W2D), TP, 1024, DFF, DFF, DFF}; pg8::StaticOrder S; S.init(TP, 1024, F.G, (int)blockIdx.x);
        pg8::EpiResid E{WSP(bf16, WS_XB), 0.5f, WSP(float, WS_RQ4), nullptr, nullptr};
        pg8::gemm_phase<pg8::EpiResid, pg8::StaticOrder, PG8_ALIGN, PG8_SP2>(F.lds + RING_OFF, g, S, E, F.wave);
        SAMPLE_SPLIT(pg8::EpiResid, E, g, 11, 7); } SEAM(11);
    if (IN(12)) { refresh(F); const float* rq = WSP(float, WS_RQ4); const GAS f32x4* gp = (const GAS f32x4*)args.in[33] + 2 * F.lane; const bf16* xb = WSP(bf16, WS_XB);
        f32x4 gg[2][2];
#pragma unroll
        for (int j = 0; j < 2; ++j) { gg[j][0] = gp[128 * j]; gg[j][1] = gp[128 * j + 1]; }
        for (int m0 = gw; m0 < MROWS; m0 += 4 * NGW) {
            v4u v[4][2]; float rs[4];
#pragma unroll
            for (int q = 0; q < 4; ++q) { const int m = min(m0 + q * NGW, MROWS - 1); { const GAS v4u* p = (const GAS v4u*)(xb + (size_t)m * 1024) + F.lane; v[q][0] = p[0]; v[q][1] = p[64]; rs[q] = rsqrtf(rq[m] * (1.f / 1024.f) + EPS); } }
#pragma unroll
            for (int q = 0; q < 4; ++q) { const int m = m0 + q * NGW; if (m < MROWS) { GAS f32x4* p = (GAS f32x4*)(m < TP ? out + O_YP + (size_t)m * 1024 : out + O_YS + (size_t)(m - TP) * 1024) + 2 * F.lane;
#pragma unroll
                for (int j = 0; j < 2; ++j) { float f[8]; unpack8(v[q][j], f);
                    __builtin_nontemporal_store((f32x4){f[0], f[1], f[2], f[3]} * rs[q] * gg[j][0], p + 128 * j); __builtin_nontemporal_store((f32x4){f[4], f[5], f[6], f[7]} * rs[q] * gg[j][1], p + 128 * j + 1); } } }
        }
    }
#undef IN
#undef SEAM
}

extern "C" void kernel_launch(void* const* d_in, const int* in_sizes, int n_in, void* d_out, int out_size, void* d_ws, size_t ws_size, hipStream_t stream) {
    static int grid = 0;
    if (grid == 0) {
        if (n_in != 34 || (size_t)out_size != O_END || ws_size < WS_END) { fprintf(stderr, "kernel_launch: unexpected sizes n_in %d out %d ws %zu\n", n_in, out_size, ws_size); grid = -1; return; }
        int dev = 0, cus = 0, per_cu = 0;
        if (hipGetDevice(&dev) != hipSuccess || hipDeviceGetAttribute(&cus, hipDeviceAttributeMultiprocessorCount, dev) != hipSuccess) { grid = -1; return; }
        if (hipFuncSetAttribute((const void*)hymba_fwd, hipFuncAttributeMaxDynamicSharedMemorySize, LDS_BYTES) != hipSuccess) { fprintf(stderr, "kernel_launch: hipFuncSetAttribute failed\n"); grid = -1; return; }
        if (hipOccupancyMaxActiveBlocksPerMultiprocessor(&per_cu, (const void*)hymba_fwd, NWAVES * 64, LDS_BYTES) != hipSuccess || per_cu < 1) fprintf(stderr, "kernel_launch: occupancy query reports %d\n", per_cu);
        (void)hipGetLastError();
        grid = cus;
    }
    if (grid < 0) return;
    if (hipMemsetAsync((char*)d_ws + WS_CTL, 0, CTL_ZERO_BYTES, stream) != hipSuccess) return;
    Args a{};
    for (int i = 0; i < 34; ++i) a.in[i] = (const float*)d_in[i];
    a.out = (float*)d_out; a.ws = (unsigned char*)d_ws; a.li = 0; a.pad = 0;
#if MK_SPLIT
    for (int ph = 0; ph < NPHASE; ++ph) { a.ph_lo = ph; a.ph_hi = ph + 1; hipLaunchKernelGGL(hymba_fwd, dim3(grid), dim3(NWAVES * 64), LDS_BYTES, stream, a); }
#else
    a.ph_lo = 0; a.ph_hi = NPHASE;
    hipLaunchKernelGGL(hymba_fwd, dim3(grid), dim3(NWAVES * 64), LDS_BYTES, stream, a);
#endif
}
```
